# Optimizing an MI355X kernel written in HIP

```python
import math
import jax
import jax.numpy as jnp
from jax import lax
import numpy as np

D_MODEL = 1024
BATCH = 16
SEQ = 2048
DEPTH = 2

N_A_LAYERS = DEPTH // 2
N_B_LAYERS = DEPTH - N_A_LAYERS

SSM_EXPAND = 2
D_INNER = SSM_EXPAND * D_MODEL
SSM_HEAD_DIM = 64
SSM_HEADS = D_INNER // SSM_HEAD_DIM
SSM_GROUPS = 4
SSM_HEADS_PER_GROUP = SSM_HEADS // SSM_GROUPS
SSM_STATE = 128
SSM_CONV = 4
SSM_CHUNK = 128
SSM_CONV_DIM = D_INNER + 2 * SSM_GROUPS * SSM_STATE
SSM_IN_DIM = D_INNER + SSM_CONV_DIM + SSM_HEADS

ATT_HEAD_DIM = 64
ATT_HEADS = D_MODEL // (2 * ATT_HEAD_DIM)
ATT_V_DIM = 2 * ATT_HEAD_DIM
ATT_BLOCK = 128
K_DIM = ATT_HEADS * 2 * ATT_HEAD_DIM
V_TOTAL = ATT_HEADS * ATT_V_DIM

NUM_BUCKETS = 32
MAX_DISTANCE = 128

FFN_DIM = 256 * ((8 * D_MODEL // 3 + 255) // 256)
FFN_CONV = 3

EPS = 1e-6

kernel_name = 'yoco_mamba2_diffattn_convffn'


def rms_norm(x, g):
    xf = x.astype(jnp.float32)
    y = xf * lax.rsqrt(jnp.mean(xf * xf, axis=-1, keepdims=True) + EPS)
    return y.astype(x.dtype) * g


def causal_dwconv(u, w, b):
    k_w = w.shape[0]
    s = u.shape[1]
    up = jnp.pad(u, ((0, 0), (k_w - 1, 0), (0, 0)))
    y = up[:, 0:s] * w[0]
    for k in range(1, k_w):
        y = y + up[:, k:k + s] * w[k]
    return y + b


def segsum(a):
    t = a.shape[-1]
    cs = jnp.cumsum(a, axis=-1)
    d = cs[..., :, None] - cs[..., None, :]
    mask = jnp.tril(jnp.ones((t, t), dtype=bool))
    return jnp.where(mask, d, -jnp.inf)


def ssd_chunked(xdt, a, bm, cm):
    b, s, h, p = xdt.shape
    g, r, l = SSM_GROUPS, SSM_HEADS_PER_GROUP, SSM_CHUNK
    c = s // l
    xc = xdt.reshape(b, c, l, g, r, p)
    ac = a.reshape(b, c, l, g, r).transpose(0, 3, 4, 1, 2)
    bc = bm.reshape(b, c, l, g, SSM_STATE)
    cc = cm.reshape(b, c, l, g, SSM_STATE)
    a_cs = jnp.cumsum(ac, axis=-1)
    decay_in = jnp.exp(segsum(ac))
    cb = jnp.einsum('bclgn,bcsgn->bcgls', cc, bc)
    y_diag = jnp.einsum('bcgls,bgrcls,bcsgrp->bclgrp', cb, decay_in, xc)
    decay_states = jnp.exp(a_cs[..., -1:] - a_cs)
    states = jnp.einsum('bclgn,bgrcl,bclgrp->bcgrpn', bc, decay_states, xc)
    states0 = jnp.concatenate([jnp.zeros_like(states[:, :1]), states], axis=1)
    chunk_tot = jnp.pad(a_cs[..., -1], ((0, 0), (0, 0), (0, 0), (1, 0)))
    decay_chunk = jnp.exp(segsum(chunk_tot))
    new_states = jnp.einsum('bgrzc,bcgrpn->bzgrpn', decay_chunk, states0)
    states_in = new_states[:, :-1]
    y_off = jnp.einsum('bclgn,bcgrpn,bgrcl->bclgrp', cc, states_in, jnp.exp(a_cs))
    return (y_diag + y_off).reshape(b, s, h, p)


def mamba2_mixer(x, ln_g, in_w, conv_w, conv_b, dt_bias, a_log, d_skip, norm_g, out_w):
    b, s, _ = x.shape
    zxbcdt = rms_norm(x, ln_g) @ in_w
    z = zxbcdt[..., :D_INNER]
    xbc = zxbcdt[..., D_INNER:D_INNER + SSM_CONV_DIM]
    dt = zxbcdt[..., D_INNER + SSM_CONV_DIM:]
    xbc = jax.nn.silu(causal_dwconv(xbc, conv_w, conv_b))
    gn = SSM_GROUPS * SSM_STATE
    xs = xbc[..., :D_INNER].reshape(b, s, SSM_HEADS, SSM_HEAD_DIM)
    bm = xbc[..., D_INNER:D_INNER + gn].reshape(b, s, SSM_GROUPS, SSM_STATE)
    cm = xbc[..., D_INNER + gn:].reshape(b, s, SSM_GROUPS, SSM_STATE)
    dt = jax.nn.softplus(dt.astype(jnp.float32) + dt_bias.astype(jnp.float32))
    a = dt * (-jnp.exp(a_log.astype(jnp.float32)))
    xs32 = xs.astype(jnp.float32)
    y = ssd_chunked(xs32 * dt[..., None], a, bm.astype(jnp.float32), cm.astype(jnp.float32))
    y = y + xs32 * d_skip.astype(jnp.float32)[:, None]
    y = y.reshape(b, s, D_INNER) * jax.nn.silu(z.astype(jnp.float32))
    y = rms_norm(y.reshape(b, s, SSM_GROUPS, D_INNER // SSM_GROUPS),
                 norm_g.reshape(SSM_GROUPS, D_INNER // SSM_GROUPS)).reshape(b, s, D_INNER)
    return y @ out_w


def conv_ffn(x, ln_g, up_w, conv_w, conv_b, down_w):
    u = causal_dwconv(rms_norm(x, ln_g) @ up_w, conv_w, conv_b)
    gate, up = u[..., :FFN_DIM], u[..., FFN_DIM:]
    return (jax.nn.silu(gate) * up) @ down_w


def shared_kv(x, kv_ln_g, kv_w, k_norm_g):
    b, s, _ = x.shape
    kv = rms_norm(x, kv_ln_g) @ kv_w
    k = kv[..., :K_DIM].reshape(b, s, ATT_HEADS, 2, ATT_HEAD_DIM)
    v = kv[..., K_DIM:].reshape(b, s, ATT_HEADS, ATT_V_DIM)
    return rms_norm(k, k_norm_g), v


def t5_bucket(dist):
    n = jnp.maximum(dist, 0)
    max_exact = NUM_BUCKETS // 2
    nf = jnp.maximum(n, 1).astype(jnp.float32)
    large = max_exact + (jnp.log(nf / max_exact) / math.log(MAX_DISTANCE / max_exact)
                         * (NUM_BUCKETS - max_exact)).astype(jnp.int32)
    large = jnp.minimum(large, NUM_BUCKETS - 1)
    return jnp.where(n < max_exact, n, large)


def diff_attention(x, k, v, rel_bias, ln_g, q_w, q_norm_g, lam_vecs, subln_g, out_w, lam_init):
    b, s, _ = x.shape
    q = (rms_norm(x, ln_g) @ q_w).reshape(b, s, ATT_HEADS, 2, ATT_HEAD_DIM)
    q = rms_norm(q, q_norm_g)
    lv = lam_vecs.astype(jnp.float32)
    lam = jnp.exp(jnp.sum(lv[0] * lv[1])) - jnp.exp(jnp.sum(lv[2] * lv[3])) + lam_init
    scale = ATT_HEAD_DIM ** -0.5
    nb = s // ATT_BLOCK
    qb = q.reshape(b, nb, ATT_BLOCK, ATT_HEADS, 2, ATT_HEAD_DIM).transpose(1, 0, 2, 3, 4, 5)
    kpos = jnp.arange(s)

    def block(args):
        qblk, i = args
        qpos = i * ATT_BLOCK + jnp.arange(ATT_BLOCK)
        dist = qpos[:, None] - kpos[None, :]
        bias = rel_bias[t5_bucket(dist)].astype(jnp.float32).transpose(2, 0, 1)
        logits = jnp.einsum('bqhcd,bkhcd->bhcqk', qblk, k).astype(jnp.float32) * scale
        logits = logits + bias[None, :, None]
        logits = jnp.where(dist >= 0, logits, -jnp.inf)
        p = jax.nn.softmax(logits, axis=-1)
        attn = p[:, :, 0] - lam * p[:, :, 1]
        return jnp.einsum('bhqk,bkhd->bqhd', attn.astype(v.dtype), v)

    o = lax.map(block, (qb, jnp.arange(nb)))
    o = o.transpose(1, 0, 2, 3, 4).reshape(b, s, ATT_HEADS, ATT_V_DIM)
    o = rms_norm(o, subln_g) * (1.0 - lam_init)
    return o.reshape(b, s, V_TOTAL) @ out_w


def setup_inputs(seed: int = 0) -> dict:
    key = jax.random.key(seed)
    ks = jax.random.split(key, 32)
    f32 = jnp.float32

    def nrm(k, shape, scale):
        return jax.random.normal(k, shape, f32) * scale

    def gain(k, shape):
        return 1.0 + 0.02 * jax.random.normal(k, shape, f32)

    na, nb = N_A_LAYERS, N_B_LAYERS
    dt = jnp.exp(jax.random.uniform(ks[6], (na, SSM_HEADS), f32)
                 * (math.log(0.1) - math.log(0.001)) + math.log(0.001))
    return {
        'x': nrm(ks[0], (BATCH, SEQ, D_MODEL), 1.0),
        'ssm_ln_g': gain(ks[1], (na, D_MODEL)),
        'ssm_in_w': nrm(ks[2], (na, D_MODEL, SSM_IN_DIM), D_MODEL ** -0.5),
        'ssm_conv_w': nrm(ks[3], (na, SSM_CONV, SSM_CONV_DIM), SSM_CONV ** -0.5),
        'ssm_conv_b': nrm(ks[4], (na, SSM_CONV_DIM), 0.02),
        'ssm_dt_bias': dt + jnp.log(-jnp.expm1(-dt)),
        'ssm_a_log': jnp.log(jax.random.uniform(ks[7], (na, SSM_HEADS), f32, 1.0, 16.0)),
        'ssm_d': gain(ks[8], (na, SSM_HEADS)),
        'ssm_norm_g': gain(ks[9], (na, D_INNER)),
        'ssm_out_w': nrm(ks[10], (na, D_INNER, D_MODEL), D_INNER ** -0.5),
        'kv_ln_g': gain(ks[11], (D_MODEL,)),
        'kv_w': nrm(ks[12], (D_MODEL, K_DIM + V_TOTAL), D_MODEL ** -0.5),
        'k_norm_g': gain(ks[13], (ATT_HEAD_DIM,)),
        'rel_bias': nrm(ks[14], (NUM_BUCKETS, ATT_HEADS), 0.5),
        'attn_ln_g': gain(ks[15], (nb, D_MODEL)),
        'q_w': nrm(ks[16], (nb, D_MODEL, K_DIM), D_MODEL ** -0.5),
        'q_norm_g': gain(ks[17], (nb, ATT_HEAD_DIM)),
        'lam_vecs': nrm(ks[18], (nb, 4, ATT_HEAD_DIM), 0.1),
        'subln_g': gain(ks[19], (nb, ATT_V_DIM)),
        'attn_out_w': nrm(ks[20], (nb, V_TOTAL, D_MODEL), V_TOTAL ** -0.5),
        'ffn_ln_g': gain(ks[21], (DEPTH, D_MODEL)),
        'ffn_up_w': nrm(ks[22], (DEPTH, D_MODEL, 2 * FFN_DIM), D_MODEL ** -0.5),
        'ffn_conv_w': nrm(ks[23], (DEPTH, FFN_CONV, 2 * FFN_DIM), FFN_CONV ** -0.5),
        'ffn_conv_b': nrm(ks[24], (DEPTH, 2 * FFN_DIM), 0.02),
        'ffn_down_w': nrm(ks[25], (DEPTH, FFN_DIM, D_MODEL), FFN_DIM ** -0.5),
    }


def reference(x, ssm_ln_g, ssm_in_w, ssm_conv_w, ssm_conv_b, ssm_dt_bias, ssm_a_log, ssm_d,
              ssm_norm_g, ssm_out_w, kv_ln_g, kv_w, k_norm_g, rel_bias, attn_ln_g, q_w,
              q_norm_g, lam_vecs, subln_g, attn_out_w, ffn_ln_g, ffn_up_w, ffn_conv_w,
              ffn_conv_b, ffn_down_w):
    k_sh, v_sh = None, None
    for layer in range(DEPTH):
        if layer < N_A_LAYERS:
            i = layer
            mix = mamba2_mixer(x, ssm_ln_g[i], ssm_in_w[i], ssm_conv_w[i], ssm_conv_b[i],
                               ssm_dt_bias[i], ssm_a_log[i], ssm_d[i], ssm_norm_g[i],
                               ssm_out_w[i])
        else:
            j = layer - N_A_LAYERS
            if j == 0:
                k_sh, v_sh = shared_kv(x, kv_ln_g, kv_w, k_norm_g)
            lam_init = 0.8 - 0.6 * math.exp(-0.3 * layer)
            mix = diff_attention(x, k_sh, v_sh, rel_bias, attn_ln_g[j], q_w[j], q_norm_g[j],
                                 lam_vecs[j], subln_g[j], attn_out_w[j], lam_init)
        x = x + mix.astype(x.dtype)
        ff = conv_ffn(x, ffn_ln_g[layer], ffn_up_w[layer], ffn_conv_w[layer],
                      ffn_conv_b[layer], ffn_down_w[layer])
        x = x + ff.astype(x.dtype)
    return x
```

```cpp
#include <hip/hip_runtime.h>
#include <hip/hip_bf16.h>
#include <cstdio>
#include <cstdint>
#include <cmath>
__device__ __forceinline__ int opaque_tid() { int t = threadIdx.x; asm volatile("" : "+v"(t)); return t; }
#define MK_ONE_LAUNCH 1
namespace pg8 {
#define PG8_LAS __attribute__((address_space(3)))
typedef unsigned short bf16_t;
typedef short bf16x8 __attribute__((ext_vector_type(8)));
typedef float f32x4 __attribute__((ext_vector_type(4)));
typedef unsigned u32x4 __attribute__((ext_vector_type(4)));
constexpr int BM = 256, BK = 64, HALF = 128, HTB = HALF * BK * 2  , STAGE_BYTES = 8 * HTB, NXCD = 8, WGM = 8;

__host__ __device__ __forceinline__ int lds_byte(int r, int c) { const int st = (r >> 4) * 2 + (c >> 5), rr = r & 15, cc = c & 31, ob = rr * 64 + cc * 2; return st * 1024 + (ob ^ (((ob >> 9) & 1) << 5)); }
__host__ __device__ __forceinline__ void stage_rc(int b, int& R, int& C) { const int st = b / 1024, sb = b % 1024, swz = sb ^ (((sb >> 9) & 1) << 5); R = (st >> 1) * 16 + swz / 64; C = (st & 1) * 32 + (swz % 64) / 2; }
__host__ __device__ __forceinline__ int perm32(int rho) { const int n = rho >> 4, i = rho & 15; return 8 * (i >> 2) + 4 * n + (i & 3); }

struct Unit { int pm, pn; };
struct Gemm { const bf16_t* A; const bf16_t* Bt; int M, N, K; };

struct StaticOrder {
    int nM, nN, nwg, G, c;
    __host__ __device__ void init(int M, int N, int G_, int c_) { nM = M / BM; nN = N / BM; nwg = nM * nN; G = G_; c = c_; }
    __host__ __device__ bool next(int i, Unit& u) const {
        const long L = (long)i * G + c; if (L >= nwg) return false;
        int wgid = (int)L; { const int q = nwg / NXCD, r = nwg % NXCD, xcd = wgid % NXCD, off = wgid / NXCD; wgid = (xcd < r ? xcd * (q + 1) : r * (q + 1) + (xcd - r) * q) + off; }
        const int nig = WGM * nN, gid = wgid / nig, fm = gid * WGM, gsz = (nM - fm) < WGM ? (nM - fm) : WGM;
        u.pm = fm + ((wgid % nig) % gsz); u.pn = (wgid % nig) / gsz; return true;
    }
    __device__ __forceinline__ void a_ready(const Unit&) const {}
    __device__ __forceinline__ void done(const Unit&) const {}
};
__device__ __forceinline__ unsigned cvt_pk_bf16(float lo, float hi) { unsigned r; asm volatile("v_cvt_pk_bf16_f32 %0, %1, %2" : "=v"(r) : "v"(lo), "v"(hi)); return r; }
typedef float f32x2 __attribute__((ext_vector_type(2)));
template <class Epi, class Sched, bool ALIGN_EPI = false, bool SP2 = false>
__device__ __forceinline__ void gemm_phase(PG8_LAS unsigned char* lds, const Gemm g, const Sched& S, const Epi& E) {
    const int tid = opaque_tid(), wid = __builtin_amdgcn_readfirstlane(tid >> 6), lane = tid & 63, wr = wid >> 2, wc = wid & 3, fr = lane & 15, fq = lane >> 4;
    const int K = g.K, nt = K / BK;
    unsigned voffA[2], voffB[2];
#pragma unroll
    for (int i = 0; i < 2; ++i) { int R, C; stage_rc(tid * 16 + i * 8192, R, C); const int Rb = Epi::PERM ? ((R & ~31) + perm32(R & 31)) : R;
        voffA[i] = (unsigned)(R * K + C) * 2u; voffB[i] = (unsigned)(Rb * K + C) * 2u; }
    const size_t kstep = (size_t)(BK * 2);
    const size_t hstep = (size_t)HALF * K * 2;
    const size_t tstep = 2 * hstep;
    const unsigned ldsw = (unsigned)wid * 1024u;
    const int aoff = lds_byte(wr * 64 + fr, fq * 8), boff = lds_byte(wc * 32 + fr, fq * 8);
#define PG8_SA(b, h) (((b) * 2 + (h)) * HTB)
#define PG8_SB(b, h) ((4 + (b) * 2 + (h)) * HTB)
#define PG8_STAGE(bufoff, gbase, voff) do { _Pragma("unroll") for (int _i = 0; _i < 2; ++_i) \
        __builtin_amdgcn_global_load_lds((const unsigned*)((const char*)(gbase) + (voff)[_i]), (PG8_LAS unsigned*)(lds + (bufoff) + ldsw + _i * 8192), 16, 0, 0); } while (0)
#define PG8_LDA(dst, b, h) do { _Pragma("unroll") for (int m = 0; m < 4; ++m) _Pragma("unroll") for (int k = 0; k < 2; ++k) dst[m][k] = *(const PG8_LAS bf16x8*)(lds + PG8_SA(b, h) + aoff + m * 2048 + k * 1024); } while (0)
#define PG8_LDB(dst, b, h) do { _Pragma("unroll") for (int n = 0; n < 2; ++n) _Pragma("unroll") for (int k = 0; k < 2; ++k) dst[n][k] = *(const PG8_LAS bf16x8*)(lds + PG8_SB(b, h) + boff + n * 2048 + k * 1024); } while (0)
#define PG8_MMA(ai, bj, At, Bt) do { __builtin_amdgcn_s_setprio(1); _Pragma("unroll") for (int m = 0; m < 4; ++m) _Pragma("unroll") for (int n = 0; n < 2; ++n) _Pragma("unroll") for (int k = 0; k < 2; ++k) \
        acc[ai][bj][m][n] = __builtin_amdgcn_mfma_f32_16x16x32_bf16(Bt[n][k], At[m][k], acc[ai][bj][m][n], 0, 0, 0); __builtin_amdgcn_s_setprio(0); } while (0)
#define PG8_WAIT_V(n) asm volatile("s_waitcnt vmcnt(" #n ")" ::: "memory")
#define PG8_WAIT_L(n) asm volatile("s_waitcnt lgkmcnt(" #n ")" ::: "memory")
#define PG8_BAR __builtin_amdgcn_s_barrier()
#define PG8_SCHED __builtin_amdgcn_sched_barrier(0)
    Unit cur, nxt; int ui = 0;
    if (!S.next(0, cur)) return;
    f32x4 acc[2][2][4][2];
#pragma unroll
    for (int a = 0; a < 2; ++a)
#pragma unroll
        for (int b = 0; b < 2; ++b)
#pragma unroll
            for (int m = 0; m < 4; ++m)
#pragma unroll
                for (int n = 0; n < 2; ++n) acc[a][b][m][n] = (f32x4){0.f, 0.f, 0.f, 0.f};
    bf16x8 At[4][2], B0[2][2], B1[2][2];
    const char* cA = (const char*)g.A + (size_t)cur.pm * tstep; const char* cB = (const char*)g.Bt + (size_t)cur.pn * tstep;
    S.a_ready(cur);
    if constexpr (SP2) {
        PG8_STAGE(PG8_SB(0, 0), cB, voffB); PG8_STAGE(PG8_SB(0, 1), cB + hstep, voffB); PG8_STAGE(PG8_SA(0, 0), cA, voffA); PG8_STAGE(PG8_SA(0, 1), cA + hstep, voffA);
        if (wr == 1) PG8_BAR;
        PG8_WAIT_V(2); PG8_BAR;
        PG8_STAGE(PG8_SB(1, 0), cB + kstep, voffB); PG8_STAGE(PG8_SA(1, 0), cA + kstep, voffA); PG8_STAGE(PG8_SB(1, 1), cB + hstep + kstep, voffB);
        PG8_WAIT_V(6); PG8_BAR;
    } else {
        PG8_STAGE(PG8_SB(0, 0), cB, voffB); PG8_STAGE(PG8_SA(0, 0), cA, voffA); PG8_STAGE(PG8_SB(0, 1), cB + hstep, voffB); PG8_STAGE(PG8_SA(0, 1), cA + hstep, voffA);
        if (wr == 1) PG8_BAR;
        PG8_WAIT_V(4); PG8_BAR;
        PG8_STAGE(PG8_SB(1, 0), cB + kstep, voffB); PG8_STAGE(PG8_SA(1, 0), cA + kstep, voffA); PG8_STAGE(PG8_SB(1, 1), cB + hstep + kstep, voffB);
        PG8_WAIT_V(6); PG8_BAR;
    }
    for (;;) {
        const bool has_next = S.next(ui + 1, nxt);
        const char* nA = has_next ? (const char*)g.A + (size_t)nxt.pm * tstep : cA; const char* nB = has_next ? (const char*)g.Bt + (size_t)nxt.pn * tstep : cB;
        for (int t = 0; t < nt; t += 2) {
            const bool last = (t == nt - 2);
            const char* a1 = cA + (size_t)(t + 1) * kstep;
            const char* a2 = last ? nA : cA + (size_t)(t + 2) * kstep; const char* b2 = last ? nB : cB + (size_t)(t + 2) * kstep;
            const char* a3 = a2 + kstep; const char* b3 = b2 + kstep;
            if (last && has_next) S.a_ready(nxt);
            if constexpr (SP2) {
            PG8_LDB(B0, 0, 0); PG8_LDB(B1, 0, 1); PG8_SCHED; PG8_LDA(At, 0, 0); PG8_STAGE(PG8_SA(1, 1), a1 + hstep, voffA);
            PG8_WAIT_V(8); PG8_WAIT_L(0); PG8_BAR; PG8_MMA(0, 0, At, B0); PG8_MMA(0, 1, At, B1); PG8_BAR; PG8_SCHED;
            PG8_LDA(At, 0, 1); PG8_STAGE(PG8_SB(0, 0), b2, voffB); PG8_STAGE(PG8_SB(0, 1), b2 + hstep, voffB); PG8_STAGE(PG8_SA(0, 0), a2, voffA);
            PG8_WAIT_V(8); PG8_WAIT_L(0); PG8_BAR; PG8_MMA(1, 0, At, B0); PG8_MMA(1, 1, At, B1); PG8_BAR; PG8_SCHED;
            PG8_LDB(B0, 1, 0); PG8_LDB(B1, 1, 1); PG8_SCHED; PG8_LDA(At, 1, 0); PG8_STAGE(PG8_SA(0, 1), a2 + hstep, voffA);
            PG8_WAIT_V(8); PG8_WAIT_L(0); PG8_BAR; PG8_MMA(0, 0, At, B0); PG8_MMA(0, 1, At, B1); PG8_BAR; PG8_SCHED;
            PG8_LDA(At, 1, 1); PG8_STAGE(PG8_SB(1, 0), b3, voffB); PG8_STAGE(PG8_SB(1, 1), b3 + hstep, voffB); PG8_STAGE(PG8_SA(1, 0), a3, voffA);
            PG8_WAIT_V(8); PG8_WAIT_L(0); PG8_BAR; PG8_MMA(1, 0, At, B0); PG8_MMA(1, 1, At, B1); PG8_BAR; PG8_SCHED;
            } else {
            PG8_LDB(B0, 0, 0); PG8_SCHED; PG8_LDA(At, 0, 0); PG8_STAGE(PG8_SA(1, 1), a1 + hstep, voffA);
            PG8_WAIT_L(8); PG8_BAR; PG8_WAIT_L(0); PG8_MMA(0, 0, At, B0); PG8_BAR; PG8_SCHED;
            PG8_LDB(B1, 0, 1); PG8_STAGE(PG8_SB(0, 0), b2, voffB);
            PG8_BAR; PG8_WAIT_L(0); PG8_MMA(0, 1, At, B1); PG8_BAR;
            PG8_LDA(At, 0, 1); PG8_STAGE(PG8_SA(0, 0), a2, voffA);
            PG8_BAR; PG8_WAIT_L(0); PG8_MMA(1, 0, At, B0); PG8_BAR; PG8_SCHED;
            PG8_STAGE(PG8_SB(0, 1), b2 + hstep, voffB);
            PG8_WAIT_V(6); PG8_BAR; PG8_MMA(1, 1, At, B1); PG8_BAR;
            PG8_LDB(B0, 1, 0); PG8_SCHED; PG8_LDA(At, 1, 0); PG8_STAGE(PG8_SA(0, 1), a2 + hstep, voffA);
            PG8_WAIT_L(8); PG8_BAR; PG8_WAIT_L(0); PG8_MMA(0, 0, At, B0); PG8_BAR; PG8_SCHED;
            PG8_LDB(B1, 1, 1); PG8_STAGE(PG8_SB(1, 0), b3, voffB);
            PG8_BAR; PG8_WAIT_L(0); PG8_MMA(0, 1, At, B1); PG8_BAR;
            PG8_LDA(At, 1, 1); PG8_STAGE(PG8_SA(1, 0), a3, voffA);
            PG8_BAR; PG8_WAIT_L(0); PG8_MMA(1, 0, At, B0); PG8_BAR; PG8_SCHED;
            PG8_STAGE(PG8_SB(1, 1), b3 + hstep, voffB);
            PG8_WAIT_V(6); PG8_BAR; PG8_MMA(1, 1, At, B1); PG8_BAR;
            }
        }
        if constexpr (ALIGN_EPI) { if (wr == 0) PG8_BAR; }
        if constexpr (!Epi::AFTER_DRAIN) { E(acc, cur, wr, wc, fr, fq); S.done(cur); }
        if (!has_next) break;
#pragma unroll
        for (int a = 0; a < 2; ++a)
#pragma unroll
            for (int b = 0; b < 2; ++b)
#pragma unroll
                for (int m = 0; m < 4; ++m)
#pragma unroll
                    for (int n = 0; n < 2; ++n) acc[a][b][m][n] = (f32x4){0.f, 0.f, 0.f, 0.f};
        cur = nxt; cA = nA; cB = nB; ++ui;
        if constexpr (ALIGN_EPI) { if (wr == 1) PG8_BAR; }
    }
    PG8_WAIT_V(0);
    if constexpr (!ALIGN_EPI) { if (wr == 0) PG8_BAR; }
    PG8_BAR;
    if constexpr (Epi::AFTER_DRAIN) { E.fused(acc, cur, wr, wc, fr, fq, lds, wid, lane); S.done(cur); }
#undef PG8_SA
#undef PG8_SB
#undef PG8_STAGE
#undef PG8_LDA
#undef PG8_LDB
#undef PG8_MMA
#undef PG8_WAIT_V
#undef PG8_WAIT_L
#undef PG8_BAR
#undef PG8_SCHED
}
}

namespace pg8 {
typedef unsigned u32x2 __attribute__((ext_vector_type(2)));
__device__ __forceinline__ u32x4 pack8(const f32x4& v0, const f32x4& v1) {
    u32x4 w; w.x = cvt_pk_bf16(v0[0], v0[1]); w.y = cvt_pk_bf16(v0[2], v0[3]); w.z = cvt_pk_bf16(v1[0], v1[1]); w.w = cvt_pk_bf16(v1[2], v1[3]); return w;
}
struct EpiIn {
    static constexpr bool PERM = true, AFTER_DRAIN = false;
    bf16_t* Z; bf16_t* XBC; float* DT; const float* rstd;
    __device__ __forceinline__ void operator()(const f32x4 (&acc)[2][2][4][2], const Unit& u, int wr, int wc, int fr, int fq) const {
        const int row0 = u.pm * BM + wr * 64 + fr, c8 = wc * 32 + 8 * fq;
#pragma unroll
        for (int ai = 0; ai < 2; ++ai)
#pragma unroll
            for (int m = 0; m < 4; ++m) {
                const int row = row0 + ai * HALF + m * 16; const float rs = rstd[row];
#pragma unroll
                for (int bj = 0; bj < 2; ++bj) {
                    const f32x4 v0 = acc[ai][bj][m][0] * rs, v1 = acc[ai][bj][m][1] * rs;
                    if (u.pn < 8) *(u32x4*)(Z + (size_t)row * 2048 + u.pn * 256 + bj * HALF + c8) = pack8(v0, v1);
                    else if (u.pn < 20) *(u32x4*)(XBC + (size_t)row * 3072 + (u.pn - 8) * 256 + bj * HALF + c8) = pack8(v0, v1);
                    else if (bj == 0 && wc == 0) { float* d = DT + (size_t)row * 32 + 8 * fq; *(f32x4*)d = v0; *(f32x4*)(d + 4) = v1; }
                }
            }
    }
};
struct EpiRes {
    static constexpr bool PERM = false, AFTER_DRAIN = false;
    const float* base; float* out;
    __device__ __forceinline__ void operator()(const f32x4 (&acc)[2][2][4][2], const Unit& u, int wr, int wc, int fr, int fq) const {
        const int row0 = u.pm * BM + wr * 64 + fr, col0 = u.pn * BM + wc * 32 + 4 * fq;
#pragma unroll
        for (int ai = 0; ai < 2; ++ai)
#pragma unroll
            for (int m = 0; m < 4; ++m) {
                const size_t off = (size_t)(row0 + ai * HALF + m * 16) * 1024 + col0;
#pragma unroll
                for (int bj = 0; bj < 2; ++bj)
#pragma unroll
                    for (int n = 0; n < 2; ++n) { const f32x4 bs = *(const f32x4*)(base + off + bj * HALF + n * 16); *(f32x4*)(out + off + bj * HALF + n * 16) = bs + acc[ai][bj][m][n]; }
                asm volatile("" ::: "memory");
            }
    }
};
struct EpiScale {
    static constexpr bool PERM = true, AFTER_DRAIN = false;
    bf16_t* O; int ldc; const float* rstd;
    __device__ __forceinline__ void operator()(const f32x4 (&acc)[2][2][4][2], const Unit& u, int wr, int wc, int fr, int fq) const {
        const int row0 = u.pm * BM + wr * 64 + fr, c8 = u.pn * BM + wc * 32 + 8 * fq;
#pragma unroll
        for (int ai = 0; ai < 2; ++ai)
#pragma unroll
            for (int m = 0; m < 4; ++m) {
                const int row = row0 + ai * HALF + m * 16; const float rs = rstd[row];
#pragma unroll
                for (int bj = 0; bj < 2; ++bj) *(u32x4*)(O + (size_t)row * ldc + bj * HALF + c8) = pack8(acc[ai][bj][m][0] * rs, acc[ai][bj][m][1] * rs);
            }
    }
};
struct EpiKVQ {
    static constexpr bool PERM = true, AFTER_DRAIN = false;
    bf16_t* Kb; size_t tstride; const float* rstd;
    __device__ __forceinline__ void operator()(const f32x4 (&acc)[2][2][4][2], const Unit& u, int wr, int wc, int fr, int fq) const {
        const int row0 = u.pm * BM + wr * 64 + fr, c8 = (u.pn & 3) * BM + wc * 32 + 8 * fq;
        bf16_t* base = Kb + (size_t)(u.pn >> 2) * tstride;
#pragma unroll
        for (int ai = 0; ai < 2; ++ai)
#pragma unroll
            for (int m = 0; m < 4; ++m) {
                const int row = row0 + ai * HALF + m * 16; const float rs = rstd[row];
#pragma unroll
                for (int bj = 0; bj < 2; ++bj) *(u32x4*)(base + (size_t)row * 1024 + bj * HALF + c8) = pack8(acc[ai][bj][m][0] * rs, acc[ai][bj][m][1] * rs);
            }
    }
};
}

constexpr int NWAVES = 8;
constexpr int NBATCH = 16, SEQ = 2048, M_TOK = NBATCH * SEQ, DM = 1024;
constexpr int DIN = 2048, NXBC = 3072, NIN = 5152, NINP = 5376, SSM_H = 32;
constexpr int FF = 2816, FF2 = 5632, MH = M_TOK / 2;
constexpr float EPS = 1e-6f, LOG2E = 1.4426950408889634f;
constexpr float LAM_INIT = 0.35550906759096926f;
constexpr float QSCALE = 0.125f * 1.4426950408889634f;

constexpr size_t MiB = 1u << 20;
constexpr size_t WS_CTL = 0, CTL_ZERO_BYTES = 1 * MiB;
constexpr size_t WS_WIN = 1 * MiB, WS_WOUT = 12 * MiB, WS_WUP0 = 16 * MiB, WS_WUP1 = 27 * MiB, WS_WDN0 = 38 * MiB, WS_WDN1 = 44 * MiB,
                 WS_WKVQ = 50 * MiB, WS_WAO = 56 * MiB, WS_RSTD = 58 * MiB, WS_DT = 59 * MiB;
constexpr size_t WS_XB = 64 * MiB;
constexpr size_t WS_R = 128 * MiB;
constexpr size_t WS_Z = WS_R, WS_XBC = WS_R + 128 * MiB;
constexpr size_t WS_U = WS_R, WS_H = WS_R + 176 * MiB;
constexpr size_t WS_K = WS_R, WS_V = WS_R + 64 * MiB, WS_Q = WS_R + 128 * MiB;
constexpr size_t WS_END = 512 * MiB;
constexpr int CW_BAR = 4096;

constexpr int RING_BYTES = 131072;
constexpr int LDSCTL_OFF = RING_BYTES, MISC_OFF = LDSCTL_OFF + 320;
constexpr int LDS_BYTES = 147456;

#define GAS __attribute__((address_space(1)))
#define LAS __attribute__((address_space(3)))
typedef unsigned short bf16;
typedef unsigned v4u __attribute__((ext_vector_type(4)));
typedef float f32x4 __attribute__((ext_vector_type(4)));
typedef short bf16x8 __attribute__((ext_vector_type(8)));
typedef GAS unsigned gu32;
typedef GAS unsigned long long gu64;
#define RLX_AGENT __ATOMIC_RELAXED, __HIP_MEMORY_SCOPE_AGENT
#define LDS_WAIT() asm volatile("s_waitcnt lgkmcnt(0)" ::: "memory")
#define VM_WAIT() asm volatile("s_waitcnt vmcnt(0)" ::: "memory")
__device__ __forceinline__ unsigned long long rt() { return __builtin_amdgcn_s_memrealtime(); }
__device__ __forceinline__ unsigned f2bf(float f) { unsigned u = __builtin_bit_cast(unsigned, f); return (u + 0x7fffu + ((u >> 16) & 1u)) >> 16; }
__device__ __forceinline__ unsigned pk2(float lo, float hi) { return f2bf(lo) | (f2bf(hi) << 16); }
#define XB_TMO      128
#define XB_XCNT(j)  (256  + 64 * (j))
#define XB_XSUB(j)  (1280 + 64 * (j))
#define XB_XGEN(j)  (2304 + 64 * (j))
#define XB_TOP      3328
#define XB_TOPGEN   3392
#define XCD_BAR_WORDS 3456
#define XB_SPIN_CAP (1u << 18)

__device__ __forceinline__ unsigned xb_ld(unsigned* p)              { return __hip_atomic_load(p, __ATOMIC_RELAXED, __HIP_MEMORY_SCOPE_AGENT); }
__device__ __forceinline__ unsigned xb_add(unsigned* p, unsigned v) { return __hip_atomic_fetch_add(p, v, __ATOMIC_RELAXED, __HIP_MEMORY_SCOPE_AGENT); }
__device__ __forceinline__ unsigned xb_xcc_id() { return (unsigned)__builtin_amdgcn_s_getreg((3 << 11) | 20) & 0xFu; }
#define XB_SPIN(cond, bar) do { unsigned _sp = 0; while (cond) { __builtin_amdgcn_s_sleep(1); \
    if ((++_sp & 255u) == 0u) { if (xb_ld(&(bar)[XB_TMO])) break; if (_sp > XB_SPIN_CAP) { atomicAdd(&(bar)[XB_TMO], 1u); break; } } } } while (0)

struct XcdBarrier {
    unsigned* bar; unsigned x;
    volatile LAS unsigned* st;
};

__device__ __forceinline__ XcdBarrier xcd_barrier_post(unsigned* bar, volatile LAS unsigned* st) {
    XcdBarrier b; b.bar = bar; b.x = xb_xcc_id(); b.st = st;
    if (threadIdx.x == 0) (void)xb_add(&bar[XB_XCNT(b.x)], 1u);
    return b;
}
__device__ __forceinline__ void xcd_barrier_complete(unsigned* bar, unsigned x, unsigned& nloc, unsigned& nx) {
    const unsigned G = gridDim.x * gridDim.y * gridDim.z;
    unsigned sum, cnt, mine, sp = 0u;
    for (;;) {
        sum = 0u; cnt = 0u; mine = 0u;
#pragma unroll
        for (unsigned j = 0; j < 16; ++j) { const unsigned c = xb_ld(&bar[XB_XCNT(j)]); sum += c; cnt += (c > 0u) ? 1u : 0u; mine = (j == x) ? c : mine; }
        if (sum == G) break;
        __builtin_amdgcn_s_sleep(1);
        if ((++sp & 255u) == 0u) { if (xb_ld(&bar[XB_TMO])) break; if (sp > XB_SPIN_CAP) { atomicAdd(&bar[XB_TMO], 1u); break; } }
    }
    nloc = mine > 0u ? mine : 1u; nx = cnt > 0u ? cnt : 1u;
}

__device__ __forceinline__ void xcd_barrier(const XcdBarrier& b) {
    asm volatile("s_waitcnt vmcnt(0)" ::: "memory");
    __syncthreads();
    if (threadIdx.x == 0) {
        unsigned* bar = b.bar;
        __builtin_amdgcn_s_waitcnt(0);
        unsigned nloc = b.st[0], nx = b.st[1];
        if (nloc == 0u) { xcd_barrier_complete(bar, b.x, nloc, nx); b.st[0] = nloc; b.st[1] = nx; }
        const unsigned old = xb_add(&bar[XB_XSUB(b.x)], 1u);
        const unsigned gen = old / nloc;
        if (old + 1u == (gen + 1u) * nloc) {
            __builtin_amdgcn_fence(__ATOMIC_RELEASE, "agent");
            asm volatile("s_waitcnt vmcnt(0)" ::: "memory");
            const unsigned og = xb_add(&bar[XB_TOP], 1u);
            const unsigned tg = og / nx;
            if (og + 1u == (tg + 1u) * nx) xb_add(&bar[XB_TOPGEN], 1u);
            else XB_SPIN(xb_ld(&bar[XB_TOPGEN]) == tg, bar);
            __builtin_amdgcn_fence(__ATOMIC_ACQUIRE, "agent");
            xb_add(&bar[XB_XGEN(b.x)], 1u);
            asm volatile("s_waitcnt vmcnt(0)" ::: "memory");
        } else {
            XB_SPIN(xb_ld(&bar[XB_XGEN(b.x)]) == gen, bar);
            __builtin_amdgcn_fence(__ATOMIC_ACQUIRE, "agent");
            asm volatile("s_waitcnt vmcnt(0)" ::: "memory");
        }
    }
    __syncthreads();
}

struct Args { const float* in[25]; float* out; unsigned char* ws; int ph_lo, ph_hi; };

__device__ __forceinline__ float bf2f(bf16 v) { return __builtin_bit_cast(float, (unsigned)v << 16); }
__device__ __forceinline__ float wave_sum(float v) {
#pragma unroll
    for (int o = 1; o < 64; o <<= 1) v += __shfl_xor(v, o);
    return v;
}
__device__ __forceinline__ float silu_f(float v) { return v / (1.f + __expf(-v)); }

__device__ __forceinline__ void wprep_item(const float* W, int K, int Nsrc, int scol0, const float* gain, int gmask, float gscale,
                                           bf16* WT, int drow0, int k0, LAS float* scr, int lane) {
#pragma unroll 8
    for (int i = 0; i < 32; ++i) { const int kk = 2 * i + (lane >> 5);
        float v = W ? W[(size_t)(k0 + kk) * Nsrc + scol0 + (lane & 31)] : 0.f;
        const float gn = gain ? gain[(k0 + kk) & gmask] * gscale : gscale;
        scr[kk * 33 + (lane & 31)] = v * gn; }
    LDS_WAIT(); asm volatile("" ::: "memory");
    const int c = lane & 7;
#pragma unroll
    for (int j = 0; j < 4; ++j) { const int n = (lane >> 3) + 8 * j; const LAS float* s = scr + (8 * c) * 33 + n;
        v4u o; o.x = pk2(s[0 * 33], s[1 * 33]); o.y = pk2(s[2 * 33], s[3 * 33]); o.z = pk2(s[4 * 33], s[5 * 33]); o.w = pk2(s[6 * 33], s[7 * 33]);
        *(GAS v4u*)(WT + (size_t)(drow0 + n) * K + k0 + 8 * c) = o; }
    LDS_WAIT(); asm volatile("" ::: "memory");
}
__device__ __forceinline__ void rowstat_phase(const float* x, bf16* xb, float* rstd, int gw, int NGW, int lane) {
    for (int m = gw; m < M_TOK; m += NGW) {
        const GAS f32x4* xr = (const GAS f32x4*)(x + (size_t)m * DM) + lane;
        f32x4 v[4]; float s = 0.f;
#pragma unroll
        for (int j = 0; j < 4; ++j) { v[j] = xr[64 * j]; s += (v[j].x * v[j].x + v[j].y * v[j].y) + (v[j].z * v[j].z + v[j].w * v[j].w); }
        s = wave_sum(s);
        GAS unsigned long long* o8 = (GAS unsigned long long*)(xb + (size_t)m * DM) + lane;
#pragma unroll
        for (int j = 0; j < 4; ++j) o8[64 * j] = (unsigned long long)pk2(v[j].x, v[j].y) | ((unsigned long long)pk2(v[j].z, v[j].w) << 32);
        if (lane == 0) rstd[m] = 1.f / sqrtf(s * (1.f / DM) + EPS);
    }
}
__device__ __forceinline__ void prep_phase(const Args& a, LAS unsigned char* lds, int gw, int NGW, int wave, int lane) {
    LAS float* scr = (LAS float*)(lds + wave * 16384);
    unsigned char* ws = a.ws;
    constexpr int I_IN = 16 * 168, I_OUT = 32 * 32, I_UP = 16 * 176, I_DN = 44 * 32, I_KV = 16 * 64, I_Q = 16 * 32, I_AO = 16 * 32;
    constexpr int NITEMS = I_IN + I_OUT + 2 * I_UP + 2 * I_DN + I_KV + I_Q + I_AO;
    for (int it = gw; it < NITEMS; it += NGW) {
        int r = it;
        if (r < I_IN) { const int kb = r / 168, db = r % 168;
            wprep_item(db < 161 ? a.in[2] : nullptr, 1024, NIN, 32 * db, a.in[1], 1023, 1.f, (bf16*)(ws + WS_WIN), 32 * db, 64 * kb, scr, lane); continue; } r -= I_IN;
        if (r < I_OUT) { const int kb = r / 32, db = r % 32;
            wprep_item(a.in[9], 2048, 1024, 32 * db, a.in[8], 2047, 1.f, (bf16*)(ws + WS_WOUT), 32 * db, 64 * kb, scr, lane); continue; } r -= I_OUT;
        if (r < 2 * I_UP) { const int l = r / I_UP; r -= l * I_UP; const int kb = r / 176, db = r % 176, j = db >> 3, q = db & 7;
            const int scol = (q < 4) ? (128 * j + 32 * q) : (FF + 128 * j + 32 * (q - 4));
            wprep_item(a.in[21] + (size_t)l * 1024 * FF2, 1024, FF2, scol, a.in[20] + l * 1024, 1023, 1.f, (bf16*)(ws + (l ? WS_WUP1 : WS_WUP0)), 32 * db, 64 * kb, scr, lane); continue; } r -= 2 * I_UP;
        if (r < 2 * I_DN) { const int l = r / I_DN; r -= l * I_DN; const int kb = r / 32, db = r % 32;
            wprep_item(a.in[24] + (size_t)l * FF * 1024, FF, 1024, 32 * db, nullptr, 0, 1.f, (bf16*)(ws + (l ? WS_WDN1 : WS_WDN0)), 32 * db, 64 * kb, scr, lane); continue; } r -= 2 * I_DN;
        if (r < I_KV) { const int kb = r / 64, db = r % 64;
            wprep_item(a.in[11], 1024, 2048, 32 * db, a.in[10], 1023, 1.f, (bf16*)(ws + WS_WKVQ), 32 * db, 64 * kb, scr, lane); continue; } r -= I_KV;
        if (r < I_Q) { const int kb = r / 32, db = r % 32;
            wprep_item(a.in[15], 1024, 1024, 32 * db, a.in[14], 1023, 1.f, (bf16*)(ws + WS_WKVQ), 2048 + 32 * db, 64 * kb, scr, lane); continue; } r -= I_Q;
        { const int kb = r / 32, db = r % 32;
            wprep_item(a.in[19], 1024, 1024, 32 * db, a.in[18], 127, 1.f - LAM_INIT, (bf16*)(ws + WS_WAO), 32 * db, 64 * kb, scr, lane); }
    }
    rowstat_phase(a.in[0], (bf16*)(ws + WS_XB), (float*)(ws + WS_RSTD), gw, NGW, lane);
}

__device__ __forceinline__ void ssd_naive_phase(const Args& a, LAS unsigned char* lds) {
    const int tid = opaque_tid();
    LAS float* cx = (LAS float*)lds;
    LAS float* cB = cx + 64 * 64;
    LAS float* cC = cB + 64 * 128;
    LAS float* cdA = cC + 64 * 128;
    LAS float* cdt = cdA + 64;
    const bf16* XBC = (const bf16*)(a.ws + WS_XBC); bf16* Z = (bf16*)(a.ws + WS_Z); const float* DT = (const float*)(a.ws + WS_DT);
    const float* conv_w = a.in[3]; const float* conv_b = a.in[4];
    const int p = tid >> 3, ns = (tid & 7) * 16;
    for (int item = blockIdx.x; item < NBATCH * SSM_H; item += gridDim.x) {
        const int b = item >> 5, h = item & 31, g = h >> 3;
        const float Aneg = -__expf(a.in[6][h]), dtb = a.in[5][h], Dh = a.in[7][h];
        float hst[16];
#pragma unroll
        for (int i = 0; i < 16; ++i) hst[i] = 0.f;
        for (int t0 = 0; t0 < SEQ; t0 += 64) {
            for (int e = tid; e < 64 * 320; e += 512) {
                const int tt = e / 320, j = e - tt * 320;
                const int col = j < 64 ? 64 * h + j : (j < 192 ? 2048 + 128 * g + (j - 64) : 2560 + 128 * g + (j - 192));
                const int t = t0 + tt;
                float v = conv_b[col];
#pragma unroll
                for (int k = 0; k < 4; ++k) { const int ts = t - 3 + k; if (ts >= 0) v += conv_w[k * NXBC + col] * bf2f(XBC[(size_t)(b * SEQ + ts) * NXBC + col]); }
                v = silu_f(v);
                if (j < 64) cx[tt * 64 + j] = v; else if (j < 192) cB[tt * 128 + (j - 64)] = v; else cC[tt * 128 + (j - 192)] = v;
            }
            if (tid < 64) { const float raw = DT[(size_t)(b * SEQ + t0 + tid) * 32 + h] + dtb; const float dtv = raw > 20.f ? raw : log1pf(__expf(raw)); cdt[tid] = dtv; cdA[tid] = __expf(dtv * Aneg); }
            __syncthreads();
            for (int tt = 0; tt < 64; ++tt) {
                const float xv = cx[tt * 64 + p], dA = cdA[tt], xdt = xv * cdt[tt];
                float acc = 0.f;
#pragma unroll
                for (int i = 0; i < 16; ++i) { hst[i] = dA * hst[i] + xdt * cB[tt * 128 + ns + i]; acc += cC[tt * 128 + ns + i] * hst[i]; }
                acc += __shfl_xor(acc, 1); acc += __shfl_xor(acc, 2); acc += __shfl_xor(acc, 4);
                if ((tid & 7) == 0) { const size_t idx = (size_t)(b * SEQ + t0 + tt) * DIN + 64 * h + p; const float z = bf2f(Z[idx]); Z[idx] = (bf16)f2bf((acc + xv * Dh) * silu_f(z)); }
            }
            __syncthreads();
        }
    }
}
__device__ __forceinline__ void groupnorm_phase(const Args& a, int gw, int NGW, int lane) {
    bf16* Z = (bf16*)(a.ws + WS_Z);
    for (int i = gw; i < M_TOK * 4; i += NGW) {
        GAS v4u* p = (GAS v4u*)(Z + (size_t)i * 512) + lane;
        const v4u w = *p; float f[8];
        f[0] = __builtin_bit_cast(float, w.x << 16); f[1] = __builtin_bit_cast(float, w.x & 0xffff0000u); f[2] = __builtin_bit_cast(float, w.y << 16); f[3] = __builtin_bit_cast(float, w.y & 0xffff0000u);
        f[4] = __builtin_bit_cast(float, w.z << 16); f[5] = __builtin_bit_cast(float, w.z & 0xffff0000u); f[6] = __builtin_bit_cast(float, w.w << 16); f[7] = __builtin_bit_cast(float, w.w & 0xffff0000u);
        float s = 0.f;
#pragma unroll
        for (int j = 0; j < 8; ++j) s += f[j] * f[j];
        s = wave_sum(s);
        const float r = 1.f / sqrtf(s * (1.f / 512.f) + EPS);
        v4u o; o.x = pk2(f[0] * r, f[1] * r); o.y = pk2(f[2] * r, f[3] * r); o.z = pk2(f[4] * r, f[5] * r); o.w = pk2(f[6] * r, f[7] * r);
        *p = o;
    }
}
__device__ __forceinline__ void convact_phase(const Args& a, int layer, int r0) {
    const bf16* U = (const bf16*)(a.ws + WS_U); bf16* H = (bf16*)(a.ws + WS_H);
    const float* cw = a.in[22] + (size_t)layer * 3 * FF2; const float* cb = a.in[23] + (size_t)layer * FF2;
    const int nthr = gridDim.x * blockDim.x;
    for (int e = blockIdx.x * blockDim.x + opaque_tid(); e < MH * (FF / 8); e += nthr) {
        const int t = e / (FF / 8), c = (e - t * (FF / 8)) * 8, j = c >> 7, i = c & 127, gcol = 256 * j + i, ucol = gcol + 128;
        const int tseq = (r0 + t) & (SEQ - 1);
        float g[8], u[8];
#pragma unroll
        for (int q = 0; q < 8; ++q) { g[q] = cb[c + q]; u[q] = cb[FF + c + q]; }
#pragma unroll
        for (int k = 0; k < 3; ++k) {
            if (tseq - 2 + k < 0) continue;
            const bf16* rowp = U + (size_t)(t - 2 + k) * FF2;
            const v4u wg = *(const GAS v4u*)(rowp + gcol), wu = *(const GAS v4u*)(rowp + ucol);
            const unsigned gg[4] = {wg.x, wg.y, wg.z, wg.w}, uu[4] = {wu.x, wu.y, wu.z, wu.w};
#pragma unroll
            for (int q = 0; q < 4; ++q) {
                g[2 * q] += cw[k * FF2 + c + 2 * q] * __builtin_bit_cast(float, gg[q] << 16); g[2 * q + 1] += cw[k * FF2 + c + 2 * q + 1] * __builtin_bit_cast(float, gg[q] & 0xffff0000u);
                u[2 * q] += cw[k * FF2 + FF + c + 2 * q] * __builtin_bit_cast(float, uu[q] << 16); u[2 * q + 1] += cw[k * FF2 + FF + c + 2 * q + 1] * __builtin_bit_cast(float, uu[q] & 0xffff0000u);
            }
        }
        v4u o; o.x = pk2(silu_f(g[0]) * u[0], silu_f(g[1]) * u[1]); o.y = pk2(silu_f(g[2]) * u[2], silu_f(g[3]) * u[3]);
        o.z = pk2(silu_f(g[4]) * u[4], silu_f(g[5]) * u[5]); o.w = pk2(silu_f(g[6]) * u[6], silu_f(g[7]) * u[7]);
        *(GAS v4u*)(H + (size_t)t * FF + c) = o;
    }
}
__device__ __forceinline__ void qknorm_phase(const Args& a, int gw, int NGW, int lane) {
    for (int i = gw; i < M_TOK * 2; i += NGW) {
        const int tok = i >> 1, isq = i & 1;
        bf16* base = (bf16*)(a.ws + (isq ? WS_Q : WS_K)) + (size_t)tok * 1024 + lane * 16;
        const float* g = (isq ? a.in[16] : a.in[12]) + (lane & 3) * 16; const float sc = isq ? QSCALE : 1.f;
        const v4u w0 = *(const GAS v4u*)base, w1 = *(const GAS v4u*)(base + 8);
        const unsigned ww[8] = {w0.x, w0.y, w0.z, w0.w, w1.x, w1.y, w1.z, w1.w};
        float f[16]; float s = 0.f;
#pragma unroll
        for (int q = 0; q < 8; ++q) { f[2 * q] = __builtin_bit_cast(float, ww[q] << 16); f[2 * q + 1] = __builtin_bit_cast(float, ww[q] & 0xffff0000u); s += f[2 * q] * f[2 * q] + f[2 * q + 1] * f[2 * q + 1]; }
        s += __shfl_xor(s, 1); s += __shfl_xor(s, 2);
        const float r = sc / sqrtf(s * (1.f / 64.f) + EPS);
        unsigned o[8];
#pragma unroll
        for (int q = 0; q < 8; ++q) o[q] = pk2(f[2 * q] * r * g[2 * q], f[2 * q + 1] * r * g[2 * q + 1]);
        *(GAS v4u*)base = (v4u){o[0], o[1], o[2], o[3]}; *(GAS v4u*)(base + 8) = (v4u){o[4], o[5], o[6], o[7]};
    }
}
__device__ __forceinline__ int t5_bucket(int n) {
    if (n < 16) return n;
    int l = 16 + (int)(__logf((float)n / 16.f) / 2.0794415416798357f * 16.f);
    return l < 31 ? l : 31;
}
__device__ __forceinline__ void attn_naive_phase(const Args& a, LAS unsigned char* lds) {
    const int tid = opaque_tid(), lane = tid & 63;
    LAS float* Qs = (LAS float*)lds;
    LAS float* Ks = Qs + 64 * 129;
    LAS float* Vs = Ks + 64 * 129;
    LAS float* Ws = Vs + 64 * 128;
    LAS float* btab = Ws + 64 * 65;
    const bf16* Kb = (const bf16*)(a.ws + WS_K); const bf16* Vb = (const bf16*)(a.ws + WS_V); bf16* Qb = (bf16*)(a.ws + WS_Q);
    const float* rel_bias = a.in[13]; const float* lv = a.in[17];
    const int r = tid >> 3, ks = tid & 7;
    for (int item = blockIdx.x; item < 4096; item += gridDim.x) {
        const int qb = 31 - (item >> 7), bh = item & 127, b = bh >> 3, h = bh & 7;
        const size_t row0 = (size_t)b * SEQ + qb * 64;
        __syncthreads();
        for (int e = tid; e < 64 * 128; e += 512) { const int rr = e >> 7, c = e & 127; Qs[rr * 129 + c] = bf2f(Qb[(row0 + rr) * 1024 + h * 128 + c]); }
        if (tid < 129) { const int bk = t5_bucket(tid); btab[tid] = rel_bias[bk * 8 + h] * LOG2E; }
        if (tid < 64) { float s0 = lv[tid] * lv[64 + tid], s1 = lv[128 + tid] * lv[192 + tid]; s0 = wave_sum(s0); s1 = wave_sum(s1); if (tid == 0) btab[129] = __expf(s0) - __expf(s1) + LAM_INIT; }
        const int qpos = qb * 64 + r;
        float m0 = -1e30f, l0 = 0.f, m1 = -1e30f, l1 = 0.f;
        for (int kt = 0; kt <= qb; ++kt) {
            __syncthreads();
            for (int e = tid; e < 64 * 128; e += 512) { const int kk = e >> 7, c = e & 127; Ks[kk * 129 + c] = bf2f(Kb[((size_t)b * SEQ + kt * 64 + kk) * 1024 + h * 128 + c]); }
            __syncthreads();
            float s0[8], s1[8];
#pragma unroll
            for (int i = 0; i < 8; ++i) { s0[i] = 0.f; s1[i] = 0.f; }
            for (int d = 0; d < 64; ++d) { const float q0 = Qs[r * 129 + d], q1 = Qs[r * 129 + 64 + d];
#pragma unroll
                for (int i = 0; i < 8; ++i) { s0[i] += q0 * Ks[(ks * 8 + i) * 129 + d]; s1[i] += q1 * Ks[(ks * 8 + i) * 129 + 64 + d]; } }
#pragma unroll
            for (int i = 0; i < 8; ++i) { const int kpos = kt * 64 + ks * 8 + i;
                if (kpos <= qpos) { const int dist = qpos - kpos; const float bb = btab[dist < 128 ? dist : 128];
                    const float a0 = s0[i] + bb, a1 = s1[i] + bb;
                    float mn = fmaxf(m0, a0); l0 = l0 * exp2f(m0 - mn) + exp2f(a0 - mn); m0 = mn;
                    mn = fmaxf(m1, a1); l1 = l1 * exp2f(m1 - mn) + exp2f(a1 - mn); m1 = mn; } }
        }
#pragma unroll
        for (int off = 1; off < 8; off <<= 1) {
            float mo = __shfl_xor(m0, off), lo = __shfl_xor(l0, off); float mn = fmaxf(m0, mo); l0 = l0 * exp2f(m0 - mn) + lo * exp2f(mo - mn); m0 = mn;
            mo = __shfl_xor(m1, off); lo = __shfl_xor(l1, off); mn = fmaxf(m1, mo); l1 = l1 * exp2f(m1 - mn) + lo * exp2f(mo - mn); m1 = mn;
        }
        const float inv0 = 1.f / l0, inv1 = 1.f / l1, lam = btab[129];
        float o[16];
#pragma unroll
        for (int d = 0; d < 16; ++d) o[d] = 0.f;
        for (int kt = 0; kt <= qb; ++kt) {
            __syncthreads();
            for (int e = tid; e < 64 * 128; e += 512) { const int kk = e >> 7, c = e & 127; const size_t gi = ((size_t)b * SEQ + kt * 64 + kk) * 1024 + h * 128 + c;
                Ks[kk * 129 + c] = bf2f(Kb[gi]); Vs[kk * 128 + c] = bf2f(Vb[gi]); }
            __syncthreads();
            float s0[8], s1[8];
#pragma unroll
            for (int i = 0; i < 8; ++i) { s0[i] = 0.f; s1[i] = 0.f; }
            for (int d = 0; d < 64; ++d) { const float q0 = Qs[r * 129 + d], q1 = Qs[r * 129 + 64 + d];
#pragma unroll
                for (int i = 0; i < 8; ++i) { s0[i] += q0 * Ks[(ks * 8 + i) * 129 + d]; s1[i] += q1 * Ks[(ks * 8 + i) * 129 + 64 + d]; } }
#pragma unroll
            for (int i = 0; i < 8; ++i) { const int kpos = kt * 64 + ks * 8 + i; float w = 0.f;
                if (kpos <= qpos) { const int dist = qpos - kpos; const float bb = btab[dist < 128 ? dist : 128];
                    w = exp2f(s0[i] + bb - m0) * inv0 - lam * exp2f(s1[i] + bb - m1) * inv1; }
                Ws[r * 65 + ks * 8 + i] = w; }
            __syncthreads();
            for (int kk = 0; kk < 64; ++kk) { const float w = Ws[r * 65 + kk];
#pragma unroll
                for (int d = 0; d < 16; ++d) o[d] += w * Vs[kk * 128 + ks * 16 + d]; }
        }
        float ss = 0.f;
#pragma unroll
        for (int d = 0; d < 16; ++d) ss += o[d] * o[d];
        ss += __shfl_xor(ss, 1); ss += __shfl_xor(ss, 2); ss += __shfl_xor(ss, 4);
        const float rs = 1.f / sqrtf(ss * (1.f / 128.f) + EPS);
        bf16* op = Qb + (row0 + r) * 1024 + h * 128 + ks * 16;
        *(GAS v4u*)op = (v4u){pk2(o[0] * rs, o[1] * rs), pk2(o[2] * rs, o[3] * rs), pk2(o[4] * rs, o[5] * rs), pk2(o[6] * rs, o[7] * rs)};
        *(GAS v4u*)(op + 8) = (v4u){pk2(o[8] * rs, o[9] * rs), pk2(o[10] * rs, o[11] * rs), pk2(o[12] * rs, o[13] * rs), pk2(o[14] * rs, o[15] * rs)};
        (void)lane;
    }
}

#ifndef MK_ONE_LAUNCH
#define MK_ONE_LAUNCH 1
#endif
constexpr int N_PHASES = 24;
__global__ void __launch_bounds__(NWAVES * 64, 2) mk_fwd(Args args) {
    extern __shared__ __attribute__((aligned(16))) unsigned char lds_raw[];
    LAS unsigned char* lds = (LAS unsigned char*)lds_raw;
    const int G = gridDim.x;
    const int vcu = (G % 8 == 0) ? ((int)blockIdx.x % 8) * (G / 8) + (int)blockIdx.x / 8 : (int)blockIdx.x;
    const int NGW = G * NWAVES;
    unsigned char* ws = args.ws;
    gu32* ctl = (gu32*)(ws + WS_CTL);
    for (int u = threadIdx.x; u < (LDS_BYTES - LDSCTL_OFF) / 4; u += NWAVES * 64) ((LAS unsigned*)(lds + LDSCTL_OFF))[u] = 0u;
    __syncthreads();
    volatile LAS unsigned* MISC = (volatile LAS unsigned*)(lds + MISC_OFF);
    XcdBarrier bar; bar.bar = (unsigned*)(ctl + CW_BAR); bar.x = 0; bar.st = nullptr;
    const bool multi = (args.ph_hi - args.ph_lo) > 1;
    if (multi) bar = xcd_barrier_post((unsigned*)(ctl + CW_BAR), MISC + 8);

    bf16* const XB = (bf16*)(ws + WS_XB); float* const RSTD = (float*)(ws + WS_RSTD);
    for (int ph = args.ph_lo; ph < args.ph_hi; ++ph) {
        const int tid = opaque_tid(), lane = tid & 63, wave = __builtin_amdgcn_readfirstlane(tid >> 6);
        const int gw = vcu * NWAVES + wave;
        if (ph == 0) prep_phase(args, lds, gw, NGW, wave, lane);
        else if (ph == 1) {
            pg8::Gemm g{XB, (const bf16*)(ws + WS_WIN), M_TOK, NINP, DM}; pg8::StaticOrder S; S.init(M_TOK, NINP, G, (int)blockIdx.x);
            pg8::EpiIn E{(bf16*)(ws + WS_Z), (bf16*)(ws + WS_XBC), (float*)(ws + WS_DT), RSTD};
            pg8::gemm_phase<pg8::EpiIn, pg8::StaticOrder, true, true>(lds, g, S, E);
        }
        else if (ph == 2) ssd_naive_phase(args, lds);
        else if (ph == 3) groupnorm_phase(args, gw, NGW, lane);
        else if (ph == 5 || ph == 12 || ph == 17) rowstat_phase(args.out, XB, RSTD, gw, NGW, lane);
        else if (ph == 13) {
            pg8::Gemm g{XB, (const bf16*)(ws + WS_WKVQ), M_TOK, 3072, DM}; pg8::StaticOrder S; S.init(M_TOK, 3072, G, (int)blockIdx.x);
            pg8::EpiKVQ E{(bf16*)(ws + WS_K), (size_t)(WS_V - WS_K) / 2, RSTD};
            static_assert(WS_Q - WS_V == WS_V - WS_K, "K, V, Q equally spaced");
            pg8::gemm_phase<pg8::EpiKVQ, pg8::StaticOrder, true, true>(lds, g, S, E);
        }
        else if (ph == 14) qknorm_phase(args, gw, NGW, lane);
        else if (ph == 15) attn_naive_phase(args, lds);
        else {
            int ffn_l = -1, ffn_s = 0;
            if (ph >= 6 && ph <= 11) { ffn_l = 0; ffn_s = ph - 6; } else if (ph >= 18 && ph <= 23) { ffn_l = 1; ffn_s = ph - 18; }
            const int half = ffn_s / 3, step = ffn_s % 3, r0 = half * MH;
            if (ffn_l >= 0 && step == 0) {
                pg8::Gemm g{XB + (size_t)r0 * DM, (const bf16*)(ws + (ffn_l ? WS_WUP1 : WS_WUP0)), MH, FF2, DM}; pg8::StaticOrder S; S.init(MH, FF2, G, (int)blockIdx.x);
                pg8::EpiScale E{(bf16*)(ws + WS_U), FF2, RSTD + r0};
                pg8::gemm_phase<pg8::EpiScale, pg8::StaticOrder, true, true>(lds, g, S, E);
            } else if (ffn_l >= 0 && step == 1) convact_phase(args, ffn_l, r0);
            else {
                const bf16* A; const bf16* Bt; int Mg, Kg; const float* base; float* outp;
                if (ph == 4) { A = (const bf16*)(ws + WS_Z); Bt = (const bf16*)(ws + WS_WOUT); Mg = M_TOK; Kg = DIN; base = args.in[0]; outp = args.out; }
                else if (ph == 16) { A = (const bf16*)(ws + WS_Q); Bt = (const bf16*)(ws + WS_WAO); Mg = M_TOK; Kg = DM; base = args.out; outp = args.out; }
                else { A = (const bf16*)(ws + WS_H); Bt = (const bf16*)(ws + (ffn_l ? WS_WDN1 : WS_WDN0)); Mg = MH; Kg = FF; base = args.out + (size_t)r0 * DM; outp = args.out + (size_t)r0 * DM; }
                pg8::Gemm g{A, Bt, Mg, DM, Kg}; pg8::StaticOrder S; S.init(Mg, DM, G, (int)blockIdx.x);
                pg8::EpiRes E{base, outp};
                pg8::gemm_phase<pg8::EpiRes, pg8::StaticOrder, true, true>(lds, g, S, E);
            }
        }
        if (ph + 1 < args.ph_hi) xcd_barrier(bar);
    }
}

extern "C" void kernel_launch(void* const* d_in, const int* in_sizes, int n_in, void* d_out, int out_size, void* d_ws, size_t ws_size, hipStream_t stream) {
    static int grid = 0;
    if (grid == 0) {
        if (n_in != 25 || in_sizes[0] != M_TOK * DM || out_size != M_TOK * DM || ws_size < WS_END) {
            fprintf(stderr, "kernel_launch: unexpected problem (n_in %d, in0 %d, out %d, ws %zu)\n", n_in, n_in > 0 ? in_sizes[0] : -1, out_size, ws_size); grid = -1; return; }
        int dev = 0, cus = 0, per_cu = 0;
        if (hipGetDevice(&dev) != hipSuccess || hipDeviceGetAttribute(&cus, hipDeviceAttributeMultiprocessorCount, dev) != hipSuccess) { grid = -1; return; }
        if (hipFuncSetAttribute((const void*)mk_fwd, hipFuncAttributeMaxDynamicSharedMemorySize, LDS_BYTES) != hipSuccess) { fprintf(stderr, "kernel_launch: hipFuncSetAttribute failed\n"); grid = -1; return; }
        if (hipOccupancyMaxActiveBlocksPerMultiprocessor(&per_cu, (const void*)mk_fwd, NWAVES * 64, LDS_BYTES) != hipSuccess || per_cu < 1)
            fprintf(stderr, "kernel_launch: occupancy query reports %d blocks per CU\n", per_cu);
        (void)hipGetLastError();
        grid = cus;
    }
    if (grid < 0) return;
    if (hipMemsetAsync((char*)d_ws + WS_CTL, 0, CTL_ZERO_BYTES, stream) != hipSuccess) { fprintf(stderr, "kernel_launch: memset failed\n"); return; }
    Args a{};
    for (int i = 0; i < 25; ++i) a.in[i] = (const float*)d_in[i];
    a.out = (float*)d_out; a.ws = (unsigned char*)d_ws;
#if MK_ONE_LAUNCH
    a.ph_lo = 0; a.ph_hi = N_PHASES;
    hipLaunchKernelGGL(mk_fwd, dim3(grid), dim3(NWAVES * 64), LDS_BYTES, stream, a);
#else
    for (int ph = 0; ph < N_PHASES; ++ph) { a.ph_lo = ph; a.ph_hi = ph + 1; hipLaunchKernelGGL(mk_fwd, dim3(grid), dim3(NWAVES * 64), LDS_BYTES, stream, a); }
#endif
    const hipError_t le = hipPeekAtLastError();
    if (le != hipSuccess) fprintf(stderr, "kernel_launch: launch failed: %s\n", hipGetErrorName(le));
}
```

```cpp
#include <hip/hip_runtime.h>
#include <hip/hip_bf16.h>
#include <cstdio>
#include <cstdint>
#include <cmath>
__device__ __forceinline__ int opaque_tid() { int t = threadIdx.x; asm volatile("" : "+v"(t)); return t; }
#ifndef ATT_REPS
#define ATT_REPS 2
#endif
#ifndef SSD_Y2XBC
#define SSD_Y2XBC 1
#endif
#ifndef SSD_SKEW_CYCLES
#define SSD_SKEW_CYCLES 25000
#endif
#define MK_ONE_LAUNCH 1

namespace pg8 {
#define PG8_LAS __attribute__((address_space(3)))
typedef unsigned short bf16_t;
typedef short bf16x8 __attribute__((ext_vector_type(8)));
typedef float f32x4 __attribute__((ext_vector_type(4)));
typedef unsigned u32x4 __attribute__((ext_vector_type(4)));
constexpr int BM = 256, BK = 64, HALF = 128, HTB = HALF * BK * 2  , STAGE_BYTES = 8 * HTB, NXCD = 8, WGM = 8;

__host__ __device__ __forceinline__ int lds_byte(int r, int c) { const int st = (r >> 4) * 2 + (c >> 5), rr = r & 15, cc = c & 31, ob = rr * 64 + cc * 2; return st * 1024 + (ob ^ (((ob >> 9) & 1) << 5)); }
__host__ __device__ __forceinline__ void stage_rc(int b, int& R, int& C) { const int st = b / 1024, sb = b % 1024, swz = sb ^ (((sb >> 9) & 1) << 5); R = (st >> 1) * 16 + swz / 64; C = (st & 1) * 32 + (swz % 64) / 2; }
__host__ __device__ __forceinline__ int perm32(int rho) { const int n = rho >> 4, i = rho & 15; return 8 * (i >> 2) + 4 * n + (i & 3); }

struct Unit { int pm, pn, ui; };
struct Gemm { const bf16_t* A; const bf16_t* Bt; int M, N, K; };

struct StaticOrder {
    int nM, nN, nwg, G, c;
    __host__ __device__ void init(int M, int N, int G_, int c_) { nM = M / BM; nN = N / BM; nwg = nM * nN; G = G_; c = c_; }
    __host__ __device__ bool next(int i, Unit& u) const {
        const long L = (long)i * G + c; if (L >= nwg) return false;
        int wgid = (int)L; { const int q = nwg / NXCD, r = nwg % NXCD, xcd = wgid % NXCD, off = wgid / NXCD; wgid = (xcd < r ? xcd * (q + 1) : r * (q + 1) + (xcd - r) * q) + off; }
        const int nig = WGM * nN, gid = wgid / nig, fm = gid * WGM, gsz = (nM - fm) < WGM ? (nM - fm) : WGM;
        u.pm = fm + ((wgid % nig) % gsz); u.pn = (wgid % nig) / gsz; return true;
    }
    __device__ __forceinline__ void a_ready(const Unit&) const {}
    __device__ __forceinline__ void done(const Unit&) const {}
};
__device__ __forceinline__ unsigned cvt_pk_bf16(float lo, float hi) { unsigned r; asm volatile("v_cvt_pk_bf16_f32 %0, %1, %2" : "=v"(r) : "v"(lo), "v"(hi)); return r; }
typedef float f32x2 __attribute__((ext_vector_type(2)));
template <class Epi, class Sched, bool ALIGN_EPI = false, bool SP2 = false>
__device__ __forceinline__ void gemm_phase(PG8_LAS unsigned char* lds, const Gemm g, const Sched& S, const Epi& E, float* probe_slot_ = nullptr) {
    const int tid = opaque_tid(), wid = __builtin_amdgcn_readfirstlane(tid >> 6), lane = tid & 63, wr = wid >> 2, wc = wid & 3, fr = lane & 15, fq = lane >> 4;
    const int K = g.K, nt = K / BK;
    unsigned voffA[2], voffB[2];
#pragma unroll
    for (int i = 0; i < 2; ++i) { int R, C; stage_rc(tid * 16 + i * 8192, R, C); const int Rb = Epi::PERM ? ((R & ~31) + perm32(R & 31)) : R;
        voffA[i] = (unsigned)(R * K + C) * 2u; voffB[i] = (unsigned)(Rb * K + C) * 2u; }
    const size_t kstep = (size_t)(BK * 2);
    const size_t hstep = (size_t)HALF * K * 2;
    const size_t tstep = 2 * hstep;
    const unsigned ldsw = (unsigned)wid * 1024u;
    const unsigned lds0_ = (unsigned)__builtin_amdgcn_readfirstlane((int)((unsigned)(uintptr_t)lds + ldsw));
    const int aoff = lds_byte(wr * 64 + fr, fq * 8), boff = lds_byte(wc * 32 + fr, fq * 8);
#define PG8_SA(b, h) (((b) * 2 + (h)) * HTB)
#define PG8_SB(b, h) ((4 + (b) * 2 + (h)) * HTB)
#define PG8_STAGE(bufoff, gbase, voff) do { _Pragma("unroll") for (int _i = 0; _i < 2; ++_i) { unsigned keep_; \
        asm volatile("s_mov_b32 m0, %2\n\ts_nop 0\n\tglobal_load_lds_dwordx4 %0, %1" \
            :: "v"((voff)[_i]), "s"((const char*)(gbase)), "s"(lds0_ + (unsigned)((bufoff) + _i * 8192)) : "memory", "m0"); (void)keep_; } } while (0)
#define PG8_LDA(dst, b, h) do { _Pragma("unroll") for (int m = 0; m < 4; ++m) _Pragma("unroll") for (int k = 0; k < 2; ++k) dst[m][k] = *(const PG8_LAS bf16x8*)(lds + PG8_SA(b, h) + aoff + m * 2048 + k * 1024); } while (0)
#define PG8_LDB(dst, b, h) do { _Pragma("unroll") for (int n = 0; n < 2; ++n) _Pragma("unroll") for (int k = 0; k < 2; ++k) dst[n][k] = *(const PG8_LAS bf16x8*)(lds + PG8_SB(b, h) + boff + n * 2048 + k * 1024); } while (0)
#define PG8_MMA(ai, bj, At, Bt) do { __builtin_amdgcn_s_setprio(1); _Pragma("unroll") for (int m = 0; m < 4; ++m) _Pragma("unroll") for (int n = 0; n < 2; ++n) _Pragma("unroll") for (int k = 0; k < 2; ++k) \
        acc[ai][bj][m][n] = __builtin_amdgcn_mfma_f32_16x16x32_bf16(Bt[n][k], At[m][k], acc[ai][bj][m][n], 0, 0, 0); __builtin_amdgcn_s_setprio(0); } while (0)
#define PG8_WAIT_V(n) asm volatile("s_waitcnt vmcnt(" #n ")" ::: "memory")
#define PG8_WAIT_L(n) asm volatile("s_waitcnt lgkmcnt(" #n ")" ::: "memory")
#define PG8_BAR __builtin_amdgcn_s_barrier()
#define PG8_SCHED __builtin_amdgcn_sched_barrier(0)
#ifdef PROBE_G
    long long tepi_ = 0; const long long tg0_ = clock64();
#endif
    Unit cur, nxt; int ui = 0;
    if (!S.next(0, cur)) return;
    cur.ui = 0;
    f32x4 acc[2][2][4][2];
#pragma unroll
    for (int a = 0; a < 2; ++a)
#pragma unroll
        for (int b = 0; b < 2; ++b)
#pragma unroll
            for (int m = 0; m < 4; ++m)
#pragma unroll
                for (int n = 0; n < 2; ++n) acc[a][b][m][n] = (f32x4){0.f, 0.f, 0.f, 0.f};
    bf16x8 At[4][2], B0[2][2], B1[2][2];
    const char* cA = (const char*)g.A + (size_t)cur.pm * tstep; const char* cB = (const char*)g.Bt + (size_t)cur.pn * tstep;
    S.a_ready(cur);
    if constexpr (SP2) {
        PG8_STAGE(PG8_SB(0, 0), cB, voffB); PG8_STAGE(PG8_SB(0, 1), cB + hstep, voffB); PG8_STAGE(PG8_SA(0, 0), cA, voffA); PG8_STAGE(PG8_SA(0, 1), cA + hstep, voffA);
        if (wr == 1) PG8_BAR;
        PG8_WAIT_V(2); PG8_BAR;
        PG8_STAGE(PG8_SB(1, 0), cB + kstep, voffB); PG8_STAGE(PG8_SA(1, 0), cA + kstep, voffA); PG8_STAGE(PG8_SB(1, 1), cB + hstep + kstep, voffB);
        PG8_WAIT_V(6); PG8_BAR;
    } else {
        PG8_STAGE(PG8_SB(0, 0), cB, voffB); PG8_STAGE(PG8_SA(0, 0), cA, voffA); PG8_STAGE(PG8_SB(0, 1), cB + hstep, voffB); PG8_STAGE(PG8_SA(0, 1), cA + hstep, voffA);
        if (wr == 1) PG8_BAR;
        PG8_WAIT_V(4); PG8_BAR;
        PG8_STAGE(PG8_SB(1, 0), cB + kstep, voffB); PG8_STAGE(PG8_SA(1, 0), cA + kstep, voffA); PG8_STAGE(PG8_SB(1, 1), cB + hstep + kstep, voffB);
        PG8_WAIT_V(6); PG8_BAR;
    }
    for (;;) {
        const bool has_next = S.next(ui + 1, nxt); nxt.ui = ui + 1;
        const char* nA = has_next ? (const char*)g.A + (size_t)nxt.pm * tstep : cA; const char* nB = has_next ? (const char*)g.Bt + (size_t)nxt.pn * tstep : cB;
        for (int t = 0; t < nt; t += 2) {
            if constexpr (Epi::KSCALE) { if (t == 0) E.kbegin(cur, tid); else if ((t & 7) == 0) E.krescale(acc, cur, t >> 3, wr, fr); }
            const bool last = (t == nt - 2);
            const char* a1 = cA + (size_t)(t + 1) * kstep;
            const char* a2 = last ? nA : cA + (size_t)(t + 2) * kstep; const char* b2 = last ? nB : cB + (size_t)(t + 2) * kstep;
            const char* a3 = a2 + kstep; const char* b3 = b2 + kstep;
            if (last && has_next) S.a_ready(nxt);
            if constexpr (SP2) {
            PG8_LDB(B0, 0, 0); PG8_LDB(B1, 0, 1); PG8_SCHED; PG8_LDA(At, 0, 0); PG8_STAGE(PG8_SA(1, 1), a1 + hstep, voffA);
            PG8_WAIT_V(8); PG8_WAIT_L(0); PG8_BAR; PG8_MMA(0, 0, At, B0); PG8_MMA(0, 1, At, B1); PG8_BAR; PG8_SCHED;
            PG8_LDA(At, 0, 1); PG8_STAGE(PG8_SB(0, 0), b2, voffB); PG8_STAGE(PG8_SB(0, 1), b2 + hstep, voffB); PG8_STAGE(PG8_SA(0, 0), a2, voffA);
            PG8_WAIT_V(8); PG8_WAIT_L(0); PG8_BAR; PG8_MMA(1, 0, At, B0); PG8_MMA(1, 1, At, B1); PG8_BAR; PG8_SCHED;
            PG8_LDB(B0, 1, 0); PG8_LDB(B1, 1, 1); PG8_SCHED; PG8_LDA(At, 1, 0); PG8_STAGE(PG8_SA(0, 1), a2 + hstep, voffA);
            PG8_WAIT_V(8); PG8_WAIT_L(0); PG8_BAR; PG8_MMA(0, 0, At, B0); PG8_MMA(0, 1, At, B1); PG8_BAR; PG8_SCHED;
            PG8_LDA(At, 1, 1); PG8_STAGE(PG8_SB(1, 0), b3, voffB); PG8_STAGE(PG8_SB(1, 1), b3 + hstep, voffB); PG8_STAGE(PG8_SA(1, 0), a3, voffA);
            PG8_WAIT_V(8); PG8_WAIT_L(0); PG8_BAR; PG8_MMA(1, 0, At, B0); PG8_MMA(1, 1, At, B1); PG8_BAR; PG8_SCHED;
            } else {
            PG8_LDB(B0, 0, 0); PG8_SCHED; PG8_LDA(At, 0, 0); PG8_STAGE(PG8_SA(1, 1), a1 + hstep, voffA);
            PG8_WAIT_L(8); PG8_BAR; PG8_WAIT_L(0); PG8_MMA(0, 0, At, B0); PG8_BAR; PG8_SCHED;
            PG8_LDB(B1, 0, 1); PG8_STAGE(PG8_SB(0, 0), b2, voffB);
            PG8_BAR; PG8_WAIT_L(0); PG8_MMA(0, 1, At, B1); PG8_BAR;
            PG8_LDA(At, 0, 1); PG8_STAGE(PG8_SA(0, 0), a2, voffA);
            PG8_BAR; PG8_WAIT_L(0); PG8_MMA(1, 0, At, B0); PG8_BAR; PG8_SCHED;
            PG8_STAGE(PG8_SB(0, 1), b2 + hstep, voffB);
            PG8_WAIT_V(6); PG8_BAR; PG8_MMA(1, 1, At, B1); PG8_BAR;
            PG8_LDB(B0, 1, 0); PG8_SCHED; PG8_LDA(At, 1, 0); PG8_STAGE(PG8_SA(0, 1), a2 + hstep, voffA);
            PG8_WAIT_L(8); PG8_BAR; PG8_WAIT_L(0); PG8_MMA(0, 0, At, B0); PG8_BAR; PG8_SCHED;
            PG8_LDB(B1, 1, 1); PG8_STAGE(PG8_SB(1, 0), b3, voffB);
            PG8_BAR; PG8_WAIT_L(0); PG8_MMA(0, 1, At, B1); PG8_BAR;
            PG8_LDA(At, 1, 1); PG8_STAGE(PG8_SA(1, 0), a3, voffA);
            PG8_BAR; PG8_WAIT_L(0); PG8_MMA(1, 0, At, B0); PG8_BAR; PG8_SCHED;
            PG8_STAGE(PG8_SB(1, 1), b3 + hstep, voffB);
            PG8_WAIT_V(6); PG8_BAR; PG8_MMA(1, 1, At, B1); PG8_BAR;
            }
        }
        if constexpr (ALIGN_EPI) { if (wr == 0) PG8_BAR; }
#ifdef PROBE_G
        const long long te0_ = clock64();
#endif
        if constexpr (!Epi::AFTER_DRAIN) { E(acc, cur, wr, wc, fr, fq); S.done(cur); }
#ifdef PROBE_G
        tepi_ += clock64() - te0_;
#endif
        if (!has_next) break;
#pragma unroll
        for (int a = 0; a < 2; ++a)
#pragma unroll
            for (int b = 0; b < 2; ++b)
#pragma unroll
                for (int m = 0; m < 4; ++m)
#pragma unroll
                    for (int n = 0; n < 2; ++n) acc[a][b][m][n] = (f32x4){0.f, 0.f, 0.f, 0.f};
        cur = nxt; cA = nA; cB = nB; ++ui;
        if constexpr (ALIGN_EPI) { if (wr == 1) PG8_BAR; }
    }
    PG8_WAIT_V(0);
    if constexpr (!ALIGN_EPI) { if (wr == 0) PG8_BAR; }
    PG8_BAR;
    if constexpr (Epi::AFTER_DRAIN) { E.fused(acc, cur, wr, wc, fr, fq, lds, wid, lane); S.done(cur); }
#ifdef PROBE_G
    if (Epi::PROBE_ID == PROBE_G && blockIdx.x == 0 && tid == 0) *probe_slot_ = (float)tepi_ / (float)(clock64() - tg0_);
#endif
#undef PG8_SA
#undef PG8_SB
#undef PG8_STAGE
#undef PG8_LDA
#undef PG8_LDB
#undef PG8_MMA
#undef PG8_WAIT_V
#undef PG8_WAIT_L
#undef PG8_BAR
#undef PG8_SCHED
}
}

namespace pg8 {
typedef unsigned u32x2 __attribute__((ext_vector_type(2)));
__device__ __forceinline__ u32x4 pack8(const f32x4& v0, const f32x4& v1) {
    u32x4 w; w.x = cvt_pk_bf16(v0[0], v0[1]); w.y = cvt_pk_bf16(v0[2], v0[3]); w.z = cvt_pk_bf16(v1[0], v1[1]); w.w = cvt_pk_bf16(v1[2], v1[3]); return w;
}
struct EpiIn {
    static constexpr int PROBE_ID = 1;
    static constexpr bool PERM = true, AFTER_DRAIN = false, KSCALE = false;
    bf16_t* Z; bf16_t* XBC; float* DT; const float* rstd;
    __device__ __forceinline__ void operator()(const f32x4 (&acc)[2][2][4][2], const Unit& u, int wr, int wc, int fr, int fq) const {
        const int row0 = u.pm * BM + wr * 64 + fr, c8 = wc * 32 + 8 * fq;
        float rsv[2][4];
#pragma unroll
        for (int ai = 0; ai < 2; ++ai)
#pragma unroll
            for (int m = 0; m < 4; ++m) rsv[ai][m] = rstd[row0 + ai * HALF + m * 16];
        asm volatile("" : "+v"(rsv[0][0]), "+v"(rsv[0][1]), "+v"(rsv[0][2]), "+v"(rsv[0][3]), "+v"(rsv[1][0]), "+v"(rsv[1][1]), "+v"(rsv[1][2]), "+v"(rsv[1][3]));
#pragma unroll
        for (int ai = 0; ai < 2; ++ai)
#pragma unroll
            for (int m = 0; m < 4; ++m) {
                const int row = row0 + ai * HALF + m * 16; const float rs = 1.f / sqrtf(rsv[ai][m] * (1.f / 1024.f) + 1e-6f);
#pragma unroll
                for (int bj = 0; bj < 2; ++bj) {
                    const f32x4 v0 = acc[ai][bj][m][0] * rs, v1 = acc[ai][bj][m][1] * rs;
                    if (u.pn < 8) *(u32x4*)(Z + (size_t)row * 2048 + u.pn * 256 + bj * HALF + c8) = pack8(v0, v1);
                    else if (u.pn < 20) *(u32x4*)(XBC + (size_t)row * 3072 + (u.pn - 8) * 256 + bj * HALF + c8) = pack8(v0, v1);
                    else if (bj == 0 && wc == 0) { float* d = DT + (size_t)row * 32 + 8 * fq; *(f32x4*)d = v0; *(f32x4*)(d + 4) = v1; }
                }
            }
    }
};
struct EpiRes {
    static constexpr int PROBE_ID = 2;
    static constexpr bool PERM = true, AFTER_DRAIN = false, KSCALE = true;
    const float* basef; const bf16_t* baseb; float* outf; bf16_t* xb; float* ss; const float* probe; const float* gss; PG8_LAS float* gtab;
    __device__ __forceinline__ void kbegin(const Unit& u, int tid) const {
        if (!gss) return;
        tid = opaque_tid();
        const int row = tid & 255, gh = tid >> 8;
        const float* gp = gss + (size_t)(((u.pm >> 3) * 4 + 2 * gh) * 4) * 2048 + (u.pm & 7) * 256 + row;
#pragma unroll
        for (int gi = 0; gi < 2; ++gi) { const float s = (gp[(gi * 4 + 0) * 2048] + gp[(gi * 4 + 1) * 2048]) + (gp[(gi * 4 + 2) * 2048] + gp[(gi * 4 + 3) * 2048]);
            const float v = s * (1.f / 512.f) + 1e-6f;
            PG8_LAS float* tp = gtab + (((u.ui & 1) * 4 + 2 * gh + gi) * 256 + row) * 2;
            tp[0] = __builtin_amdgcn_sqrtf(v); tp[1] = __builtin_amdgcn_rsqf(v); }
    }
    __device__ __forceinline__ void krescale(f32x4 (&acc)[2][2][4][2], const Unit& u, int g, int wr, int fr) const {
        if (!gss) return;
        const PG8_LAS float* tp = gtab + (((u.ui & 1) * 4 + g) * 256 + wr * 64 + fr) * 2;
#pragma unroll
        for (int ai = 0; ai < 2; ++ai)
#pragma unroll
            for (int m = 0; m < 4; ++m) { const float ratio = tp[(ai * HALF + m * 16) * 2] * tp[(ai * HALF + m * 16) * 2 - 511];
#pragma unroll
                for (int bj = 0; bj < 2; ++bj)
#pragma unroll
                    for (int n = 0; n < 2; ++n) acc[ai][bj][m][n] *= ratio; }
    }
    __device__ __forceinline__ void ldbase(size_t off, f32x4& lo, f32x4& hi) const {
        if (basef) { lo = *(const f32x4*)(basef + off); hi = *(const f32x4*)(basef + off + 4); return; }
        const u32x4 w = *(const u32x4*)(baseb + off);
        lo = (f32x4){__builtin_bit_cast(float, w.x << 16), __builtin_bit_cast(float, w.x & 0xffff0000u), __builtin_bit_cast(float, w.y << 16), __builtin_bit_cast(float, w.y & 0xffff0000u)};
        hi = (f32x4){__builtin_bit_cast(float, w.z << 16), __builtin_bit_cast(float, w.z & 0xffff0000u), __builtin_bit_cast(float, w.w << 16), __builtin_bit_cast(float, w.w & 0xffff0000u)};
    }
    __device__ __forceinline__ void operator()(const f32x4 (&acc)[2][2][4][2], const Unit& u, int wr, int wc, int fr, int fq) const {
        const int row0 = u.pm * BM + wr * 64 + fr, col0 = u.pn * BM + wc * 32 + 8 * fq;
        f32x4 bs[3][2][2];
#pragma unroll
        for (int q = 0; q < 2; ++q)
#pragma unroll
            for (int bj = 0; bj < 2; ++bj) ldbase((size_t)(row0 + q * 16) * 1024 + col0 + bj * HALF, bs[q][bj][0], bs[q][bj][1]);
#pragma unroll
        for (int gi = 0; gi < 8; ++gi) {
            const int ai = gi >> 2, m = gi & 3;
            const size_t off = (size_t)(row0 + ai * HALF + m * 16) * 1024 + col0;
            if (gi < 6) { const size_t offn = (size_t)(row0 + ((gi + 2) >> 2) * HALF + ((gi + 2) & 3) * 16) * 1024 + col0;
#pragma unroll
                for (int bj = 0; bj < 2; ++bj) ldbase(offn + bj * HALF, bs[(gi + 2) % 3][bj][0], bs[(gi + 2) % 3][bj][1]); }
            float s = 0.f;
            const float r3 = gss ? gtab[(((u.ui & 1) * 4 + 3) * 256 + wr * 64 + fr + ai * HALF + m * 16) * 2 + 1] : 1.f;
#pragma unroll
            for (int bj = 0; bj < 2; ++bj) {
                f32x4 o0 = bs[gi % 3][bj][0] + acc[ai][bj][m][0] * r3, o1 = bs[gi % 3][bj][1] + acc[ai][bj][m][1] * r3;
#ifdef PROBE_T
                if (probe && gi == 0 && bj == 0 && row0 == 0 && col0 == 0) o0[0] += 0.08f + 0.2f * probe[0];
#endif
                if (outf) { *(f32x4*)(outf + off + bj * HALF) = o0; *(f32x4*)(outf + off + bj * HALF + 4) = o1; }
                if (xb) { u32x4 w; w.x = cvt_pk_bf16(o0[0], o0[1]); w.y = cvt_pk_bf16(o0[2], o0[3]); w.z = cvt_pk_bf16(o1[0], o1[1]); w.w = cvt_pk_bf16(o1[2], o1[3]); *(u32x4*)(xb + off + bj * HALF) = w; }
                s += ((o0[0] * o0[0] + o0[1] * o0[1]) + (o0[2] * o0[2] + o0[3] * o0[3])) + ((o1[0] * o1[0] + o1[1] * o1[1]) + (o1[2] * o1[2] + o1[3] * o1[3])); }
            if (ss) { s += __shfl_xor(s, 16); s += __shfl_xor(s, 32); if (fq == 0) atomicAdd(ss + row0 + ai * HALF + m * 16, s); }
            asm volatile("" ::: "memory");
        }
    }
};
struct EpiScale {
    static constexpr int PROBE_ID = 3;
    static constexpr bool PERM = true, AFTER_DRAIN = false, KSCALE = false;
    bf16_t* O; int ldc; const float* rstd;
    __device__ __forceinline__ void operator()(const f32x4 (&acc)[2][2][4][2], const Unit& u, int wr, int wc, int fr, int fq) const {
        const int row0 = u.pm * BM + wr * 64 + fr, c8 = u.pn * BM + wc * 32 + 8 * fq;
#pragma unroll
        for (int ai = 0; ai < 2; ++ai)
#pragma unroll
            for (int m = 0; m < 4; ++m) {
                const int row = row0 + ai * HALF + m * 16; const float rs = 1.f / sqrtf(rstd[row] * (1.f / 1024.f) + 1e-6f);
#pragma unroll
                for (int bj = 0; bj < 2; ++bj) *(u32x4*)(O + (size_t)row * ldc + bj * HALF + c8) = pack8(acc[ai][bj][m][0] * rs, acc[ai][bj][m][1] * rs);
            }
    }
};
struct EpiKVQ {
    static constexpr int PROBE_ID = 4;
    static constexpr bool PERM = true, AFTER_DRAIN = false, KSCALE = false;
    bf16_t* Kb; size_t tstride; const float* rstd; const float* kg; const float* qg; float qscale;
    __device__ __forceinline__ void operator()(const f32x4 (&acc)[2][2][4][2], const Unit& u, int wr, int wc, int fr, int fq) const {
        const int row0 = u.pm * BM + wr * 64 + fr, t = u.pn >> 2;
        bf16_t* base = Kb + (size_t)t * tstride + (u.pn & 3) * BM + 64 * wc + 8 * fq;
        f32x4 g[2][2];
        const float* gp = (t == 2) ? qg : kg; const float sc = (t == 2) ? qscale : 1.f;
#pragma unroll
        for (int bj = 0; bj < 2; ++bj)
#pragma unroll
            for (int n = 0; n < 2; ++n) g[bj][n] = (t == 1) ? (f32x4){1.f, 1.f, 1.f, 1.f} : *(const f32x4*)(gp + 32 * bj + 8 * fq + 4 * n) * sc;
        float rsv[2][4];
#pragma unroll
        for (int ai = 0; ai < 2; ++ai)
#pragma unroll
            for (int m = 0; m < 4; ++m) rsv[ai][m] = rstd[row0 + ai * HALF + m * 16];
        asm volatile("" : "+v"(rsv[0][0]), "+v"(rsv[0][1]), "+v"(rsv[0][2]), "+v"(rsv[0][3]), "+v"(rsv[1][0]), "+v"(rsv[1][1]), "+v"(rsv[1][2]), "+v"(rsv[1][3]));
#pragma unroll
        for (int ai = 0; ai < 2; ++ai)
#pragma unroll
            for (int m = 0; m < 4; ++m) {
                const int row = row0 + ai * HALF + m * 16; const float rs = 1.f / sqrtf(rsv[ai][m] * (1.f / 1024.f) + 1e-6f);
                f32x4 v[2][2]; float s = 0.f;
#pragma unroll
                for (int bj = 0; bj < 2; ++bj)
#pragma unroll
                    for (int n = 0; n < 2; ++n) { v[bj][n] = acc[ai][bj][m][n] * rs; s += (v[bj][n][0] * v[bj][n][0] + v[bj][n][1] * v[bj][n][1]) + (v[bj][n][2] * v[bj][n][2] + v[bj][n][3] * v[bj][n][3]); }
                s += __shfl_xor(s, 16); s += __shfl_xor(s, 32);
                const float rq = (t == 1) ? 1.f : 1.f / sqrtf(s * (1.f / 64.f) + 1e-6f);
#pragma unroll
                for (int bj = 0; bj < 2; ++bj) *(u32x4*)(base + (size_t)row * 1024 + 32 * bj) = pack8(v[bj][0] * rq * g[bj][0], v[bj][1] * rq * g[bj][1]);
            }
    }
};

struct EpiConvFFN {
    static constexpr int PROBE_ID = 5;
    static constexpr bool PERM = true, AFTER_DRAIN = false, KSCALE = false;
    bf16_t* H; bf16_t* raw; const float* ss; const float* cw; const float* cb; PG8_LAS unsigned char* xl;
    static constexpr int RP = 144, SLAB = 18 * RP, HALO_OFF = 8 * SLAB;
    __device__ __forceinline__ void operator()(const f32x4 (&acc)[2][2][4][2], const Unit& u, int wr, int wc, int fr, int fq) const {
        const int lane = fr + 16 * fq, c = lane & 31, hf = lane >> 5, c2 = lane & 15, hq = lane >> 4, wid = wr * 4 + wc;
        PG8_LAS unsigned char* slab = xl + wid * SLAB;
        PG8_LAS unsigned char* halo = xl + HALO_OFF;
        const int chg = 128 * u.pn + 32 * wc + 2 * c2;
        typedef float f32x2v __attribute__((ext_vector_type(2)));
        const f32x2v wg0 = *(const f32x2v*)(cw + chg), wg1 = *(const f32x2v*)(cw + 5632 + chg), wg2 = *(const f32x2v*)(cw + 2 * 5632 + chg), bg = *(const f32x2v*)(cb + chg);
        const f32x2v wu0 = *(const f32x2v*)(cw + 2816 + chg), wu1 = *(const f32x2v*)(cw + 5632 + 2816 + chg), wu2 = *(const f32x2v*)(cw + 2 * 5632 + 2816 + chg), bu = *(const f32x2v*)(cb + 2816 + chg);
        const int row0 = u.pm * BM + wr * 64 + fr;
        float rsv[2][4];
#pragma unroll
        for (int ai = 0; ai < 2; ++ai)
#pragma unroll
            for (int m = 0; m < 4; ++m) rsv[ai][m] = ss[row0 + ai * HALF + m * 16];
#pragma unroll
        for (int ai = 0; ai < 2; ++ai)
#pragma unroll
            for (int m = 0; m < 4; ++m) rsv[ai][m] = 1.f / sqrtf(rsv[ai][m] * (1.f / 1024.f) + 1e-6f);
        bf16_t* rawp = raw + ((size_t)u.pm * 4 * 22 + u.pn) * 256 + wc * 64 + 8 * fq;
#pragma unroll
        for (int ai = 0; ai < 2; ++ai) {
            if (fr >= 14) {
                const float rs = rsv[ai][3];
                const int bi = 2 * ai + wr;
#pragma unroll
                for (int bj = 0; bj < 2; ++bj) { u32x4 w; { const f32x4 v0 = acc[ai][bj][3][0] * rs, v1 = acc[ai][bj][3][1] * rs; w.x = cvt_pk_bf16(v0[0], v0[1]); w.y = cvt_pk_bf16(v0[2], v0[3]); w.z = cvt_pk_bf16(v1[0], v1[1]); w.w = cvt_pk_bf16(v1[2], v1[3]); }
                        if (bi < 3) *(PG8_LAS u32x4*)(halo + ((bi * 2 + (fr - 14)) * 256 + wc * 64 + bj * 32 + 8 * fq) * 2) = w;
                        else *(u32x4*)(rawp + (size_t)(2 + fr - 14) * 22 * 256 + bj * 32) = w; }
            }
        }
        if (wr == 0 && fr < 2) {
            const float rs = rsv[0][0];
#pragma unroll
            for (int bj = 0; bj < 2; ++bj) { u32x4 w; { const f32x4 v0 = acc[0][bj][0][0] * rs, v1 = acc[0][bj][0][1] * rs; w.x = cvt_pk_bf16(v0[0], v0[1]); w.y = cvt_pk_bf16(v0[2], v0[3]); w.z = cvt_pk_bf16(v1[0], v1[1]); w.w = cvt_pk_bf16(v1[2], v1[3]); }
                    *(u32x4*)(rawp + (size_t)fr * 22 * 256 + bj * 32) = w; }
        }
        asm volatile("s_waitcnt lgkmcnt(0)" ::: "memory"); __builtin_amdgcn_s_barrier(); asm volatile("" ::: "memory");
#pragma unroll
        for (int ai = 0; ai < 2; ++ai) {
            const int bi = 2 * ai + wr;
            { unsigned hv = 0u; if (bi > 0) hv = *(const PG8_LAS unsigned*)(halo + (((bi - 1) * 2 + hf) * 256 + wc * 64 + 2 * c) * 2);
              *(PG8_LAS unsigned*)(slab + hf * RP + 4 * c) = hv; }
#pragma unroll
            for (int m = 0; m < 4; ++m) {
                const float rs = rsv[ai][m];
#pragma unroll
                for (int bj = 0; bj < 2; ++bj) { u32x4 w; { const f32x4 v0 = acc[ai][bj][m][0] * rs, v1 = acc[ai][bj][m][1] * rs; w.x = cvt_pk_bf16(v0[0], v0[1]); w.y = cvt_pk_bf16(v0[2], v0[3]); w.z = cvt_pk_bf16(v1[0], v1[1]); w.w = cvt_pk_bf16(v1[2], v1[3]); }
                        *(PG8_LAS u32x4*)(slab + (2 + fr) * RP + (bj * 32 + 8 * fq) * 2) = w; }
                asm volatile("s_waitcnt lgkmcnt(0)" ::: "memory");
                unsigned gw[6], uw[6];
#pragma unroll
                for (int i = 0; i < 6; ++i) { const PG8_LAS unsigned char* rp = slab + (4 * hq + i) * RP + 4 * c2; gw[i] = *(const PG8_LAS unsigned*)rp; uw[i] = *(const PG8_LAS unsigned*)(rp + 64); }
                asm volatile("s_waitcnt lgkmcnt(0)" ::: "memory");
                if (hq == 3) {
#pragma unroll
                    for (int i = 0; i < 2; ++i) { *(PG8_LAS unsigned*)(slab + i * RP + 4 * c2) = gw[4 + i]; *(PG8_LAS unsigned*)(slab + i * RP + 64 + 4 * c2) = uw[4 + i]; }
                }
#define CF_LO(w_) __builtin_bit_cast(float, (w_) << 16)
#define CF_HI(w_) __builtin_bit_cast(float, (w_) & 0xffff0000u)
#pragma unroll
                for (int i = 0; i < 4; ++i) {
                    const float cg0 = bg.x + wg0.x * CF_LO(gw[i]) + wg1.x * CF_LO(gw[i + 1]) + wg2.x * CF_LO(gw[i + 2]), cg1 = bg.y + wg0.y * CF_HI(gw[i]) + wg1.y * CF_HI(gw[i + 1]) + wg2.y * CF_HI(gw[i + 2]);
                    const float cu0 = bu.x + wu0.x * CF_LO(uw[i]) + wu1.x * CF_LO(uw[i + 1]) + wu2.x * CF_LO(uw[i + 2]), cu1 = bu.y + wu0.y * CF_HI(uw[i]) + wu1.y * CF_HI(uw[i + 1]) + wu2.y * CF_HI(uw[i + 2]);
                    const float h0 = cg0 * __builtin_amdgcn_rcpf(1.f + __builtin_amdgcn_exp2f(cg0 * -1.4426950408889634f)) * cu0;
                    const float h1 = cg1 * __builtin_amdgcn_rcpf(1.f + __builtin_amdgcn_exp2f(cg1 * -1.4426950408889634f)) * cu1;
                    *(PG8_LAS unsigned*)(slab + (2 + 4 * hq + i) * RP + 4 * c2) = cvt_pk_bf16(h0, h1);
                }
#undef CF_LO
#undef CF_HI
                asm volatile("s_waitcnt lgkmcnt(0)" ::: "memory");
                { const int row = lane >> 2, c8 = (lane & 3) * 8;
                  const u32x4 w = *(const PG8_LAS u32x4*)(slab + (2 + row) * RP + c8 * 2);
                  *(u32x4*)(H + (size_t)(u.pm * BM + 64 * bi + 16 * m + row) * 2816 + 128 * u.pn + 32 * wc + c8) = w; }
                asm volatile("s_waitcnt lgkmcnt(0)" ::: "memory");
            }
        }
    }
};

struct EpiInConv {
    static constexpr int PROBE_ID = 1;
    static constexpr bool PERM = true, AFTER_DRAIN = false, KSCALE = false;
    bf16_t* Z; bf16_t* XBC; float* DT; const float* ss; bf16_t* raw; const float* cw; const float* cb; PG8_LAS unsigned char* xl;
    static constexpr int RP = 144, SLAB = 19 * RP, HALO_OFF = 8 * SLAB;
    __device__ __forceinline__ void operator()(const f32x4 (&acc)[2][2][4][2], const Unit& u, int wr, int wc, int fr, int fq) const {
        const int row0 = u.pm * BM + wr * 64 + fr;
        float rsv[2][4];
#pragma unroll
        for (int ai = 0; ai < 2; ++ai)
#pragma unroll
            for (int m = 0; m < 4; ++m) rsv[ai][m] = ss[row0 + ai * HALF + m * 16];
        asm volatile("" : "+v"(rsv[0][0]), "+v"(rsv[0][1]), "+v"(rsv[0][2]), "+v"(rsv[0][3]), "+v"(rsv[1][0]), "+v"(rsv[1][1]), "+v"(rsv[1][2]), "+v"(rsv[1][3]));
#pragma unroll
        for (int ai = 0; ai < 2; ++ai)
#pragma unroll
            for (int m = 0; m < 4; ++m) rsv[ai][m] = 1.f / sqrtf(rsv[ai][m] * (1.f / 1024.f) + 1e-6f);
        if (u.pn < 8) {
#pragma unroll
            for (int ai = 0; ai < 2; ++ai)
#pragma unroll
                for (int m = 0; m < 4; ++m) { bf16_t* zp = Z + (size_t)(row0 + ai * HALF + m * 16) * 2048 + u.pn * 256 + wc * 32 + 8 * fq; const float rs = rsv[ai][m];
#pragma unroll
                    for (int bj = 0; bj < 2; ++bj) { u32x4 w; { const f32x4 v0 = acc[ai][bj][m][0] * rs, v1 = acc[ai][bj][m][1] * rs; w.x = cvt_pk_bf16(v0[0], v0[1]); w.y = cvt_pk_bf16(v0[2], v0[3]); w.z = cvt_pk_bf16(v1[0], v1[1]); w.w = cvt_pk_bf16(v1[2], v1[3]); } *(u32x4*)(zp + bj * HALF) = w; } }
            return;
        }
        if (u.pn == 20) {
            if (wc == 0) {
#pragma unroll
                for (int ai = 0; ai < 2; ++ai)
#pragma unroll
                    for (int m = 0; m < 4; ++m)
#pragma unroll
                        for (int n = 0; n < 2; ++n) *(f32x4*)(DT + (size_t)(row0 + ai * HALF + m * 16) * 32 + 8 * fq + 4 * n) = acc[ai][0][m][n] * rsv[ai][m];
            }
            return;
        }
        const int up = u.pn - 8, lane = fr + 16 * fq, c = lane & 31, c2 = lane & 15, hq = lane >> 4, wid = wr * 4 + wc;
        PG8_LAS unsigned char* slab = xl + wid * SLAB;
        PG8_LAS unsigned char* halo = xl + HALO_OFF;
        typedef float f32x2v __attribute__((ext_vector_type(2)));
        const int colA = up * 256 + 32 * wc + 2 * c2, colB = colA + 128;
        f32x2v wA[4], wB[4];
#pragma unroll
        for (int k = 0; k < 4; ++k) { wA[k] = *(const f32x2v*)(cw + k * 3072 + colA); wB[k] = *(const f32x2v*)(cw + k * 3072 + colB); }
        const f32x2v bA = *(const f32x2v*)(cb + colA), bB = *(const f32x2v*)(cb + colB);
        bf16_t* rawp = raw + ((size_t)u.pm * 6 * 12 + up) * 256 + wc * 64 + 8 * fq;
#pragma unroll
        for (int ai = 0; ai < 2; ++ai) {
            if (fr >= 13) {
                const float rs = rsv[ai][3]; const int bi = 2 * ai + wr;
#pragma unroll
                for (int bj = 0; bj < 2; ++bj) { u32x4 w; { const f32x4 v0 = acc[ai][bj][3][0] * rs, v1 = acc[ai][bj][3][1] * rs; w.x = cvt_pk_bf16(v0[0], v0[1]); w.y = cvt_pk_bf16(v0[2], v0[3]); w.z = cvt_pk_bf16(v1[0], v1[1]); w.w = cvt_pk_bf16(v1[2], v1[3]); }
                        if (bi < 3) *(PG8_LAS u32x4*)(halo + ((bi * 3 + (fr - 13)) * 256 + wc * 64 + bj * 32 + 8 * fq) * 2) = w;
                        else *(u32x4*)(rawp + (size_t)(3 + fr - 13) * 12 * 256 + bj * 32) = w; }
            }
        }
        if (wr == 0 && fr < 3) {
            const float rs = rsv[0][0];
#pragma unroll
            for (int bj = 0; bj < 2; ++bj) { u32x4 w; { const f32x4 v0 = acc[0][bj][0][0] * rs, v1 = acc[0][bj][0][1] * rs; w.x = cvt_pk_bf16(v0[0], v0[1]); w.y = cvt_pk_bf16(v0[2], v0[3]); w.z = cvt_pk_bf16(v1[0], v1[1]); w.w = cvt_pk_bf16(v1[2], v1[3]); }
                    *(u32x4*)(rawp + (size_t)fr * 12 * 256 + bj * 32) = w; }
        }
        asm volatile("s_waitcnt lgkmcnt(0)" ::: "memory"); __builtin_amdgcn_s_barrier(); asm volatile("" ::: "memory");
#define CF_LO(w_) __builtin_bit_cast(float, (w_) << 16)
#define CF_HI(w_) __builtin_bit_cast(float, (w_) & 0xffff0000u)
#pragma unroll
        for (int ai = 0; ai < 2; ++ai) {
            const int bi = 2 * ai + wr;
            { unsigned h0 = 0u, h1 = 0u;
              if (bi > 0) { h0 = *(const PG8_LAS unsigned*)(halo + (((bi - 1) * 3 + (lane >> 5)) * 256 + wc * 64 + 2 * c) * 2); if (lane < 32) h1 = *(const PG8_LAS unsigned*)(halo + (((bi - 1) * 3 + 2) * 256 + wc * 64 + 2 * c) * 2); }
              *(PG8_LAS unsigned*)(slab + (lane >> 5) * RP + 4 * c) = h0; if (lane < 32) *(PG8_LAS unsigned*)(slab + 2 * RP + 4 * c) = h1; }
#pragma unroll
            for (int m = 0; m < 4; ++m) {
                const float rs = rsv[ai][m];
#pragma unroll
                for (int bj = 0; bj < 2; ++bj) { u32x4 w; { const f32x4 v0 = acc[ai][bj][m][0] * rs, v1 = acc[ai][bj][m][1] * rs; w.x = cvt_pk_bf16(v0[0], v0[1]); w.y = cvt_pk_bf16(v0[2], v0[3]); w.z = cvt_pk_bf16(v1[0], v1[1]); w.w = cvt_pk_bf16(v1[2], v1[3]); }
                        *(PG8_LAS u32x4*)(slab + (3 + fr) * RP + (bj * 32 + 8 * fq) * 2) = w; }
                asm volatile("s_waitcnt lgkmcnt(0)" ::: "memory");
                unsigned aw[7], bw[7];
#pragma unroll
                for (int i = 0; i < 7; ++i) { const PG8_LAS unsigned char* rp = slab + (4 * hq + i) * RP + 4 * c2; aw[i] = *(const PG8_LAS unsigned*)rp; bw[i] = *(const PG8_LAS unsigned*)(rp + 64); }
                asm volatile("s_waitcnt lgkmcnt(0)" ::: "memory");
                if (hq == 3) {
#pragma unroll
                    for (int i = 0; i < 3; ++i) { *(PG8_LAS unsigned*)(slab + i * RP + 4 * c2) = aw[4 + i]; *(PG8_LAS unsigned*)(slab + i * RP + 64 + 4 * c2) = bw[4 + i]; }
                }
#pragma unroll
                for (int i = 0; i < 4; ++i) {
                    const float a0 = bA.x + wA[0].x * CF_LO(aw[i]) + wA[1].x * CF_LO(aw[i + 1]) + wA[2].x * CF_LO(aw[i + 2]) + wA[3].x * CF_LO(aw[i + 3]);
                    const float a1 = bA.y + wA[0].y * CF_HI(aw[i]) + wA[1].y * CF_HI(aw[i + 1]) + wA[2].y * CF_HI(aw[i + 2]) + wA[3].y * CF_HI(aw[i + 3]);
                    const float b0 = bB.x + wB[0].x * CF_LO(bw[i]) + wB[1].x * CF_LO(bw[i + 1]) + wB[2].x * CF_LO(bw[i + 2]) + wB[3].x * CF_LO(bw[i + 3]);
                    const float b1 = bB.y + wB[0].y * CF_HI(bw[i]) + wB[1].y * CF_HI(bw[i + 1]) + wB[2].y * CF_HI(bw[i + 2]) + wB[3].y * CF_HI(bw[i + 3]);
#define CF_SILU(v_) ((v_) * __builtin_amdgcn_rcpf(1.f + __builtin_amdgcn_exp2f((v_) * -1.4426950408889634f)))
                    *(PG8_LAS unsigned*)(slab + (3 + 4 * hq + i) * RP + 4 * c2) = cvt_pk_bf16(CF_SILU(a0), CF_SILU(a1));
                    *(PG8_LAS unsigned*)(slab + (3 + 4 * hq + i) * RP + 64 + 4 * c2) = cvt_pk_bf16(CF_SILU(b0), CF_SILU(b1));
#undef CF_SILU
                }
                asm volatile("s_waitcnt lgkmcnt(0)" ::: "memory");
                { const int row = lane >> 2, q = lane & 3;
                  const u32x4 w0 = *(const PG8_LAS u32x4*)(slab + (3 + row) * RP + 32 * q), w1 = *(const PG8_LAS u32x4*)(slab + (3 + row) * RP + 32 * q + 16);
                  bf16_t* op = XBC + (size_t)(u.pm * BM + 64 * bi + 16 * m + row) * 3072 + up * 256 + (q >> 1) * 128 + 32 * wc + 16 * (q & 1);
                  *(u32x4*)op = w0; *(u32x4*)(op + 8) = w1; }
                asm volatile("s_waitcnt lgkmcnt(0)" ::: "memory");
            }
        }
#undef CF_LO
#undef CF_HI
    }
};
}

constexpr int NWAVES = 8;
constexpr int NBATCH = 16, SEQ = 2048, M_TOK = NBATCH * SEQ, DM = 1024;
constexpr int DIN = 2048, NXBC = 3072, NIN = 5152, NINP = 5376, SSM_H = 32;
constexpr int FF = 2816, FF2 = 5632, MH = M_TOK / 2;
constexpr float EPS = 1e-6f, LOG2E = 1.4426950408889634f;
constexpr float LAM_INIT = 0.35550906759096926f;
constexpr float QSCALE = 0.125f * 1.4426950408889634f;

constexpr size_t MiB = 1u << 20;
constexpr size_t WS_CTL = 0, CTL_ZERO_BYTES = 1 * MiB;
constexpr size_t WS_WIN = 1 * MiB, WS_WOUT = 12 * MiB, WS_WUP0 = 16 * MiB, WS_WUP1 = 27 * MiB, WS_WDN0 = 38 * MiB, WS_WDN1 = 44 * MiB,
                 WS_WKVQ = 50 * MiB, WS_WAO = 56 * MiB, WS_RSTD = 58 * MiB, WS_DT = 59 * MiB;
constexpr size_t WS_XB = 64 * MiB;
constexpr size_t WS_R = 128 * MiB;
constexpr size_t WS_Z = WS_R, WS_XBC = WS_R + 128 * MiB, WS_XRAW = WS_R + 320 * MiB;
constexpr size_t WS_U = WS_R, WS_H = WS_R, WS_FRAW = WS_R + 176 * MiB;
constexpr size_t WS_K = WS_R, WS_V = WS_R + 64 * MiB, WS_Q = WS_R + 128 * MiB, WS_O = WS_R + 192 * MiB;
constexpr size_t WS_GSS = WS_R + 340 * MiB;
constexpr size_t WS_END = 512 * MiB;
constexpr int CW_BAR = 4096;
constexpr size_t WS_SS1 = 256 * 1024, WS_SS2 = 384 * 1024, WS_SS3 = 512 * 1024;

constexpr int RING_BYTES = 131072;
constexpr int LDS_BYTES = 163840;
constexpr int LDSCTL_OFF = LDS_BYTES - 1024, MISC_OFF = LDSCTL_OFF + 320;

#define GAS __attribute__((address_space(1)))
#define LAS __attribute__((address_space(3)))
typedef unsigned short bf16;
typedef unsigned v4u __attribute__((ext_vector_type(4)));
typedef float f32x4 __attribute__((ext_vector_type(4)));
typedef short bf16x8 __attribute__((ext_vector_type(8)));
typedef GAS unsigned gu32;
typedef GAS unsigned long long gu64;
#define RLX_AGENT __ATOMIC_RELAXED, __HIP_MEMORY_SCOPE_AGENT
#define LDS_WAIT() asm volatile("s_waitcnt lgkmcnt(0)" ::: "memory")
#define VM_WAIT() asm volatile("s_waitcnt vmcnt(0)" ::: "memory")
__device__ __forceinline__ unsigned long long rt() { return __builtin_amdgcn_s_memrealtime(); }
typedef float f32x2_cv __attribute__((ext_vector_type(2))); typedef __bf16 bf16x2_cv __attribute__((ext_vector_type(2)));
__device__ __forceinline__ unsigned pk2(float lo, float hi) { f32x2_cv v = {lo, hi}; bf16x2_cv b = __builtin_convertvector(v, bf16x2_cv); return __builtin_bit_cast(unsigned, b); }
__device__ __forceinline__ unsigned f2bf(float f) { return pk2(f, f) & 0xffffu; }
#define XB_TMO      128
#define XB_XCNT(j)  (256  + 64 * (j))
#define XB_XSUB(j)  (1280 + 64 * (j))
#define XB_XGEN(j)  (2304 + 64 * (j))
#define XB_TOP      3328
#define XB_TOPGEN   3392
#define XCD_BAR_WORDS 3456
#define XB_SPIN_CAP (1u << 18)

__device__ __forceinline__ unsigned xb_ld(unsigned* p)              { return __hip_atomic_load(p, __ATOMIC_RELAXED, __HIP_MEMORY_SCOPE_AGENT); }
__device__ __forceinline__ unsigned xb_add(unsigned* p, unsigned v) { return __hip_atomic_fetch_add(p, v, __ATOMIC_RELAXED, __HIP_MEMORY_SCOPE_AGENT); }
__device__ __forceinline__ unsigned xb_xcc_id() { return (unsigned)__builtin_amdgcn_s_getreg((3 << 11) | 20) & 0xFu; }
#define XB_SPIN(cond, bar) do { unsigned _sp = 0; while (cond) { __builtin_amdgcn_s_sleep(1); \
    if ((++_sp & 255u) == 0u) { if (xb_ld(&(bar)[XB_TMO])) break; if (_sp > XB_SPIN_CAP) { atomicAdd(&(bar)[XB_TMO], 1u); break; } } } } while (0)

struct XcdBarrier {
    unsigned* bar; unsigned x;
    volatile LAS unsigned* st;
};

__device__ __forceinline__ XcdBarrier xcd_barrier_post(unsigned* bar, volatile LAS unsigned* st) {
    XcdBarrier b; b.bar = bar; b.x = xb_xcc_id(); b.st = st;
    if (threadIdx.x == 0) (void)xb_add(&bar[XB_XCNT(b.x)], 1u);
    return b;
}
__device__ __forceinline__ void xcd_barrier_complete(unsigned* bar, unsigned x, unsigned& nloc, unsigned& nx) {
    const unsigned G = gridDim.x * gridDim.y * gridDim.z;
    unsigned sum, cnt, mine, sp = 0u;
    for (;;) {
        sum = 0u; cnt = 0u; mine = 0u;
#pragma unroll
        for (unsigned j = 0; j < 16; ++j) { const unsigned c = xb_ld(&bar[XB_XCNT(j)]); sum += c; cnt += (c > 0u) ? 1u : 0u; mine = (j == x) ? c : mine; }
        if (sum == G) break;
        __builtin_amdgcn_s_sleep(1);
        if ((++sp & 255u) == 0u) { if (xb_ld(&bar[XB_TMO])) break; if (sp > XB_SPIN_CAP) { atomicAdd(&bar[XB_TMO], 1u); break; } }
    }
    nloc = mine > 0u ? mine : 1u; nx = cnt > 0u ? cnt : 1u;
}

__device__ __forceinline__ void xcd_barrier(const XcdBarrier& b) {
    asm volatile("s_waitcnt vmcnt(0)" ::: "memory");
    __syncthreads();
    if (threadIdx.x == 0) {
        unsigned* bar = b.bar;
        __builtin_amdgcn_s_waitcnt(0);
        unsigned nloc = b.st[0], nx = b.st[1];
        if (nloc == 0u) { xcd_barrier_complete(bar, b.x, nloc, nx); b.st[0] = nloc; b.st[1] = nx; }
        const unsigned old = xb_add(&bar[XB_XSUB(b.x)], 1u);
        const unsigned gen = old / nloc;
        if (old + 1u == (gen + 1u) * nloc) {
            __builtin_amdgcn_fence(__ATOMIC_RELEASE, "agent");
            asm volatile("s_waitcnt vmcnt(0)" ::: "memory");
            const unsigned og = xb_add(&bar[XB_TOP], 1u);
            const unsigned tg = og / nx;
            if (og + 1u == (tg + 1u) * nx) xb_add(&bar[XB_TOPGEN], 1u);
            else XB_SPIN(xb_ld(&bar[XB_TOPGEN]) == tg, bar);
            __builtin_amdgcn_fence(__ATOMIC_ACQUIRE, "agent");
            xb_add(&bar[XB_XGEN(b.x)], 1u);
            asm volatile("s_waitcnt vmcnt(0)" ::: "memory");
        } else {
            XB_SPIN(xb_ld(&bar[XB_XGEN(b.x)]) == gen, bar);
            __builtin_amdgcn_fence(__ATOMIC_ACQUIRE, "agent");
            asm volatile("s_waitcnt vmcnt(0)" ::: "memory");
        }
    }
    __syncthreads();
}

struct Args { const float* in[25]; float* out; unsigned char* ws; int ph_lo, ph_hi; unsigned char prog[64]; };

typedef unsigned u32x4v __attribute__((ext_vector_type(4)));
__device__ __forceinline__ float bf2f(bf16 v) { return __builtin_bit_cast(float, (unsigned)v << 16); }
__device__ __forceinline__ float wave_sum(float v) {
#pragma unroll
    for (int o = 1; o < 64; o <<= 1) v += __shfl_xor(v, o);
    return v;
}
__device__ __forceinline__ float silu_f(float v) { return v * __builtin_amdgcn_rcpf(1.f + __builtin_amdgcn_exp2f(v * -1.4426950408889634f)); }

__device__ __forceinline__ void wprep_item(const float* W, int K, int Nsrc, int scol0, const float* gain, int gmask, float gscale,
                                           bf16* WT, int drow0, int k0, LAS float* scr, int lane) {
    float wv[32];
    asm volatile("" : "+s"(gscale));
#pragma unroll
    for (int i = 0; i < 32; ++i) { const int kk = 2 * i + (lane >> 5); wv[i] = W ? W[(size_t)(k0 + kk) * Nsrc + scol0 + (lane & 31)] : 0.f; }
#pragma unroll
    for (int i = 0; i < 32; ++i) { const int kk = 2 * i + (lane >> 5);
        const float gn = gain ? gain[(k0 + kk) & gmask] * gscale : gscale;
        scr[kk * 33 + (lane & 31)] = wv[i] * gn; }
    LDS_WAIT(); asm volatile("" ::: "memory");
    const int c = lane & 7;
#pragma unroll
    for (int j = 0; j < 4; ++j) { const int n = (lane >> 3) + 8 * j; const LAS float* s = scr + (8 * c) * 33 + n;
        v4u o; o.x = pk2(s[0 * 33], s[1 * 33]); o.y = pk2(s[2 * 33], s[3 * 33]); o.z = pk2(s[4 * 33], s[5 * 33]); o.w = pk2(s[6 * 33], s[7 * 33]);
        *(GAS v4u*)(WT + (size_t)(drow0 + n) * K + k0 + 8 * c) = o; }
    LDS_WAIT(); asm volatile("" ::: "memory");
}
__device__ __forceinline__ void rowstat_phase(const float* x, bf16* xb, float* rstd, int vcu, int NGW) {
    const int tid_ = opaque_tid(), lane = tid_ & 63, gw = vcu * NWAVES + __builtin_amdgcn_readfirstlane(tid_ >> 6);
    for (int m0 = gw * 2; m0 < M_TOK; m0 += NGW * 2) {
        f32x4 v[2][4]; float s[2];
#pragma unroll
        for (int r = 0; r < 2; ++r) { const GAS f32x4* xr = (const GAS f32x4*)(x + (size_t)(m0 + r) * DM) + lane;
#pragma unroll
            for (int j = 0; j < 4; ++j) v[r][j] = xr[64 * j]; }
#pragma unroll
        for (int r = 0; r < 2; ++r) { float t = 0.f;
#pragma unroll
            for (int j = 0; j < 4; ++j) t += (v[r][j].x * v[r][j].x + v[r][j].y * v[r][j].y) + (v[r][j].z * v[r][j].z + v[r][j].w * v[r][j].w);
            s[r] = wave_sum(t);
            GAS unsigned long long* o8 = (GAS unsigned long long*)(xb + (size_t)(m0 + r) * DM) + lane;
#pragma unroll
            for (int j = 0; j < 4; ++j) o8[64 * j] = (unsigned long long)pk2(v[r][j].x, v[r][j].y) | ((unsigned long long)pk2(v[r][j].z, v[r][j].w) << 32); }
        if (lane < 2) rstd[m0 + lane] = lane ? s[1] : s[0];
    }
}
__device__ __forceinline__ void prep_phase(const Args& a, LAS unsigned char* lds, int vcu, int NGW) {
    const int tid_ = opaque_tid(), lane = tid_ & 63, wave = __builtin_amdgcn_readfirstlane(tid_ >> 6), gw = vcu * NWAVES + wave;
    LAS float* scr = (LAS float*)(lds + wave * 16384);
    unsigned char* ws = a.ws;
    constexpr int I_IN = 16 * 168, I_OUT = 32 * 32, I_UP = 16 * 176, I_DN = 44 * 32, I_KV = 16 * 64, I_Q = 16 * 32, I_AO = 16 * 32;
    constexpr int NITEMS = I_IN + I_OUT + 2 * I_UP + 2 * I_DN + I_KV + I_Q + I_AO;
    for (int it = gw; it < NITEMS; it += NGW) {
        int r = it;
        if (r < I_IN) { const int kb = r / 168, db = r % 168;
            wprep_item(db < 161 ? a.in[2] : nullptr, 1024, NIN, 32 * db, a.in[1], 1023, 1.f, (bf16*)(ws + WS_WIN), 32 * db, 64 * kb, scr, lane); continue; } r -= I_IN;
        if (r < I_OUT) { const int kb = r / 32, db = r % 32;
            wprep_item(a.in[9], 2048, 1024, 32 * db, a.in[8], 2047, 1.f, (bf16*)(ws + WS_WOUT), 32 * db, 64 * kb, scr, lane); continue; } r -= I_OUT;
        if (r < 2 * I_UP) { const int l = r / I_UP; r -= l * I_UP; const int kb = r / 176, db = r % 176, j = db >> 3, q = db & 7;
            const int scol = (q < 4) ? (128 * j + 32 * q) : (FF + 128 * j + 32 * (q - 4));
            wprep_item(a.in[21] + (size_t)l * 1024 * FF2, 1024, FF2, scol, a.in[20] + l * 1024, 1023, 1.f, (bf16*)(ws + (l ? WS_WUP1 : WS_WUP0)), 32 * db, 64 * kb, scr, lane); continue; } r -= 2 * I_UP;
        if (r < 2 * I_DN) { const int l = r / I_DN; r -= l * I_DN; const int kb = r / 32, db = r % 32;
            wprep_item(a.in[24] + (size_t)l * FF * 1024, FF, 1024, 32 * db, nullptr, 0, 1.f, (bf16*)(ws + (l ? WS_WDN1 : WS_WDN0)), 32 * db, 64 * kb, scr, lane); continue; } r -= 2 * I_DN;
        if (r < I_KV) { const int kb = r / 64, db = r % 64, q = db & 7;
            wprep_item(a.in[11], 1024, 2048, 256 * (db >> 3) + 64 * (q & 3) + 32 * (q >> 2), a.in[10], 1023, 1.f, (bf16*)(ws + WS_WKVQ), 32 * db, 64 * kb, scr, lane); continue; } r -= I_KV;
        if (r < I_Q) { const int kb = r / 32, db = r % 32, q = db & 7;
            wprep_item(a.in[15], 1024, 1024, 256 * (db >> 3) + 64 * (q & 3) + 32 * (q >> 2), a.in[14], 1023, 1.f, (bf16*)(ws + WS_WKVQ), 2048 + 32 * db, 64 * kb, scr, lane); continue; } r -= I_Q;
        { const int kb = r / 32, db = r % 32;
            wprep_item(a.in[19], 1024, 1024, 32 * db, a.in[18], 127, 1.f - LAM_INIT, (bf16*)(ws + WS_WAO), 32 * db, 64 * kb, scr, lane); }
    }
    rowstat_phase(a.in[0], (bf16*)(ws + WS_XB), (float*)(ws + WS_RSTD), vcu, NGW);
}

__device__ __forceinline__ void ssd_naive_phase(const Args& a, LAS unsigned char* lds) {
    const int tid = opaque_tid();
    LAS float* cx = (LAS float*)lds;
    LAS float* cB = cx + 64 * 64;
    LAS float* cC = cB + 64 * 128;
    LAS float* cdA = cC + 64 * 128;
    LAS float* cdt = cdA + 64;
    const bf16* XBC = (const bf16*)(a.ws + WS_XBC); bf16* Z = (bf16*)(a.ws + WS_Z); const float* DT = (const float*)(a.ws + WS_DT);
    const float* conv_w = a.in[3]; const float* conv_b = a.in[4];
    const int p = tid >> 3, ns = (tid & 7) * 16;
    for (int item = blockIdx.x; item < NBATCH * SSM_H; item += gridDim.x) {
        const int b = item >> 5, h = item & 31, g = h >> 3;
        const float Aneg = -__expf(a.in[6][h]), dtb = a.in[5][h], Dh = a.in[7][h];
        float hst[16];
#pragma unroll
        for (int i = 0; i < 16; ++i) hst[i] = 0.f;
        for (int t0 = 0; t0 < SEQ; t0 += 64) {
            for (int e = tid; e < 64 * 320; e += 512) {
                const int tt = e / 320, j = e - tt * 320;
                const int col = j < 64 ? 64 * h + j : (j < 192 ? 2048 + 128 * g + (j - 64) : 2560 + 128 * g + (j - 192));
                const int t = t0 + tt;
                float v = conv_b[col];
#pragma unroll
                for (int k = 0; k < 4; ++k) { const int ts = t - 3 + k; if (ts >= 0) v += conv_w[k * NXBC + col] * bf2f(XBC[(size_t)(b * SEQ + ts) * NXBC + col]); }
                v = silu_f(v);
                if (j < 64) cx[tt * 64 + j] = v; else if (j < 192) cB[tt * 128 + (j - 64)] = v; else cC[tt * 128 + (j - 192)] = v;
            }
            if (tid < 64) { const float raw = DT[(size_t)(b * SEQ + t0 + tid) * 32 + h] + dtb; const float dtv = raw > 20.f ? raw : log1pf(__expf(raw)); cdt[tid] = dtv; cdA[tid] = __expf(dtv * Aneg); }
            __syncthreads();
            for (int tt = 0; tt < 64; ++tt) {
                const float xv = cx[tt * 64 + p], dA = cdA[tt], xdt = xv * cdt[tt];
                float acc = 0.f;
#pragma unroll
                for (int i = 0; i < 16; ++i) { hst[i] = dA * hst[i] + xdt * cB[tt * 128 + ns + i]; acc += cC[tt * 128 + ns + i] * hst[i]; }
                acc += __shfl_xor(acc, 1); acc += __shfl_xor(acc, 2); acc += __shfl_xor(acc, 4);
                if ((tid & 7) == 0) { const size_t idx = (size_t)(b * SEQ + t0 + tt) * DIN + 64 * h + p; const float z = bf2f(Z[idx]); Z[idx] = (bf16)f2bf((acc + xv * Dh) * silu_f(z)); }
            }
            __syncthreads();
        }
    }
}
__device__ __forceinline__ void unpack8(const v4u w, float (&f)[8]) {
    f[0] = __builtin_bit_cast(float, w.x << 16); f[1] = __builtin_bit_cast(float, w.x & 0xffff0000u); f[2] = __builtin_bit_cast(float, w.y << 16); f[3] = __builtin_bit_cast(float, w.y & 0xffff0000u);
    f[4] = __builtin_bit_cast(float, w.z << 16); f[5] = __builtin_bit_cast(float, w.z & 0xffff0000u); f[6] = __builtin_bit_cast(float, w.w << 16); f[7] = __builtin_bit_cast(float, w.w & 0xffff0000u);
}
__device__ __forceinline__ void groupnorm_phase(const Args& a, int vcu, int NGW) {
    const int tid_ = opaque_tid(), lane = tid_ & 63, gw = vcu * NWAVES + __builtin_amdgcn_readfirstlane(tid_ >> 6);
    bf16* Z = (bf16*)(a.ws + WS_Z);
    for (int i = gw; i < M_TOK * 4; i += NGW) {
        GAS v4u* p = (GAS v4u*)(Z + (size_t)i * 512) + lane;
        float f[8]; unpack8(*p, f);
        float s = 0.f;
#pragma unroll
        for (int j = 0; j < 8; ++j) s += f[j] * f[j];
        s = wave_sum(s);
        const float r = 1.f / sqrtf(s * (1.f / 512.f) + EPS);
        v4u o; o.x = pk2(f[0] * r, f[1] * r); o.y = pk2(f[2] * r, f[3] * r); o.z = pk2(f[4] * r, f[5] * r); o.w = pk2(f[6] * r, f[7] * r);
        *p = o;
    }
}
__device__ __forceinline__ void convact_phase(const Args& a, int layer, int r0) {
    const bf16* U = (const bf16*)(a.ws + WS_U); bf16* H = (bf16*)(a.ws + WS_H);
    const float* cw = a.in[22] + (size_t)layer * 3 * FF2; const float* cb = a.in[23] + (size_t)layer * FF2;
    constexpr int NG = FF / 8, NITEMS = (MH / 32) * NG;
    const int nthr = gridDim.x * 512;
    for (int item = blockIdx.x * 512 + opaque_tid(); item < NITEMS; item += nthr) {
        const int seg = item / NG, c = (item - seg * NG) * 8, gcol = 256 * (c >> 7) + (c & 127);
        const int t1 = seg * 32, tseq = (r0 + t1) & (SEQ - 1);
        float wg[3][8], wu[3][8], bg[8], bu[8];
#pragma unroll
        for (int q = 0; q < 2; ++q) {
            const f32x4 x = *(const GAS f32x4*)(cb + c + 4 * q), y = *(const GAS f32x4*)(cb + FF + c + 4 * q);
#pragma unroll
            for (int e = 0; e < 4; ++e) { bg[4 * q + e] = x[e]; bu[4 * q + e] = y[e]; }
#pragma unroll
            for (int k = 0; k < 3; ++k) { const f32x4 xg = *(const GAS f32x4*)(cw + k * FF2 + c + 4 * q), xu = *(const GAS f32x4*)(cw + k * FF2 + FF + c + 4 * q);
#pragma unroll
                for (int e = 0; e < 4; ++e) { wg[k][4 * q + e] = xg[e]; wu[k][4 * q + e] = xu[e]; } }
        }
        const bf16* up = U + (size_t)t1 * FF2 + gcol;
        v4u g2 = {0u, 0u, 0u, 0u}, g1 = g2, u2 = g2, u1 = g2;
        if (tseq != 0) { g2 = *(const GAS v4u*)(up - 2 * (ptrdiff_t)FF2); u2 = *(const GAS v4u*)(up - 2 * (ptrdiff_t)FF2 + 128); g1 = *(const GAS v4u*)(up - (ptrdiff_t)FF2); u1 = *(const GAS v4u*)(up - (ptrdiff_t)FF2 + 128); }
        bf16* hp = H + (size_t)t1 * FF + c;
#pragma unroll 8
        for (int rr = 0; rr < 32; ++rr) {
            const v4u g0 = *(const GAS v4u*)(up + (size_t)rr * FF2), u0 = *(const GAS v4u*)(up + (size_t)rr * FF2 + 128);
            float a2[8], a1[8], a0[8], b2[8], b1[8], b0[8];
            unpack8(g2, a2); unpack8(g1, a1); unpack8(g0, a0); unpack8(u2, b2); unpack8(u1, b1); unpack8(u0, b0);
            float hv[8];
#pragma unroll
            for (int e = 0; e < 8; ++e) { const float gg = bg[e] + wg[0][e] * a2[e] + wg[1][e] * a1[e] + wg[2][e] * a0[e], uu = bu[e] + wu[0][e] * b2[e] + wu[1][e] * b1[e] + wu[2][e] * b0[e]; hv[e] = silu_f(gg) * uu; }
            *(GAS v4u*)(hp + (size_t)rr * FF) = (v4u){pk2(hv[0], hv[1]), pk2(hv[2], hv[3]), pk2(hv[4], hv[5]), pk2(hv[6], hv[7])};
            g2 = g1; g1 = g0; u2 = u1; u1 = u0;
        }
    }
}
__device__ __forceinline__ void bcconv_phase(const Args& a) {
    const bf16* XBC = (const bf16*)(a.ws + WS_XBC); bf16* BCc = (bf16*)(a.ws + WS_XB);
    const float* cw = a.in[3]; const float* cb = a.in[4];
    constexpr int NG = 1024 / 8, NITEMS = (M_TOK / 32) * NG;
    const int nthr = gridDim.x * 512;
    for (int item = blockIdx.x * 512 + opaque_tid(); item < NITEMS; item += nthr) {
        const int seg = item / NG, c = (item - seg * NG) * 8, t1 = seg * 32, tseq = t1 & (SEQ - 1);
        float w[4][8], bb[8];
#pragma unroll
        for (int q = 0; q < 2; ++q) { const f32x4 x = *(const GAS f32x4*)(cb + 2048 + c + 4 * q);
#pragma unroll
            for (int e = 0; e < 4; ++e) bb[4 * q + e] = x[e];
#pragma unroll
            for (int k = 0; k < 4; ++k) { const f32x4 y = *(const GAS f32x4*)(cw + k * NXBC + 2048 + c + 4 * q);
#pragma unroll
                for (int e = 0; e < 4; ++e) w[k][4 * q + e] = y[e]; } }
        const bf16* sp = XBC + (size_t)t1 * NXBC + 2048 + c;
        v4u r3 = {0u, 0u, 0u, 0u}, r2 = r3, r1 = r3;
        if (tseq != 0) { r3 = *(const GAS v4u*)(sp - 3 * (ptrdiff_t)NXBC); r2 = *(const GAS v4u*)(sp - 2 * (ptrdiff_t)NXBC); r1 = *(const GAS v4u*)(sp - (ptrdiff_t)NXBC); }
        bf16* dp = BCc + (size_t)t1 * 1024 + c;
#pragma unroll 8
        for (int rr = 0; rr < 32; ++rr) {
            const v4u r0 = *(const GAS v4u*)(sp + (size_t)rr * NXBC);
            float a3[8], a2[8], a1[8], a0[8]; unpack8(r3, a3); unpack8(r2, a2); unpack8(r1, a1); unpack8(r0, a0);
            float o[8];
#pragma unroll
            for (int e = 0; e < 8; ++e) o[e] = silu_f(bb[e] + w[0][e] * a3[e] + w[1][e] * a2[e] + w[2][e] * a1[e] + w[3][e] * a0[e]);
            *(GAS v4u*)(dp + (size_t)rr * 1024) = (v4u){pk2(o[0], o[1]), pk2(o[2], o[3]), pk2(o[4], o[5]), pk2(o[6], o[7])};
            r3 = r2; r2 = r1; r1 = r0;
        }
    }
}
__device__ __forceinline__ void ssmconv_fixup_phase(const Args& a) {
    const bf16* raw = (const bf16*)(a.ws + WS_XRAW); bf16* XBC = (bf16*)(a.ws + WS_XBC);
    const float* cw = a.in[3]; const float* cb = a.in[4];
    const int nthr = gridDim.x * 512;
    for (int e = blockIdx.x * 512 + opaque_tid(); e < (M_TOK / 256) * 3 * NXBC; e += nthr) {
        const int pm = e / (3 * NXBC), rem = e - pm * 3 * NXBC, r = rem / NXBC, col = rem - r * NXBC;
        const int rc = (col >> 8) * 256 + ((col >> 5) & 3) * 64 + ((col >> 7) & 1) * 32 + (col & 31);
        float x[6];
#pragma unroll
        for (int k = 0; k < 3; ++k) {
            x[k] = ((pm & 7) != 0) ? bf2f(raw[((size_t)(pm - 1) * 6 + 3 + k) * NXBC + rc]) : 0.f;
            x[3 + k] = bf2f(raw[((size_t)pm * 6 + k) * NXBC + rc]);
        }
        const float v = cb[col] + cw[col] * x[r] + cw[NXBC + col] * x[r + 1] + cw[2 * NXBC + col] * x[r + 2] + cw[3 * NXBC + col] * x[r + 3];
        XBC[(size_t)(pm * 256 + r) * NXBC + col] = (bf16)f2bf(silu_f(v));
    }
}
__device__ __forceinline__ void convffn_fixup_phase(const Args& a, int layer) {
    const bf16* raw = (const bf16*)(a.ws + WS_FRAW); bf16* H = (bf16*)(a.ws + WS_H);
    const float* cw = a.in[22] + (size_t)layer * 3 * FF2; const float* cb = a.in[23] + (size_t)layer * FF2;
    const int nthr = gridDim.x * 512;
    for (int e = blockIdx.x * 512 + opaque_tid(); e < (M_TOK / 256) * 2 * FF; e += nthr) {
        const int pm = e / (2 * FF), rem = e - pm * 2 * FF, r = rem / FF, ch = rem - r * FF;
        const int col = (ch >> 7) * 256 + ((ch >> 5) & 3) * 64 + (ch & 31);
        float g[4], u[4];
#pragma unroll
        for (int k = 0; k < 2; ++k) {
            if ((pm & 7) != 0) { const bf16* p = raw + ((size_t)(pm - 1) * 4 + 2 + k) * 22 * 256 + col; g[k] = bf2f(p[0]); u[k] = bf2f(p[32]); } else { g[k] = 0.f; u[k] = 0.f; }
            const bf16* q = raw + ((size_t)pm * 4 + k) * 22 * 256 + col; g[2 + k] = bf2f(q[0]); u[2 + k] = bf2f(q[32]);
        }
        const float cg = cb[ch] + cw[ch] * g[r] + cw[FF2 + ch] * g[r + 1] + cw[2 * FF2 + ch] * g[r + 2];
        const float cu = cb[FF + ch] + cw[FF + ch] * u[r] + cw[FF2 + FF + ch] * u[r + 1] + cw[2 * FF2 + FF + ch] * u[r + 2];
        H[(size_t)(pm * 256 + r) * FF + ch] = (bf16)f2bf(silu_f(cg) * cu);
    }
}
__device__ __forceinline__ void qknorm_phase(const Args& a, int vcu, int NGW) {
    const int tid_ = opaque_tid(), lane = tid_ & 63, gw = vcu * NWAVES + __builtin_amdgcn_readfirstlane(tid_ >> 6);
    for (int i = gw; i < M_TOK * 2; i += NGW) {
        const int tok = i >> 1, isq = i & 1;
        bf16* base = (bf16*)(a.ws + (isq ? WS_Q : WS_K)) + (size_t)tok * 1024 + lane * 16;
        const float* g = (isq ? a.in[16] : a.in[12]) + (lane & 3) * 16; const float sc = isq ? QSCALE : 1.f;
        const v4u w0 = *(const GAS v4u*)base, w1 = *(const GAS v4u*)(base + 8);
        const unsigned ww[8] = {w0.x, w0.y, w0.z, w0.w, w1.x, w1.y, w1.z, w1.w};
        float f[16]; float s = 0.f;
#pragma unroll
        for (int q = 0; q < 8; ++q) { f[2 * q] = __builtin_bit_cast(float, ww[q] << 16); f[2 * q + 1] = __builtin_bit_cast(float, ww[q] & 0xffff0000u); s += f[2 * q] * f[2 * q] + f[2 * q + 1] * f[2 * q + 1]; }
        s += __shfl_xor(s, 1); s += __shfl_xor(s, 2);
        const float r = sc / sqrtf(s * (1.f / 64.f) + EPS);
        unsigned o[8];
#pragma unroll
        for (int q = 0; q < 8; ++q) o[q] = pk2(f[2 * q] * r * g[2 * q], f[2 * q + 1] * r * g[2 * q + 1]);
        *(GAS v4u*)base = (v4u){o[0], o[1], o[2], o[3]}; *(GAS v4u*)(base + 8) = (v4u){o[4], o[5], o[6], o[7]};
    }
}
__device__ __forceinline__ int t5_bucket(int n) {
    if (n < 16) return n;
    int l = 16 + (int)(__logf((float)n / 16.f) / 2.0794415416798357f * 16.f);
    return l < 31 ? l : 31;
}
__device__ __forceinline__ void attn_naive_phase(const Args& a, LAS unsigned char* lds) {
    const int tid = opaque_tid(), lane = tid & 63;
    LAS float* Qs = (LAS float*)lds;
    LAS float* Ks = Qs + 64 * 129;
    LAS float* Vs = Ks + 64 * 129;
    LAS float* Ws = Vs + 64 * 128;
    LAS float* btab = Ws + 64 * 65;
    const bf16* Kb = (const bf16*)(a.ws + WS_K); const bf16* Vb = (const bf16*)(a.ws + WS_V); bf16* Qb = (bf16*)(a.ws + WS_Q);
    const float* rel_bias = a.in[13]; const float* lv = a.in[17];
    const int r = tid >> 3, ks = tid & 7;
    for (int item = blockIdx.x; item < 4096; item += gridDim.x) {
        const int qb = 31 - (item >> 7), bh = item & 127, b = bh >> 3, h = bh & 7;
        const size_t row0 = (size_t)b * SEQ + qb * 64;
        __syncthreads();
        for (int e = tid; e < 64 * 128; e += 512) { const int rr = e >> 7, c = e & 127; Qs[rr * 129 + c] = bf2f(Qb[(row0 + rr) * 1024 + h * 128 + c]); }
        if (tid < 129) { const int bk = t5_bucket(tid); btab[tid] = rel_bias[bk * 8 + h] * LOG2E; }
        if (tid < 64) { float s0 = lv[tid] * lv[64 + tid], s1 = lv[128 + tid] * lv[192 + tid]; s0 = wave_sum(s0); s1 = wave_sum(s1); if (tid == 0) btab[129] = __expf(s0) - __expf(s1) + LAM_INIT; }
        const int qpos = qb * 64 + r;
        float m0 = -1e30f, l0 = 0.f, m1 = -1e30f, l1 = 0.f;
        for (int kt = 0; kt <= qb; ++kt) {
            __syncthreads();
            for (int e = tid; e < 64 * 128; e += 512) { const int kk = e >> 7, c = e & 127; Ks[kk * 129 + c] = bf2f(Kb[((size_t)b * SEQ + kt * 64 + kk) * 1024 + h * 128 + c]); }
            __syncthreads();
            float s0[8], s1[8];
#pragma unroll
            for (int i = 0; i < 8; ++i) { s0[i] = 0.f; s1[i] = 0.f; }
            for (int d = 0; d < 64; ++d) { const float q0 = Qs[r * 129 + d], q1 = Qs[r * 129 + 64 + d];
#pragma unroll
                for (int i = 0; i < 8; ++i) { s0[i] += q0 * Ks[(ks * 8 + i) * 129 + d]; s1[i] += q1 * Ks[(ks * 8 + i) * 129 + 64 + d]; } }
#pragma unroll
            for (int i = 0; i < 8; ++i) { const int kpos = kt * 64 + ks * 8 + i;
                if (kpos <= qpos) { const int dist = qpos - kpos; const float bb = btab[dist < 128 ? dist : 128];
                    const float a0 = s0[i] + bb, a1 = s1[i] + bb;
                    float mn = fmaxf(m0, a0); l0 = l0 * exp2f(m0 - mn) + exp2f(a0 - mn); m0 = mn;
                    mn = fmaxf(m1, a1); l1 = l1 * exp2f(m1 - mn) + exp2f(a1 - mn); m1 = mn; } }
        }
#pragma unroll
        for (int off = 1; off < 8; off <<= 1) {
            float mo = __shfl_xor(m0, off), lo = __shfl_xor(l0, off); float mn = fmaxf(m0, mo); l0 = l0 * exp2f(m0 - mn) + lo * exp2f(mo - mn); m0 = mn;
            mo = __shfl_xor(m1, off); lo = __shfl_xor(l1, off); mn = fmaxf(m1, mo); l1 = l1 * exp2f(m1 - mn) + lo * exp2f(mo - mn); m1 = mn;
        }
        const float inv0 = 1.f / l0, inv1 = 1.f / l1, lam = btab[129];
        float o[16];
#pragma unroll
        for (int d = 0; d < 16; ++d) o[d] = 0.f;
        for (int kt = 0; kt <= qb; ++kt) {
            __syncthreads();
            for (int e = tid; e < 64 * 128; e += 512) { const int kk = e >> 7, c = e & 127; const size_t gi = ((size_t)b * SEQ + kt * 64 + kk) * 1024 + h * 128 + c;
                Ks[kk * 129 + c] = bf2f(Kb[gi]); Vs[kk * 128 + c] = bf2f(Vb[gi]); }
            __syncthreads();
            float s0[8], s1[8];
#pragma unroll
            for (int i = 0; i < 8; ++i) { s0[i] = 0.f; s1[i] = 0.f; }
            for (int d = 0; d < 64; ++d) { const float q0 = Qs[r * 129 + d], q1 = Qs[r * 129 + 64 + d];
#pragma unroll
                for (int i = 0; i < 8; ++i) { s0[i] += q0 * Ks[(ks * 8 + i) * 129 + d]; s1[i] += q1 * Ks[(ks * 8 + i) * 129 + 64 + d]; } }
#pragma unroll
            for (int i = 0; i < 8; ++i) { const int kpos = kt * 64 + ks * 8 + i; float w = 0.f;
                if (kpos <= qpos) { const int dist = qpos - kpos; const float bb = btab[dist < 128 ? dist : 128];
                    w = exp2f(s0[i] + bb - m0) * inv0 - lam * exp2f(s1[i] + bb - m1) * inv1; }
                Ws[r * 65 + ks * 8 + i] = w; }
            __syncthreads();
            for (int kk = 0; kk < 64; ++kk) { const float w = Ws[r * 65 + kk];
#pragma unroll
                for (int d = 0; d < 16; ++d) o[d] += w * Vs[kk * 128 + ks * 16 + d]; }
        }
        float ss = 0.f;
#pragma unroll
        for (int d = 0; d < 16; ++d) ss += o[d] * o[d];
        ss += __shfl_xor(ss, 1); ss += __shfl_xor(ss, 2); ss += __shfl_xor(ss, 4);
        const float rs = 1.f / sqrtf(ss * (1.f / 128.f) + EPS);
        bf16* op = Qb + (row0 + r) * 1024 + h * 128 + ks * 16;
        *(GAS v4u*)op = (v4u){pk2(o[0] * rs, o[1] * rs), pk2(o[2] * rs, o[3] * rs), pk2(o[4] * rs, o[5] * rs), pk2(o[6] * rs, o[7] * rs)};
        *(GAS v4u*)(op + 8) = (v4u){pk2(o[8] * rs, o[9] * rs), pk2(o[10] * rs, o[11] * rs), pk2(o[12] * rs, o[13] * rs), pk2(o[14] * rs, o[15] * rs)};
        (void)lane;
    }
}

typedef float f32x16 __attribute__((ext_vector_type(16)));
typedef short s16x4 __attribute__((ext_vector_type(4)));
typedef short v4i16_t __attribute__((ext_vector_type(4)));
__device__ __forceinline__ int crow(int r, int hi) { return (r & 3) + 8 * (r >> 2) + 4 * hi; }
__device__ __forceinline__ s16x4 vtr(const LAS unsigned char* p) { return __builtin_bit_cast(s16x4, __builtin_amdgcn_ds_read_tr16_b64_v4i16((LAS v4i16_t*)p)); }
template <int CTRL> __device__ __forceinline__ float dpp_add(float v) { return v + __builtin_bit_cast(float, __builtin_amdgcn_update_dpp(0, __builtin_bit_cast(int, v), CTRL, 0xf, 0xf, true)); }
__device__ __forceinline__ float red32(float v) {
    v = dpp_add<0xB1>(v); v = dpp_add<0x4E>(v); v = dpp_add<0x141>(v); v = dpp_add<0x140>(v);
    return v + __builtin_bit_cast(float, __builtin_amdgcn_ds_swizzle(__builtin_bit_cast(int, v), 0x401F));
}
__device__ __forceinline__ float wave_max(float v) {
#pragma unroll
    for (int o = 1; o < 64; o <<= 1) v = fmaxf(v, __shfl_xor(v, o));
    return v;
}
__device__ __forceinline__ void glds16(const void* sbase, unsigned voff, unsigned lds_dst) { unsigned keep;
    asm volatile("s_nop 4\n\ts_mov_b32 %0, m0\n\ts_mov_b32 m0, %3\n\ts_nop 0\n\tglobal_load_lds_dwordx4 %1, %2\n\ts_mov_b32 m0, %0" : "=&s"(keep) : "v"(voff), "s"(sbase), "s"(lds_dst) : "memory"); }
__device__ __forceinline__ void attn_fast_phase(const Args& a, LAS unsigned char* lds, int vcu) {
    const int tid = opaque_tid(), lane = tid & 63, wid = __builtin_amdgcn_readfirstlane(tid >> 6), r32 = lane & 31, hi = lane >> 5;
    const int comp = wid >> 2, wq = wid & 3;
    const bf16* Kb = (const bf16*)(a.ws + WS_K); const bf16* Vb = (const bf16*)(a.ws + WS_V); const bf16* Qb = (const bf16*)(a.ws + WS_Q); bf16* Ob = (bf16*)(a.ws + WS_O);
    const float* rel_bias = a.in[13]; const float* lv = a.in[17];
    LAS float* misc = (LAS float*)(lds + 131072);
    LAS float* wsf = misc + 256 + wid * 32;
    LAS float* X = (LAS float*)lds;
    const unsigned lds0 = (unsigned)(uintptr_t)lds;
    LAS float* tabs = misc + 512;
    { const int k = tid >> 7, d = tid & 127, hk = (4 * (vcu >> 3) + k) & 7;
      tabs[k * 132 + d] = rel_bias[t5_bucket(d) * 8 + hk] * LOG2E;
      if (d == 0) tabs[k * 132 + 128] = rel_bias[31 * 8 + hk] * LOG2E; }
    if (wid < 4) {
        const int hk = (4 * (vcu >> 3) + wid) & 7;
        float s0 = lv[lane] * lv[64 + lane], s1 = lv[128 + lane] * lv[192 + lane]; s0 = wave_sum(s0); s1 = wave_sum(s1);
        const float gq = wave_max(fabsf(a.in[16][lane])), gk = wave_max(fabsf(a.in[12][lane]));
        const float bm = wave_max(lane < 32 ? rel_bias[lane * 8 + hk] * LOG2E : -1e30f);
        if (lane == 0) { tabs[wid * 132 + 129] = __expf(s0) - __expf(s1) + LAM_INIT; tabs[wid * 132 + 131] = QSCALE * 64.f * gq * gk + bm; }
    }
    __syncthreads();
    for (int j = 0; j < 8; ++j) {
        const int bh = 4 * (vcu >> 3) + (j >> 1), s8 = vcu & 7, qb = (j & 1) ? 15 - s8 : s8;
        const int b = bh >> 3, h = bh & 7;
        const size_t tok0 = (size_t)b * SEQ;
        const int q0 = qb * 128;
        const LAS float* mt = tabs + (j >> 1) * 132;
        const bf16* qp = Qb + (tok0 + q0 + 32 * wq + r32) * 1024 + h * 128 + comp * 64 + 8 * hi;
        bf16x8 qr[4];
#pragma unroll
        for (int ks = 0; ks < 4; ++ks) qr[ks] = *(const GAS bf16x8*)(qp + 16 * ks);
        f32x16 o[4];
#pragma unroll
        for (int d = 0; d < 4; ++d)
#pragma unroll
            for (int r = 0; r < 16; ++r) o[d][r] = 0.f;
        float lsum = 0.f;
        const int NT = 2 * (qb + 1);
        const bf16* ksrc0 = Kb + tok0 * 1024 + h * 128;
        const unsigned kvoff = ((lane >> 2) * 1024 + 8 * ((lane & 3) ^ ((lane >> 4) & 3))) * 2, vvoff = ((lane >> 2) * 1024 + 8 * (lane & 3)) * 2;
        const bf16* vsrc0 = Vb + tok0 * 1024 + h * 128;
#define ATT_DMA_TILE(t, slot) do { _Pragma("unroll") for (int i_ = 0; i_ < 2; ++i_) { const int pk_ = wid + 8 * i_, d32_ = pk_ >> 2, k16_ = pk_ & 3; \
            glds16(ksrc0 + (size_t)(64 * (t) + 16 * k16_) * 1024 + 32 * d32_, kvoff, (unsigned)__builtin_amdgcn_readfirstlane((int)(lds0 + (slot) * 32768 + pk_ * 1024))); } \
        _Pragma("unroll") for (int i_ = 0; i_ < 2; ++i_) { const int pv_ = wid + 8 * i_, dvb_ = pv_ >> 2, k16_ = pv_ & 3; \
            glds16(vsrc0 + (size_t)(64 * (t) + 16 * k16_) * 1024 + 32 * dvb_, vvoff, (unsigned)__builtin_amdgcn_readfirstlane((int)(lds0 + (slot) * 32768 + 16384 + pv_ * 1024))); } } while (0)
        ATT_DMA_TILE(0, 0); ATT_DMA_TILE(1, 1);
        if (NT > 2) ATT_DMA_TILE(2, 2);
        asm volatile("" : "+v"(qr[0]), "+v"(qr[1]), "+v"(qr[2]), "+v"(qr[3]));
        if (NT > 2) asm volatile("s_waitcnt vmcnt(8) lgkmcnt(0)" ::: "memory"); else asm volatile("s_waitcnt vmcnt(4) lgkmcnt(0)" ::: "memory");
        __builtin_amdgcn_s_barrier(); asm volatile("" ::: "memory");
        const float cfar = mt[128] - mt[131], cnear = -mt[131];
        const int qpos = q0 + 32 * wq + r32;
#define ATT_QK(P0, P1, tt, slot_) do { const LAS unsigned char* kb_ = lds + (slot_) * 32768 + (r32 >> 4) * 1024 + (r32 & 15) * 64; \
            const float c0_ = ((tt) >= NT - 4) ? cnear : cfar; bf16x8 kf_[8]; \
            _Pragma("unroll") for (int ks = 0; ks < 4; ++ks) { const int po_ = (comp * 2 + (ks >> 1)) * 4096 + ((((ks & 1) * 2 + hi) ^ ((r32 >> 2) & 3)) * 16); \
                kf_[2 * ks] = *(const LAS bf16x8*)(kb_ + po_); kf_[2 * ks + 1] = *(const LAS bf16x8*)(kb_ + po_ + 2048); } \
            _Pragma("unroll") for (int r = 0; r < 16; ++r) { P0[r] = c0_; P1[r] = c0_; } \
            _Pragma("unroll") for (int ks = 0; ks < 4; ++ks) { \
                P0 = __builtin_amdgcn_mfma_f32_32x32x16_bf16(kf_[2 * ks], qr[ks], P0, 0, 0, 0); \
                P1 = __builtin_amdgcn_mfma_f32_32x32x16_bf16(kf_[2 * ks + 1], qr[ks], P1, 0, 0, 0); } } while (0)
#define ATT_PV(slot_) do { const LAS unsigned char* vbase_ = lds + (slot_) * 32768 + 16384 + ((lane >> 4) & 1) * 32 + (lane & 3) * 8 + (4 * hi + ((lane & 15) >> 2)) * 64; \
            _Pragma("unroll") for (int dvb = 0; dvb < 4; ++dvb) _Pragma("unroll") for (int ks = 0; ks < 4; ++ks) { \
                const s16x4 lo_ = vtr(vbase_ + dvb * 4096 + ks * 1024), hh_ = vtr(vbase_ + dvb * 4096 + ks * 1024 + 512); \
                const bf16x8 vf_ = (bf16x8){lo_[0], lo_[1], lo_[2], lo_[3], hh_[0], hh_[1], hh_[2], hh_[3]}; \
                o[dvb] = __builtin_amdgcn_mfma_f32_32x32x16_bf16(__builtin_bit_cast(bf16x8, pw[ks]), vf_, o[dvb], 0, 0, 0); \
                } } while (0)
        f32x16 p0, p1;
        u32x4v pw[4];
#pragma unroll
        for (int q = 0; q < 4; ++q) pw[q] = (u32x4v){0u, 0u, 0u, 0u};
        int slotp = 3, slot = 0, slotn = 1, slotf = 2;
        for (int t = 0; t < NT; ++t) {
            if (comp == 1 && t > 0) ATT_PV(slotp);
            ATT_QK(p0, p1, t, slot);
            const bool near = t >= NT - 4;
            if (near) {
#define ATT_NEAR(P, koff) do { float bb_[16]; \
                    _Pragma("unroll") for (int r = 0; r < 16; ++r) { const int d_ = qpos - (64 * t + (koff) + crow(r, hi)); bb_[r] = mt[d_ < 0 ? 0 : (d_ < 128 ? d_ : 128)]; } \
                    _Pragma("unroll") for (int r = 0; r < 16; ++r) asm volatile("" : "+v"(bb_[r]));        \
                    _Pragma("unroll") for (int r = 0; r < 16; ++r) { const int d_ = qpos - (64 * t + (koff) + crow(r, hi)); const float x_ = P[r] + bb_[r]; \
                        P[r] = __builtin_amdgcn_exp2f(d_ < 0 ? -INFINITY : x_); } } while (0)
                ATT_NEAR(p0, 0); ATT_NEAR(p1, 32);
#undef ATT_NEAR
            } else {
#pragma unroll
                for (int r = 0; r < 16; ++r) { p0[r] = __builtin_amdgcn_exp2f(p0[r]); p1[r] = __builtin_amdgcn_exp2f(p1[r]); }
            }
            float sacc = 0.f;
#pragma unroll
            for (int r = 0; r < 16; ++r) sacc += p0[r] + p1[r];
            lsum += sacc;
#pragma unroll
            for (int q = 0; q < 4; ++q) { pw[0][q] = pk2(p0[2 * q], p0[2 * q + 1]); pw[1][q] = pk2(p0[8 + 2 * q], p0[9 + 2 * q]);
                pw[2][q] = pk2(p1[2 * q], p1[2 * q + 1]); pw[3][q] = pk2(p1[8 + 2 * q], p1[9 + 2 * q]); }
            if (comp == 0) ATT_PV(slot);
            if (t + 2 < NT) asm volatile("s_waitcnt vmcnt(4) lgkmcnt(0)" ::: "memory"); else asm volatile("s_waitcnt vmcnt(0) lgkmcnt(0)" ::: "memory");
            __builtin_amdgcn_s_barrier(); asm volatile("" ::: "memory");
            if (t + 3 < NT) ATT_DMA_TILE(t + 3, slotp);
            { const int s_ = slotp; slotp = slot; slot = slotn; slotn = slotf; slotf = s_; }
        }
        if (comp == 1) ATT_PV(slotp);
        asm volatile("s_waitcnt lgkmcnt(0)" ::: "memory"); __builtin_amdgcn_s_barrier(); asm volatile("" ::: "memory");
#undef ATT_PV
#undef ATT_QK
#undef ATT_DMA_TILE
        const float lt = lsum + __shfl_xor(lsum, 32);
        if (hi == 0) wsf[r32] = lt;
        LDS_WAIT(); asm volatile("" ::: "memory");
        float rli[16];
#pragma unroll
        for (int r = 0; r < 16; ++r) rli[r] = __builtin_amdgcn_rcpf(wsf[crow(r, hi)]);
        if (comp == 1) {
            const float lam = mt[129];
#pragma unroll
            for (int dvb = 0; dvb < 4; ++dvb)
#pragma unroll
                for (int q = 0; q < 4; ++q) {
                    f32x4 w;
#pragma unroll
                    for (int i = 0; i < 4; ++i) w[i] = o[dvb][4 * q + i] * rli[4 * q + i] * lam;
                    *(LAS f32x4*)(X + ((wq * 128 + 32 * dvb + r32) * 36 + 8 * q + 4 * hi)) = w; }
        }
        __syncthreads();
        if (comp == 0) {
            float ss[16];
#pragma unroll
            for (int r = 0; r < 16; ++r) ss[r] = 0.f;
#pragma unroll
            for (int dvb = 0; dvb < 4; ++dvb)
#pragma unroll
                for (int q = 0; q < 4; ++q) { const f32x4 xv = *(const LAS f32x4*)(X + ((wq * 128 + 32 * dvb + r32) * 36 + 8 * q + 4 * hi));
#pragma unroll
                    for (int i = 0; i < 4; ++i) { const int r = 4 * q + i; const float v = o[dvb][r] * rli[r] - xv[i]; o[dvb][r] = v; ss[r] += v * v; } }
#pragma unroll
            for (int r = 0; r < 16; ++r) { float s = ss[r]; s = red32(s); ss[r] = 1.f / sqrtf(s * (1.f / 128.f) + EPS); }
            LDS_WAIT(); asm volatile("" ::: "memory");
            LAS bf16* stg = (LAS bf16*)((LAS unsigned char*)X + 73728 + wq * 8192);
#pragma unroll
            for (int dvb = 0; dvb < 4; ++dvb)
#pragma unroll
                for (int r = 0; r < 16; ++r) stg[crow(r, hi) * 128 + 32 * dvb + r32] = (bf16)f2bf(o[dvb][r] * ss[r]);
            LDS_WAIT(); asm volatile("" ::: "memory");
            const int lane_e = opaque_tid() & 63;
#pragma unroll
            for (int i = 0; i < 8; ++i) { const int row = 4 * i + (lane_e >> 4), ch = lane_e & 15;
                const v4u w = *(const LAS v4u*)(stg + row * 128 + ch * 8);
                *(GAS v4u*)(Ob + (tok0 + q0 + 32 * wq + row) * 1024 + h * 128 + ch * 8) = w; }
        }
        __syncthreads();
    }
}

constexpr int SSD_LD = 272;
constexpr int SSD_BS = 0, SSD_CS = 128 * SSD_LD, SSD_XS = 2 * 128 * SSD_LD, SSD_ST = 3 * 128 * SSD_LD, SSD_VEC = 4 * 128 * SSD_LD,
              SSD_HALO = SSD_VEC + 2048, SSD_STG = SSD_HALO + 2048, SSD_GSL = SSD_STG + 8 * 2048;
static_assert(SSD_GSL + 1024 <= LDSCTL_OFF, "SSD LDS map");
__device__ __forceinline__ bf16x8 frag_tr(const LAS unsigned char* p) {
    const s16x4 lo = vtr(p), hh = vtr(p + 8 * SSD_LD);
    return (bf16x8){lo[0], lo[1], lo[2], lo[3], hh[0], hh[1], hh[2], hh[3]};
}
__device__ __forceinline__ void ssd_fast_phase(const Args& a, LAS unsigned char* lds, int vcu) {
    const int tid = opaque_tid(), lane = tid & 63, wid = __builtin_amdgcn_readfirstlane(tid >> 6), r32 = lane & 31, hi = lane >> 5;
    const unsigned zz_ = (unsigned)tid >> 31; const v4u vzero = {zz_, zz_, zz_, zz_};
    const int hh = wid >> 2, wl = hh ? 3 - (wid & 3) : (wid & 3), wn = wid & 3;
    const int b = vcu >> 4, g = (vcu >> 2) & 3, h0 = 8 * g + 2 * (vcu & 3), hd = h0 + hh;
    float* gss = (float*)(a.ws + WS_GSS);
    const bf16* XBC = (const bf16*)(a.ws + WS_XBC); const float* DT = (const float*)(a.ws + WS_DT);
    const size_t tok0 = (size_t)b * SEQ;
    LAS float* dtv = (LAS float*)(lds + SSD_VEC);
    LAS float* acs = dtv + 256;
#define SSD_ROLES() const int tidr_ = opaque_tid(); const int cg = tidr_ % 48, ls = tidr_ / 48; \
    const int ccol = cg < 16 ? 64 * h0 + 8 * cg : (cg < 32 ? 2048 + 128 * g + 8 * (cg - 16) : 2560 + 128 * g + 8 * (cg - 32)); \
    const int cdst = (cg < 16 ? SSD_XS + 16 * cg : (cg < 32 ? SSD_BS + 16 * (cg - 16) : SSD_CS + 16 * (cg - 32))); (void)cdst; (void)ccol; (void)ls
    const float Aneg = -__expf(a.in[6][hd]), Dh = a.in[7][hd];
    f32x16 stq[2];
#pragma unroll
    for (int pb = 0; pb < 2; ++pb)
#pragma unroll
        for (int r = 0; r < 16; ++r) stq[pb][r] = 0.f;
    for (int e = tid; e < 128 * SSD_LD / 16; e += 512) *(LAS v4u*)(lds + SSD_ST + e * 16) = vzero;
    const int g16 = (lane >> 4) & 1, tq = (lane & 15) >> 2, tp = lane & 3;
    v4u pre[16];
#define SSD_PREFETCH(ch_) do { if (tid < 384) { SSD_ROLES(); const bf16* src_ = XBC + (tok0 + (ch_) * 128 + 16 * ls) * NXBC + ccol; \
        _Pragma("unroll") for (int i = 0; i < 16; ++i) pre[i] = *(const GAS v4u*)(src_ + (size_t)i * NXBC); } } while (0)
    float dtp[2] = {0.f, 0.f};
#define SSD_DTPREFETCH(ch_) do { if (wid >= 6) { const int hq_ = h0 + (wid - 6); const int lane_ = opaque_tid() & 63; \
        dtp[0] = DT[(tok0 + (ch_) * 128 + lane_) * 32 + hq_]; dtp[1] = DT[(tok0 + (ch_) * 128 + 64 + lane_) * 32 + hq_]; } } while (0)
    SSD_PREFETCH(0); SSD_DTPREFETCH(0);
    for (int ch = 0; ch < SEQ / 128; ++ch) {
        const int t0 = ch * 128;
        if (tid < 384) {
            SSD_ROLES();
#pragma unroll
            for (int i = 0; i < 16; ++i) *(LAS v4u*)(lds + cdst + (16 * ls + i) * SSD_LD) = pre[i];
        } else {
            const int q = wid - 6, hq = h0 + q; const float An = -__expf(a.in[6][hq]), dtb = a.in[5][hq];
            const float r0 = dtp[0] + dtb, r1 = dtp[1] + dtb;
            const float d0 = r0 > 20.f ? r0 : __logf(1.f + __expf(r0)), d1 = r1 > 20.f ? r1 : __logf(1.f + __expf(r1));
            float s0 = d0 * An, s1 = d1 * An;
#define SSD_DPP(v_, ctrl_, rmask_, bc_) __builtin_bit_cast(float, __builtin_amdgcn_update_dpp(0, __builtin_bit_cast(int, v_), ctrl_, rmask_, 0xf, bc_))
#define SSD_SCAN(v_) do { v_ += SSD_DPP(v_, 0x111, 0xf, true); v_ += SSD_DPP(v_, 0x112, 0xf, true); v_ += SSD_DPP(v_, 0x114, 0xf, true); v_ += SSD_DPP(v_, 0x118, 0xf, true); \
                v_ += SSD_DPP(v_, 0x142, 0xa, false); v_ += SSD_DPP(v_, 0x143, 0xc, false); } while (0)
            SSD_SCAN(s0); SSD_SCAN(s1);
#undef SSD_SCAN
#undef SSD_DPP
            s1 += __builtin_bit_cast(float, __builtin_amdgcn_readlane(__builtin_bit_cast(int, s0), 63));
            dtv[q * 128 + lane] = d0; dtv[q * 128 + 64 + lane] = d1; acs[q * 128 + lane] = s0; acs[q * 128 + 64 + lane] = s1;
        }
        __syncthreads();
        {
            const int lane = opaque_tid() & 63, r32 = lane & 31, hi = lane >> 5, g16 = (lane >> 4) & 1, tq = (lane & 15) >> 2, tp = lane & 3;
            bf16* Zb = (bf16*)(a.ws + WS_Z);
            v4u zv[2][2];
#pragma unroll
            for (int pb = 0; pb < 2; ++pb)
#pragma unroll
                for (int i = 0; i < 2; ++i) zv[pb][i] = *(const GAS v4u*)(Zb + (tok0 + t0 + 32 * wl + 16 * i + (lane >> 2)) * DIN + 64 * hd + 32 * pb + (lane & 3) * 8);
            bf16x8 cf[8];
            const LAS unsigned char* cp = lds + SSD_CS + (32 * wl + r32) * SSD_LD + 16 * hi;
#pragma unroll
            for (int ks = 0; ks < 8; ++ks) cf[ks] = *(const LAS bf16x8*)(cp + 32 * ks);
            f32x16 acc[2];
#pragma unroll
            for (int pb = 0; pb < 2; ++pb) {
#pragma unroll
                for (int r = 0; r < 16; ++r) acc[pb][r] = 0.f;
                const LAS unsigned char* sp = lds + SSD_ST + (hh * 64 + 32 * pb + r32) * SSD_LD + 16 * hi;
#pragma unroll
                for (int ks = 0; ks < 8; ++ks) acc[pb] = __builtin_amdgcn_mfma_f32_32x32x16_bf16(cf[ks], *(const LAS bf16x8*)(sp + 32 * ks), acc[pb], 0, 0, 0);
            }
            const LAS float* acsh = acs + hh * 128; const LAS float* dth = dtv + hh * 128;
#pragma unroll
            for (int q = 0; q < 4; ++q) { const f32x4 av = *(const LAS f32x4*)(acsh + 32 * wl + 8 * q + 4 * hi);
#pragma unroll
                for (int i = 0; i < 4; ++i) { const float e = __expf(av[i]); acc[0][4 * q + i] *= e; acc[1][4 * q + i] *= e; } }
            const int lrow = 32 * wl + r32; const float acs_l = acsh[lrow];
            for (int sb = 0; sb <= wl; ++sb) {
                f32x16 gt;
#pragma unroll
                for (int r = 0; r < 16; ++r) gt[r] = 0.f;
                const LAS unsigned char* bp = lds + SSD_BS + (32 * sb + r32) * SSD_LD + 16 * hi;
#pragma unroll
                for (int ks = 0; ks < 8; ++ks) gt = __builtin_amdgcn_mfma_f32_32x32x16_bf16(*(const LAS bf16x8*)(bp + 32 * ks), cf[ks], gt, 0, 0, 0);
#pragma unroll
                for (int q = 0; q < 4; ++q) { const f32x4 av = *(const LAS f32x4*)(acsh + 32 * sb + 8 * q + 4 * hi), dv = *(const LAS f32x4*)(dth + 32 * sb + 8 * q + 4 * hi);
#pragma unroll
                    for (int i = 0; i < 4; ++i) { const int r = 4 * q + i, s = 32 * sb + 8 * q + 4 * hi + i;
                        float m = gt[r] * __expf(acs_l - av[i]) * dv[i];
                        if (s == lrow) m += Dh;
                        gt[r] = (s <= lrow) ? m : 0.f; } }
                u32x4v pw0, pw1;
#pragma unroll
                for (int q = 0; q < 4; ++q) { pw0[q] = pg8::cvt_pk_bf16(gt[2 * q], gt[2 * q + 1]); pw1[q] = pg8::cvt_pk_bf16(gt[8 + 2 * q], gt[9 + 2 * q]); }
#pragma unroll
                for (int pb = 0; pb < 2; ++pb) {
                    const LAS unsigned char* xp = lds + SSD_XS + (32 * sb + 4 * hi + tq) * SSD_LD + (64 * hh + 32 * pb + 16 * g16 + 4 * tp) * 2;
                    acc[pb] = __builtin_amdgcn_mfma_f32_32x32x16_bf16(__builtin_bit_cast(bf16x8, pw0), frag_tr(xp), acc[pb], 0, 0, 0);
                    acc[pb] = __builtin_amdgcn_mfma_f32_32x32x16_bf16(__builtin_bit_cast(bf16x8, pw1), frag_tr(xp + 16 * SSD_LD), acc[pb], 0, 0, 0);
                }
            }
            LAS bf16* stg = (LAS bf16*)(lds + SSD_STG + wid * 2048);
            float sqa[2] = {0.f, 0.f};
#pragma unroll
            for (int pb = 0; pb < 2; ++pb) {
#pragma unroll
                for (int r = 0; r < 16; ++r) stg[crow(r, hi) * 32 + r32] = (bf16)f2bf(acc[pb][r]);
                LDS_WAIT(); asm volatile("" ::: "memory");
#pragma unroll
                for (int i = 0; i < 2; ++i) { const int row = 16 * i + (lane >> 2), c8 = (lane & 3) * 8;
                    float y[8], z[8]; unpack8(*(const LAS v4u*)(stg + row * 32 + c8), y); unpack8(zv[pb][i], z);
                    float sq = 0.f;
#pragma unroll
                    for (int e = 0; e < 8; ++e) { y[e] *= silu_f(z[e]); sq += y[e] * y[e]; }
                    *(GAS v4u*)(Zb + (tok0 + t0 + 32 * wl + row) * DIN + 64 * hd + 32 * pb + c8) = (v4u){pk2(y[0], y[1]), pk2(y[2], y[3]), pk2(y[4], y[5]), pk2(y[6], y[7])};
                    sqa[i] += sq; }
                LDS_WAIT(); asm volatile("" ::: "memory");
            }
#pragma unroll
            for (int i = 0; i < 2; ++i) { float sq = sqa[i];
                sq += __builtin_bit_cast(float, __builtin_amdgcn_update_dpp(0, __builtin_bit_cast(int, sq), 0xB1, 0xf, 0xf, true));
                sq += __builtin_bit_cast(float, __builtin_amdgcn_update_dpp(0, __builtin_bit_cast(int, sq), 0x4E, 0xf, 0xf, true));
                if ((lane & 3) == 0) ((LAS float*)(lds + SSD_GSL))[hh * 128 + 32 * wl + 16 * i + (lane >> 2)] = sq; }
        }
        __syncthreads();
        if (ch + 1 < SEQ / 128) { SSD_PREFETCH(ch + 1); SSD_DTPREFETCH(ch + 1); }
        {
            const int tidc = opaque_tid();
            if (tidc < 128) gss[(size_t)((b * 4 + g) * 4 + (vcu & 3)) * SEQ + t0 + tidc] = ((LAS float*)(lds + SSD_GSL))[tidc] + ((LAS float*)(lds + SSD_GSL))[128 + tidc];
 const int l = tidc >> 2, c0 = (tidc & 3) * 32, hq = c0 >> 6;
            const float f = __expf(acs[hq * 128 + 127] - acs[hq * 128 + l]) * dtv[hq * 128 + l];
            LAS unsigned char* xp = lds + SSD_XS + l * SSD_LD + c0 * 2;
#pragma unroll
            for (int q = 0; q < 4; ++q) { v4u w = *(LAS v4u*)(xp + 16 * q); unsigned ww[4] = {w.x, w.y, w.z, w.w};
#pragma unroll
                for (int i = 0; i < 4; ++i) ww[i] = pk2(__builtin_bit_cast(float, ww[i] << 16) * f, __builtin_bit_cast(float, ww[i] & 0xffff0000u) * f);
                *(LAS v4u*)(xp + 16 * q) = (v4u){ww[0], ww[1], ww[2], ww[3]}; }
        }
        __syncthreads();
        {
            const int lane = opaque_tid() & 63, r32 = lane & 31, hi = lane >> 5, g16 = (lane >> 4) & 1, tq = (lane & 15) >> 2, tp = lane & 3;
            const float eL = __expf(acs[hh * 128 + 127]);
#pragma unroll
            for (int pb = 0; pb < 2; ++pb)
#pragma unroll
                for (int r = 0; r < 16; ++r) stq[pb][r] *= eL;
            const LAS unsigned char* bp = lds + SSD_BS + (4 * hi + tq) * SSD_LD + (32 * wn + 16 * g16 + 4 * tp) * 2;
            const LAS unsigned char* xp = lds + SSD_XS + (4 * hi + tq) * SSD_LD + (64 * hh + 16 * g16 + 4 * tp) * 2;
#pragma unroll
            for (int ks = 0; ks < 8; ++ks) {
                const bf16x8 bt = frag_tr(bp + 16 * ks * SSD_LD);
                stq[0] = __builtin_amdgcn_mfma_f32_32x32x16_bf16(bt, frag_tr(xp + 16 * ks * SSD_LD), stq[0], 0, 0, 0);
                stq[1] = __builtin_amdgcn_mfma_f32_32x32x16_bf16(bt, frag_tr(xp + 16 * ks * SSD_LD + 64), stq[1], 0, 0, 0);
            }
#pragma unroll
            for (int pb = 0; pb < 2; ++pb)
#pragma unroll
                for (int rg = 0; rg < 4; ++rg) {
                    typedef unsigned u32x2v __attribute__((ext_vector_type(2)));
                    u32x2v w; w.x = pg8::cvt_pk_bf16(stq[pb][4 * rg], stq[pb][4 * rg + 1]); w.y = pg8::cvt_pk_bf16(stq[pb][4 * rg + 2], stq[pb][4 * rg + 3]);
                    *(LAS u32x2v*)(lds + SSD_ST + (hh * 64 + 32 * pb + r32) * SSD_LD + (32 * wn + 8 * rg + 4 * hi) * 2) = w;
                }
        }
        __syncthreads();
    }
}


#ifndef MK_ONE_LAUNCH
#define MK_ONE_LAUNCH 1
#endif
constexpr int N_PHASES = 24;
#ifndef MK_PROG
#define MK_PROG {0, 1, 25, 2, 4, 6, 7, 8, 13, 15, 16, 18, 19, 20}
#endif
__global__ void __launch_bounds__(NWAVES * 64, 2) mk_fwd(Args args) {
    extern __shared__ __attribute__((aligned(16))) unsigned char lds_raw[];
    LAS unsigned char* lds = (LAS unsigned char*)lds_raw;
    const int G = gridDim.x;
    const int vcu = (G % 8 == 0) ? ((int)blockIdx.x % 8) * (G / 8) + (int)blockIdx.x / 8 : (int)blockIdx.x;
    const int NGW = G * NWAVES;
    unsigned char* ws = args.ws;
    gu32* ctl = (gu32*)(ws + WS_CTL);
    for (int u = threadIdx.x; u < (LDS_BYTES - LDSCTL_OFF) / 4; u += NWAVES * 64) ((LAS unsigned*)(lds + LDSCTL_OFF))[u] = 0u;
    __syncthreads();
    volatile LAS unsigned* MISC = (volatile LAS unsigned*)(lds + MISC_OFF);
    XcdBarrier bar; bar.bar = (unsigned*)(ctl + CW_BAR); bar.x = 0; bar.st = nullptr;
    const int ph_lo = __builtin_amdgcn_readfirstlane(args.ph_lo), ph_hi = __builtin_amdgcn_readfirstlane(args.ph_hi);
    const bool multi = (ph_hi - ph_lo) > 1;
    if (multi) bar = xcd_barrier_post((unsigned*)(ctl + CW_BAR), MISC + 8);

    bf16* const XB = (bf16*)(ws + WS_XB); float* const SS0 = (float*)(ws + WS_RSTD);
    float* const SS1 = (float*)(ws + WS_SS1); float* const SS2 = (float*)(ws + WS_SS2); float* const SS3 = (float*)(ws + WS_SS3);
    for (int pi = ph_lo; pi < ph_hi; ++pi) {
        const int ph = args.prog[pi];
        if (ph == 0) prep_phase(args, lds, vcu, NGW);
        else if (ph == 1) {
            pg8::Gemm g{XB, (const bf16*)(ws + WS_WIN), M_TOK, NINP, DM}; pg8::StaticOrder S; S.init(M_TOK, NINP, G, (int)blockIdx.x);
            pg8::EpiInConv E{(bf16*)(ws + WS_Z), (bf16*)(ws + WS_XBC), (float*)(ws + WS_DT), SS0, (bf16*)(ws + WS_XRAW), args.in[3], args.in[4], lds + RING_BYTES};
            pg8::gemm_phase<pg8::EpiInConv, pg8::StaticOrder, true, true>(lds, g, S, E, (float*)(ws + 768 * 1024));
        }
        else if (ph == 25) ssmconv_fixup_phase(args);
        else if (ph == 2) ssd_fast_phase(args, lds, vcu);
        else if (ph == 3) groupnorm_phase(args, vcu, NGW);
        else if (ph == 24) bcconv_phase(args);
        else if (ph == 5 || ph == 12 || ph == 17) rowstat_phase(args.out, XB, SS0, vcu, NGW);
        else if (ph == 13) {
            pg8::Gemm g{XB, (const bf16*)(ws + WS_WKVQ), M_TOK, 3072, DM}; pg8::StaticOrder S; S.init(M_TOK, 3072, G, (int)blockIdx.x);
            pg8::EpiKVQ E{(bf16*)(ws + WS_K), (size_t)(WS_V - WS_K) / 2, SS2, args.in[12], args.in[16], QSCALE};
            static_assert(WS_Q - WS_V == WS_V - WS_K, "K, V, Q equally spaced");
            pg8::gemm_phase<pg8::EpiKVQ, pg8::StaticOrder, true, true>(lds, g, S, E, (float*)(ws + 768 * 1024));
        }
        else if (ph == 14) qknorm_phase(args, vcu, NGW);
        else if (ph == 15) attn_fast_phase(args, lds, vcu);
        else {
            const int ffn_l = (ph >= 18) ? 1 : 0;
            if (ph == 6 || ph == 18) {
                pg8::Gemm g{XB, (const bf16*)(ws + (ffn_l ? WS_WUP1 : WS_WUP0)), M_TOK, FF2, DM}; pg8::StaticOrder S; S.init(M_TOK, FF2, G, (int)blockIdx.x);
                pg8::EpiConvFFN E{(bf16*)(ws + WS_H), (bf16*)(ws + WS_FRAW), ffn_l ? SS3 : SS1, args.in[22] + (size_t)ffn_l * 3 * FF2, args.in[23] + (size_t)ffn_l * FF2, lds + RING_BYTES};
                pg8::gemm_phase<pg8::EpiConvFFN, pg8::StaticOrder, true, true>(lds, g, S, E, (float*)(ws + 768 * 1024));
            } else if (ph == 7 || ph == 19) convffn_fixup_phase(args, ffn_l);
            else {
                const bf16* A; const bf16* Bt; int Kg; const float* basef = nullptr; const bf16* baseb = XB; float* outf = nullptr; bf16* xbp = XB; float* ssp;
                if (ph == 4) { A = (const bf16*)(ws + WS_Z); Bt = (const bf16*)(ws + WS_WOUT); Kg = DIN; basef = args.in[0]; baseb = nullptr; ssp = SS1; }
                else if (ph == 16) { A = (const bf16*)(ws + WS_O); Bt = (const bf16*)(ws + WS_WAO); Kg = DM; ssp = SS3; }
                else { A = (const bf16*)(ws + WS_H); Bt = (const bf16*)(ws + (ffn_l ? WS_WDN1 : WS_WDN0)); Kg = FF; ssp = ffn_l ? nullptr : SS2; if (ffn_l) { outf = args.out; xbp = nullptr; } }
                pg8::Gemm g{A, Bt, M_TOK, DM, Kg}; pg8::StaticOrder S; S.init(M_TOK, DM, G, (int)blockIdx.x);
                pg8::EpiRes E{basef, baseb, outf, xbp, ssp, (ph == 20) ? (const float*)(ws + 768 * 1024) : nullptr, (ph == 4) ? (const float*)(ws + WS_GSS) : nullptr, (PG8_LAS float*)(lds + RING_BYTES)};
                pg8::gemm_phase<pg8::EpiRes, pg8::StaticOrder, true, true>(lds, g, S, E, (float*)(ws + 768 * 1024));
            }
        }
        if (pi + 1 < ph_hi) xcd_barrier(bar);
    }
}

extern "C" void kernel_launch(void* const* d_in, const int* in_sizes, int n_in, void* d_out, int out_size, void* d_ws, size_t ws_size, hipStream_t stream) {
    static int grid = 0;
    if (grid == 0) {
        if (n_in != 25 || in_sizes[0] != M_TOK * DM || out_size != M_TOK * DM || ws_size < WS_END) {
            fprintf(stderr, "kernel_launch: unexpected problem (n_in %d, in0 %d, out %d, ws %zu)\n", n_in, n_in > 0 ? in_sizes[0] : -1, out_size, ws_size); grid = -1; return; }
        int dev = 0, cus = 0, per_cu = 0;
        if (hipGetDevice(&dev) != hipSuccess || hipDeviceGetAttribute(&cus, hipDeviceAttributeMultiprocessorCount, dev) != hipSuccess) { grid = -1; return; }
        if (hipFuncSetAttribute((const void*)mk_fwd, hipFuncAttributeMaxDynamicSharedMemorySize, LDS_BYTES) != hipSuccess) { fprintf(stderr, "kernel_launch: hipFuncSetAttribute failed\n"); grid = -1; return; }
        if (hipOccupancyMaxActiveBlocksPerMultiprocessor(&per_cu, (const void*)mk_fwd, NWAVES * 64, LDS_BYTES) != hipSuccess || per_cu < 1)
            fprintf(stderr, "kernel_launch: occupancy query reports %d blocks per CU\n", per_cu);
        (void)hipGetLastError();
        grid = cus;
        if (grid != 256) { fprintf(stderr, "kernel_launch: built for a 256-CU device, found %d CUs\n", cus); grid = -1; return; }
    }
    if (grid < 0) return;
    if (hipMemsetAsync((char*)d_ws + WS_CTL, 0, CTL_ZERO_BYTES, stream) != hipSuccess) { fprintf(stderr, "kernel_launch: memset failed\n"); return; }
    Args a{};
    for (int i = 0; i < 25; ++i) a.in[i] = (const float*)d_in[i];
    a.out = (float*)d_out; a.ws = (unsigned char*)d_ws;
#ifndef MK_PROG
#define MK_PROG {0, 1, 2, 3, 4, 5, 6, 7, 8, 9, 10, 11, 12, 13, 14, 15, 16, 17, 18, 19, 20, 21, 22, 23}
#endif
    static const unsigned char prog_[] = MK_PROG; const int nprog = (int)sizeof(prog_);
    for (int i = 0; i < nprog && i < 64; ++i) a.prog[i] = prog_[i];
#if MK_ONE_LAUNCH
    a.ph_lo = 0; a.ph_hi = nprog;
    hipLaunchKernelGGL(mk_fwd, dim3(grid), dim3(NWAVES * 64), LDS_BYTES, stream, a);
#else
    for (int ph = 0; ph < nprog; ++ph) { a.ph_lo = ph; a.ph_hi = ph + 1; hipLaunchKernelGGL(mk_fwd, dim3(grid), dim3(NWAVES * 64), LDS_BYTES, stream, a); }
#endif
    const hipError_t le = hipPeekAtLastError();
    if (le != hipSuccess) fprintf(stderr, "kernel_launch: launch failed: %s\n", hipGetErrorName(le));
}
```

```cpp
#include <hip/hip_runtime.h>
#include <hip/hip_bf16.h>
#include <cstdio>
#include <cstdint>
#include <cmath>
__device__ __forceinline__ int opaque_tid() { int t = threadIdx.x; asm volatile("" : "+v"(t)); return t; }
__device__ __forceinline__ float shfl_xor_f(float v, int m) { int l_; asm volatile("v_mbcnt_lo_u32_b32 %0, -1, 0\n\tv_mbcnt_hi_u32_b32 %0, -1, %0" : "=v"(l_));
    return __builtin_bit_cast(float, __builtin_amdgcn_ds_bpermute((l_ ^ m) << 2, __builtin_bit_cast(int, v))); }
#ifndef ATT_REPS
#define ATT_REPS 2
#endif
#ifndef SSD_Y2XBC
#define SSD_Y2XBC 1
#endif
#ifndef SSD_SKEW_CYCLES
#define SSD_SKEW_CYCLES 25000
#endif
#define MK_ONE_LAUNCH 1

namespace pg8 {
#define PG8_LAS __attribute__((address_space(3)))
typedef unsigned short bf16_t;
typedef short bf16x8 __attribute__((ext_vector_type(8)));
typedef float f32x4 __attribute__((ext_vector_type(4)));
typedef unsigned u32x4 __attribute__((ext_vector_type(4)));
constexpr int BM = 256, BK = 64, HALF = 128, HTB = HALF * BK * 2  , STAGE_BYTES = 8 * HTB, NXCD = 8, WGM = 8;

__host__ __device__ __forceinline__ int lds_byte(int r, int c) { const int st = (r >> 4) * 2 + (c >> 5), rr = r & 15, cc = c & 31, ob = rr * 64 + cc * 2; return st * 1024 + (ob ^ (((ob >> 9) & 1) << 5)); }
__host__ __device__ __forceinline__ void stage_rc(int b, int& R, int& C) { const int st = b / 1024, sb = b % 1024, swz = sb ^ (((sb >> 9) & 1) << 5); R = (st >> 1) * 16 + swz / 64; C = (st & 1) * 32 + (swz % 64) / 2; }
__host__ __device__ __forceinline__ int perm32(int rho) { const int n = rho >> 4, i = rho & 15; return 8 * (i >> 2) + 4 * n + (i & 3); }

struct Unit { int pm, pn, ui; };
struct Gemm { const bf16_t* A; const bf16_t* Bt; int M, N, K; };

struct StaticOrder {
    int nM, nN, nwg, G, c;
    __host__ __device__ void init(int M, int N, int G_, int c_) { nM = M / BM; nN = N / BM; nwg = nM * nN; G = G_; c = c_; }
    __host__ __device__ bool next(int i, Unit& u) const {
        const long L = (long)i * G + c; if (L >= nwg) return false;
        int wgid = (int)L; { const int q = nwg / NXCD, r = nwg % NXCD, xcd = wgid % NXCD, off = wgid / NXCD; wgid = (xcd < r ? xcd * (q + 1) : r * (q + 1) + (xcd - r) * q) + off; }
        const int nig = WGM * nN, gid = wgid / nig, fm = gid * WGM, gsz = (nM - fm) < WGM ? (nM - fm) : WGM;
        u.pm = fm + ((wgid % nig) % gsz); u.pn = (wgid % nig) / gsz; return true;
    }
    __device__ __forceinline__ void a_ready(const Unit&) const {}
    __device__ __forceinline__ void done(const Unit&) const {}
};
__device__ __forceinline__ unsigned cvt_pk_bf16(float lo, float hi) { unsigned r; asm volatile("v_cvt_pk_bf16_f32 %0, %1, %2" : "=v"(r) : "v"(lo), "v"(hi)); return r; }
typedef float f32x2 __attribute__((ext_vector_type(2)));
template <class Epi, class Sched, bool ALIGN_EPI = false, bool SP2 = false>
__device__ __forceinline__ void gemm_phase(PG8_LAS unsigned char* lds, const Gemm g, const Sched& S, const Epi& E, float* probe_slot_ = nullptr) {
    const int tid = opaque_tid(), wid = __builtin_amdgcn_readfirstlane(tid >> 6), lane = tid & 63, wr = wid >> 2, wc = wid & 3, fr = lane & 15, fq = lane >> 4;
    const int K = g.K, nt = K / BK;
    unsigned voffA[2], voffB[2];
#pragma unroll
    for (int i = 0; i < 2; ++i) { int R, C; stage_rc(tid * 16 + i * 8192, R, C); const int Rb = Epi::PERM ? ((R & ~31) + perm32(R & 31)) : R;
        voffA[i] = (unsigned)(R * K + C) * 2u; voffB[i] = (unsigned)(Rb * K + C) * 2u; }
    const size_t kstep = (size_t)(BK * 2);
    const size_t hstep = (size_t)HALF * K * 2;
    const size_t tstep = 2 * hstep;
    const unsigned ldsw = (unsigned)wid * 1024u;
    const unsigned lds0_ = (unsigned)__builtin_amdgcn_readfirstlane((int)((unsigned)(uintptr_t)lds + ldsw));
    const int aoff = lds_byte(wr * 64 + fr, fq * 8), boff = lds_byte(wc * 32 + fr, fq * 8);
#define PG8_SA(b, h) (((b) * 2 + (h)) * HTB)
#define PG8_SB(b, h) ((4 + (b) * 2 + (h)) * HTB)
#define PG8_STAGE(bufoff, gbase, voff) do { _Pragma("unroll") for (int _i = 0; _i < 2; ++_i) { unsigned keep_; \
        asm volatile("s_mov_b32 m0, %2\n\ts_nop 0\n\tglobal_load_lds_dwordx4 %0, %1" \
            :: "v"((voff)[_i]), "s"((const char*)(gbase)), "s"(lds0_ + (unsigned)((bufoff) + _i * 8192)) : "memory", "m0"); (void)keep_; } } while (0)
#define PG8_LDA(dst, b, h) do { _Pragma("unroll") for (int m = 0; m < 4; ++m) _Pragma("unroll") for (int k = 0; k < 2; ++k) dst[m][k] = *(const PG8_LAS bf16x8*)(lds + PG8_SA(b, h) + aoff + m * 2048 + k * 1024); } while (0)
#define PG8_LDB(dst, b, h) do { _Pragma("unroll") for (int n = 0; n < 2; ++n) _Pragma("unroll") for (int k = 0; k < 2; ++k) dst[n][k] = *(const PG8_LAS bf16x8*)(lds + PG8_SB(b, h) + boff + n * 2048 + k * 1024); } while (0)
#define PG8_MMA(ai, bj, At, Bt) do { __builtin_amdgcn_s_setprio(1); _Pragma("unroll") for (int m = 0; m < 4; ++m) _Pragma("unroll") for (int n = 0; n < 2; ++n) _Pragma("unroll") for (int k = 0; k < 2; ++k) \
        acc[ai][bj][m][n] = __builtin_amdgcn_mfma_f32_16x16x32_bf16(Bt[n][k], At[m][k], acc[ai][bj][m][n], 0, 0, 0); __builtin_amdgcn_s_setprio(0); } while (0)
#define PG8_WAIT_V(n) asm volatile("s_waitcnt vmcnt(" #n ")" ::: "memory")
#define PG8_WAIT_L(n) asm volatile("s_waitcnt lgkmcnt(" #n ")" ::: "memory")
#define PG8_BAR __builtin_amdgcn_s_barrier()
#define PG8_SCHED __builtin_amdgcn_sched_barrier(0)
#ifdef PROBE_G
#endif
    Unit cur, nxt; int ui = 0;
    if (!S.next(0, cur)) return;
    cur.ui = 0;
    f32x4 acc[2][2][4][2];
#pragma unroll
    for (int a = 0; a < 2; ++a)
#pragma unroll
        for (int b = 0; b < 2; ++b)
#pragma unroll
            for (int m = 0; m < 4; ++m)
#pragma unroll
                for (int n = 0; n < 2; ++n) acc[a][b][m][n] = (f32x4){0.f, 0.f, 0.f, 0.f};
    bf16x8 At[4][2], B0[2][2], B1[2][2];
    const char* cA = (const char*)g.A + (size_t)cur.pm * tstep; const char* cB = (const char*)g.Bt + (size_t)cur.pn * tstep;
    S.a_ready(cur);
    if constexpr (SP2) {
        PG8_STAGE(PG8_SB(0, 0), cB, voffB); PG8_STAGE(PG8_SB(0, 1), cB + hstep, voffB); PG8_STAGE(PG8_SA(0, 0), cA, voffA); PG8_STAGE(PG8_SA(0, 1), cA + hstep, voffA);
        if (wr == 1) PG8_BAR;
        PG8_WAIT_V(2); PG8_BAR;
        PG8_STAGE(PG8_SB(1, 0), cB + kstep, voffB); PG8_STAGE(PG8_SA(1, 0), cA + kstep, voffA); PG8_STAGE(PG8_SB(1, 1), cB + hstep + kstep, voffB);
        PG8_WAIT_V(6); PG8_BAR;
    } else {
        PG8_STAGE(PG8_SB(0, 0), cB, voffB); PG8_STAGE(PG8_SA(0, 0), cA, voffA); PG8_STAGE(PG8_SB(0, 1), cB + hstep, voffB); PG8_STAGE(PG8_SA(0, 1), cA + hstep, voffA);
        if (wr == 1) PG8_BAR;
        PG8_WAIT_V(4); PG8_BAR;
        PG8_STAGE(PG8_SB(1, 0), cB + kstep, voffB); PG8_STAGE(PG8_SA(1, 0), cA + kstep, voffA); PG8_STAGE(PG8_SB(1, 1), cB + hstep + kstep, voffB);
        PG8_WAIT_V(6); PG8_BAR;
    }
    for (;;) {
        const bool has_next = S.next(ui + 1, nxt); nxt.ui = ui + 1;
        const char* nA = has_next ? (const char*)g.A + (size_t)nxt.pm * tstep : cA; const char* nB = has_next ? (const char*)g.Bt + (size_t)nxt.pn * tstep : cB;
        for (int t = 0; t < nt; t += 2) {
            if constexpr (Epi::KSCALE) { if (t == 0) E.kbegin(cur, tid); else if ((t & 7) == 0) E.krescale(acc, cur, t >> 3, wr, fr); }
            const bool last = (t == nt - 2);
            const char* a1 = cA + (size_t)(t + 1) * kstep;
            const char* a2 = last ? nA : cA + (size_t)(t + 2) * kstep; const char* b2 = last ? nB : cB + (size_t)(t + 2) * kstep;
            const char* a3 = a2 + kstep; const char* b3 = b2 + kstep;
            if (last && has_next) S.a_ready(nxt);
            if constexpr (SP2) {
            PG8_LDB(B0, 0, 0); PG8_LDB(B1, 0, 1); PG8_SCHED; PG8_LDA(At, 0, 0); PG8_STAGE(PG8_SA(1, 1), a1 + hstep, voffA);
            PG8_WAIT_V(8); PG8_WAIT_L(0); PG8_BAR; PG8_MMA(0, 0, At, B0); PG8_MMA(0, 1, At, B1); PG8_BAR; PG8_SCHED;
            PG8_LDA(At, 0, 1); PG8_STAGE(PG8_SB(0, 0), b2, voffB); PG8_STAGE(PG8_SB(0, 1), b2 + hstep, voffB); PG8_STAGE(PG8_SA(0, 0), a2, voffA);
            PG8_WAIT_V(8); PG8_WAIT_L(0); PG8_BAR; PG8_MMA(1, 0, At, B0); PG8_MMA(1, 1, At, B1); PG8_BAR; PG8_SCHED;
            PG8_LDB(B0, 1, 0); PG8_LDB(B1, 1, 1); PG8_SCHED; PG8_LDA(At, 1, 0); PG8_STAGE(PG8_SA(0, 1), a2 + hstep, voffA);
            PG8_WAIT_V(8); PG8_WAIT_L(0); PG8_BAR; PG8_MMA(0, 0, At, B0); PG8_MMA(0, 1, At, B1); PG8_BAR; PG8_SCHED;
            PG8_LDA(At, 1, 1); PG8_STAGE(PG8_SB(1, 0), b3, voffB); PG8_STAGE(PG8_SB(1, 1), b3 + hstep, voffB); PG8_STAGE(PG8_SA(1, 0), a3, voffA);
            PG8_WAIT_V(8); PG8_WAIT_L(0); PG8_BAR; PG8_MMA(1, 0, At, B0); PG8_MMA(1, 1, At, B1); PG8_BAR; PG8_SCHED;
            } else {
            PG8_LDB(B0, 0, 0); PG8_SCHED; PG8_LDA(At, 0, 0); PG8_STAGE(PG8_SA(1, 1), a1 + hstep, voffA);
            PG8_WAIT_L(8); PG8_BAR; PG8_WAIT_L(0); PG8_MMA(0, 0, At, B0); PG8_BAR; PG8_SCHED;
            PG8_LDB(B1, 0, 1); PG8_STAGE(PG8_SB(0, 0), b2, voffB);
            PG8_BAR; PG8_WAIT_L(0); PG8_MMA(0, 1, At, B1); PG8_BAR;
            PG8_LDA(At, 0, 1); PG8_STAGE(PG8_SA(0, 0), a2, voffA);
            PG8_BAR; PG8_WAIT_L(0); PG8_MMA(1, 0, At, B0); PG8_BAR; PG8_SCHED;
            PG8_STAGE(PG8_SB(0, 1), b2 + hstep, voffB);
            PG8_WAIT_V(6); PG8_BAR; PG8_MMA(1, 1, At, B1); PG8_BAR;
            PG8_LDB(B0, 1, 0); PG8_SCHED; PG8_LDA(At, 1, 0); PG8_STAGE(PG8_SA(0, 1), a2 + hstep, voffA);
            PG8_WAIT_L(8); PG8_BAR; PG8_WAIT_L(0); PG8_MMA(0, 0, At, B0); PG8_BAR; PG8_SCHED;
            PG8_LDB(B1, 1, 1); PG8_STAGE(PG8_SB(1, 0), b3, voffB);
            PG8_BAR; PG8_WAIT_L(0); PG8_MMA(0, 1, At, B1); PG8_BAR;
            PG8_LDA(At, 1, 1); PG8_STAGE(PG8_SA(1, 0), a3, voffA);
            PG8_BAR; PG8_WAIT_L(0); PG8_MMA(1, 0, At, B0); PG8_BAR; PG8_SCHED;
            PG8_STAGE(PG8_SB(1, 1), b3 + hstep, voffB);
            PG8_WAIT_V(6); PG8_BAR; PG8_MMA(1, 1, At, B1); PG8_BAR;
            }
        }
        if constexpr (ALIGN_EPI) { if (wr == 0) PG8_BAR; }
#ifdef PROBE_G
        const long long te0_ = __builtin_amdgcn_s_memrealtime();
#endif
        if constexpr (!Epi::AFTER_DRAIN) { E(acc, cur, wr, wc, fr, fq); S.done(cur); }
#ifdef PROBE_G
        if (Epi::PROBE_ID == PROBE_G) { const long long now_ = __builtin_amdgcn_s_memrealtime(), tgt_ = now_ + PROBE_GK * (now_ - te0_);
            while ((long long)__builtin_amdgcn_s_memrealtime() < tgt_) __builtin_amdgcn_s_sleep(4); }
#endif
        if (!has_next) break;
#pragma unroll
        for (int a = 0; a < 2; ++a)
#pragma unroll
            for (int b = 0; b < 2; ++b)
#pragma unroll
                for (int m = 0; m < 4; ++m)
#pragma unroll
                    for (int n = 0; n < 2; ++n) acc[a][b][m][n] = (f32x4){0.f, 0.f, 0.f, 0.f};
        cur = nxt; cA = nA; cB = nB; ++ui;
        if constexpr (ALIGN_EPI) { if (wr == 1) PG8_BAR; }
    }
    PG8_WAIT_V(0);
    if constexpr (!ALIGN_EPI) { if (wr == 0) PG8_BAR; }
    PG8_BAR;
    if constexpr (Epi::AFTER_DRAIN) { E.fused(acc, cur, wr, wc, fr, fq, lds, wid, lane); S.done(cur); }
#ifdef PROBE_G
#endif
#undef PG8_SA
#undef PG8_SB
#undef PG8_STAGE
#undef PG8_LDA
#undef PG8_LDB
#undef PG8_MMA
#undef PG8_WAIT_V
#undef PG8_WAIT_L
#undef PG8_BAR
#undef PG8_SCHED
}
}

namespace pg8 {
typedef unsigned u32x2 __attribute__((ext_vector_type(2)));
__device__ __forceinline__ u32x4 pack8(const f32x4& v0, const f32x4& v1) {
    u32x4 w; w.x = cvt_pk_bf16(v0[0], v0[1]); w.y = cvt_pk_bf16(v0[2], v0[3]); w.z = cvt_pk_bf16(v1[0], v1[1]); w.w = cvt_pk_bf16(v1[2], v1[3]); return w;
}
struct EpiIn {
    static constexpr int PROBE_ID = 1;
    static constexpr bool PERM = true, AFTER_DRAIN = false, KSCALE = false;
    bf16_t* Z; bf16_t* XBC; float* DT; const float* rstd;
    __device__ __forceinline__ void operator()(const f32x4 (&acc)[2][2][4][2], const Unit& u, int wr, int wc, int fr, int fq) const {
        const int row0 = u.pm * BM + wr * 64 + fr, c8 = wc * 32 + 8 * fq;
        float rsv[2][4];
#pragma unroll
        for (int ai = 0; ai < 2; ++ai)
#pragma unroll
            for (int m = 0; m < 4; ++m) rsv[ai][m] = rstd[row0 + ai * HALF + m * 16];
        asm volatile("" : "+v"(rsv[0][0]), "+v"(rsv[0][1]), "+v"(rsv[0][2]), "+v"(rsv[0][3]), "+v"(rsv[1][0]), "+v"(rsv[1][1]), "+v"(rsv[1][2]), "+v"(rsv[1][3]));
#pragma unroll
        for (int ai = 0; ai < 2; ++ai)
#pragma unroll
            for (int m = 0; m < 4; ++m) {
                const int row = row0 + ai * HALF + m * 16; const float rs = 1.f / sqrtf(rsv[ai][m] * (1.f / 1024.f) + 1e-6f);
#pragma unroll
                for (int bj = 0; bj < 2; ++bj) {
                    const f32x4 v0 = acc[ai][bj][m][0] * rs, v1 = acc[ai][bj][m][1] * rs;
                    if (u.pn < 8) *(u32x4*)(Z + (size_t)row * 2048 + u.pn * 256 + bj * HALF + c8) = pack8(v0, v1);
                    else if (u.pn < 20) *(u32x4*)(XBC + (size_t)row * 3072 + (u.pn - 8) * 256 + bj * HALF + c8) = pack8(v0, v1);
                    else if (bj == 0 && wc == 0) { float* d = DT + (size_t)row * 32 + 8 * fq; *(f32x4*)d = v0; *(f32x4*)(d + 4) = v1; }
                }
            }
    }
};
struct EpiRes {
    static constexpr int PROBE_ID = 2;
    static constexpr bool PERM = true, AFTER_DRAIN = false, KSCALE = true;
    const float* basef; const bf16_t* baseb; float* outf; bf16_t* xb; float* ss; const float* probe; const float* gss; PG8_LAS float* gtab;
    __device__ __forceinline__ void kbegin(const Unit& u, int tid) const {
        if (!gss) return;
        tid = opaque_tid();
        const int row = tid & 255, gh = tid >> 8;
        const f32x4* gp = (const f32x4*)(gss + (size_t)(u.pm * BM + row) * 16 + gh * 8);
        const f32x4 p0 = gp[0], p1 = gp[1];
        const float v0 = ((p0[0] + p0[1]) + (p0[2] + p0[3])) * (1.f / 512.f) + 1e-6f, v1 = ((p1[0] + p1[1]) + (p1[2] + p1[3])) * (1.f / 512.f) + 1e-6f;
        PG8_LAS float* tp = gtab + (((u.ui & 1) * 4 + 2 * gh) * 256 + row) * 2;
        tp[0] = __builtin_amdgcn_sqrtf(v0); tp[1] = __builtin_amdgcn_rsqf(v0); tp[512] = __builtin_amdgcn_sqrtf(v1); tp[513] = __builtin_amdgcn_rsqf(v1);
    }
    __device__ __forceinline__ void krescale(f32x4 (&acc)[2][2][4][2], const Unit& u, int g, int wr, int fr) const {
        if (!gss) return;
        const PG8_LAS float* tp = gtab + (((u.ui & 1) * 4 + g) * 256 + wr * 64 + fr) * 2;
#pragma unroll
        for (int ai = 0; ai < 2; ++ai)
#pragma unroll
            for (int m = 0; m < 4; ++m) { const float ratio = tp[(ai * HALF + m * 16) * 2] * tp[(ai * HALF + m * 16) * 2 - 511];
#pragma unroll
                for (int bj = 0; bj < 2; ++bj)
#pragma unroll
                    for (int n = 0; n < 2; ++n) acc[ai][bj][m][n] *= ratio; }
    }
    __device__ __forceinline__ void ldbase(size_t off, f32x4& lo, f32x4& hi) const {
        if (basef) { lo = *(const f32x4*)(basef + off); hi = *(const f32x4*)(basef + off + 4); return; }
        const u32x4 w = *(const u32x4*)(baseb + off);
        lo = (f32x4){__builtin_bit_cast(float, w.x << 16), __builtin_bit_cast(float, w.x & 0xffff0000u), __builtin_bit_cast(float, w.y << 16), __builtin_bit_cast(float, w.y & 0xffff0000u)};
        hi = (f32x4){__builtin_bit_cast(float, w.z << 16), __builtin_bit_cast(float, w.z & 0xffff0000u), __builtin_bit_cast(float, w.w << 16), __builtin_bit_cast(float, w.w & 0xffff0000u)};
    }
    __device__ __forceinline__ void operator()(const f32x4 (&acc)[2][2][4][2], const Unit& u, int wr, int wc, int fr, int fq) const {
        const int row0 = u.pm * BM + wr * 64 + fr, col0 = u.pn * BM + wc * 32 + 8 * fq;
        f32x4 bs[3][2][2];
#pragma unroll
        for (int q = 0; q < 2; ++q)
#pragma unroll
            for (int bj = 0; bj < 2; ++bj) ldbase((size_t)(row0 + q * 16) * 1024 + col0 + bj * HALF, bs[q][bj][0], bs[q][bj][1]);
#pragma unroll
        for (int gi = 0; gi < 8; ++gi) {
            const int ai = gi >> 2, m = gi & 3;
            const size_t off = (size_t)(row0 + ai * HALF + m * 16) * 1024 + col0;
            if (gi < 6) { const size_t offn = (size_t)(row0 + ((gi + 2) >> 2) * HALF + ((gi + 2) & 3) * 16) * 1024 + col0;
#pragma unroll
                for (int bj = 0; bj < 2; ++bj) ldbase(offn + bj * HALF, bs[(gi + 2) % 3][bj][0], bs[(gi + 2) % 3][bj][1]); }
            float s = 0.f;
            const float r3 = gss ? gtab[(((u.ui & 1) * 4 + 3) * 256 + wr * 64 + fr + ai * HALF + m * 16) * 2 + 1] : 1.f;
#pragma unroll
            for (int bj = 0; bj < 2; ++bj) {
                f32x4 o0 = bs[gi % 3][bj][0] + acc[ai][bj][m][0] * r3, o1 = bs[gi % 3][bj][1] + acc[ai][bj][m][1] * r3;
#ifdef PROBE_T
                if (probe && gi == 0 && bj == 0 && row0 == 0 && col0 == 0) o0[0] += 0.08f + 0.2f * probe[0];
#endif
                if (outf) { *(f32x4*)(outf + off + bj * HALF) = o0; *(f32x4*)(outf + off + bj * HALF + 4) = o1; }
                if (xb) { u32x4 w; w.x = cvt_pk_bf16(o0[0], o0[1]); w.y = cvt_pk_bf16(o0[2], o0[3]); w.z = cvt_pk_bf16(o1[0], o1[1]); w.w = cvt_pk_bf16(o1[2], o1[3]); *(u32x4*)(xb + off + bj * HALF) = w; }
                s += ((o0[0] * o0[0] + o0[1] * o0[1]) + (o0[2] * o0[2] + o0[3] * o0[3])) + ((o1[0] * o1[0] + o1[1] * o1[1]) + (o1[2] * o1[2] + o1[3] * o1[3])); }
            if (ss) { s += shfl_xor_f(s, 16); s += shfl_xor_f(s, 32); if (fq == 0) atomicAdd(ss + row0 + ai * HALF + m * 16, s); }
            asm volatile("" ::: "memory");
        }
    }
};
struct EpiScale {
    static constexpr int PROBE_ID = 3;
    static constexpr bool PERM = true, AFTER_DRAIN = false, KSCALE = false;
    bf16_t* O; int ldc; const float* rstd;
    __device__ __forceinline__ void operator()(const f32x4 (&acc)[2][2][4][2], const Unit& u, int wr, int wc, int fr, int fq) const {
        const int row0 = u.pm * BM + wr * 64 + fr, c8 = u.pn * BM + wc * 32 + 8 * fq;
#pragma unroll
        for (int ai = 0; ai < 2; ++ai)
#pragma unroll
            for (int m = 0; m < 4; ++m) {
                const int row = row0 + ai * HALF + m * 16; const float rs = 1.f / sqrtf(rstd[row] * (1.f / 1024.f) + 1e-6f);
#pragma unroll
                for (int bj = 0; bj < 2; ++bj) *(u32x4*)(O + (size_t)row * ldc + bj * HALF + c8) = pack8(acc[ai][bj][m][0] * rs, acc[ai][bj][m][1] * rs);
            }
    }
};
struct EpiKVQ {
    static constexpr int PROBE_ID = 4;
    static constexpr bool PERM = true, AFTER_DRAIN = false, KSCALE = false;
    bf16_t* Kb; size_t tstride; const float* rstd; const float* kg; const float* qg; float qscale;
    __device__ __forceinline__ void operator()(const f32x4 (&acc)[2][2][4][2], const Unit& u, int wr, int wc, int fr, int fq) const {
        const int row0 = u.pm * BM + wr * 64 + fr, t = u.pn >> 2;
        bf16_t* base = Kb + (size_t)t * tstride + (u.pn & 3) * BM + 64 * wc + 8 * fq;
        f32x4 g[2][2];
        const float* gp = (t == 2) ? qg : kg; const float sc = (t == 2) ? qscale : 1.f;
#pragma unroll
        for (int bj = 0; bj < 2; ++bj)
#pragma unroll
            for (int n = 0; n < 2; ++n) g[bj][n] = (t == 1) ? (f32x4){1.f, 1.f, 1.f, 1.f} : *(const f32x4*)(gp + 32 * bj + 8 * fq + 4 * n) * sc;
        float rsv[2][4];
#pragma unroll
        for (int ai = 0; ai < 2; ++ai)
#pragma unroll
            for (int m = 0; m < 4; ++m) rsv[ai][m] = rstd[row0 + ai * HALF + m * 16];
        asm volatile("" : "+v"(rsv[0][0]), "+v"(rsv[0][1]), "+v"(rsv[0][2]), "+v"(rsv[0][3]), "+v"(rsv[1][0]), "+v"(rsv[1][1]), "+v"(rsv[1][2]), "+v"(rsv[1][3]));
#pragma unroll
        for (int ai = 0; ai < 2; ++ai)
#pragma unroll
            for (int m = 0; m < 4; ++m) {
                const int row = row0 + ai * HALF + m * 16; const float rs = 1.f / sqrtf(rsv[ai][m] * (1.f / 1024.f) + 1e-6f);
                f32x4 v[2][2]; float s = 0.f;
#pragma unroll
                for (int bj = 0; bj < 2; ++bj)
#pragma unroll
                    for (int n = 0; n < 2; ++n) { v[bj][n] = acc[ai][bj][m][n] * rs; s += (v[bj][n][0] * v[bj][n][0] + v[bj][n][1] * v[bj][n][1]) + (v[bj][n][2] * v[bj][n][2] + v[bj][n][3] * v[bj][n][3]); }
                s += shfl_xor_f(s, 16); s += shfl_xor_f(s, 32);
                const float rq = (t == 1) ? 1.f : 1.f / sqrtf(s * (1.f / 64.f) + 1e-6f);
#pragma unroll
                for (int bj = 0; bj < 2; ++bj) *(u32x4*)(base + (size_t)row * 1024 + 32 * bj) = pack8(v[bj][0] * rq * g[bj][0], v[bj][1] * rq * g[bj][1]);
            }
    }
};

struct EpiConvFFN {
    static constexpr int PROBE_ID = 5;
    static constexpr bool PERM = true, AFTER_DRAIN = false, KSCALE = false;
    bf16_t* H; bf16_t* raw; const float* ss; const float* cw; const float* cb; PG8_LAS unsigned char* xl;
    static constexpr int RP = 144, SLAB = 18 * RP, HALO_OFF = 8 * SLAB;
    __device__ __forceinline__ void operator()(const f32x4 (&acc)[2][2][4][2], const Unit& u, int wr, int wc, int fr, int fq) const {
        const int lane = opaque_tid() & 63  , c = lane & 31, hf = lane >> 5, c2 = lane & 15, hq = lane >> 4, wid = wr * 4 + wc;
        PG8_LAS unsigned char* slab = xl + wid * SLAB;
        PG8_LAS unsigned char* halo = xl + HALO_OFF;
        const int chg = 128 * u.pn + 32 * wc + 2 * c2;
        typedef float f32x2v __attribute__((ext_vector_type(2)));
        const f32x2v wg0 = *(const f32x2v*)(cw + chg), wg1 = *(const f32x2v*)(cw + 5632 + chg), wg2 = *(const f32x2v*)(cw + 2 * 5632 + chg), bg = *(const f32x2v*)(cb + chg);
        const f32x2v wu0 = *(const f32x2v*)(cw + 2816 + chg), wu1 = *(const f32x2v*)(cw + 5632 + 2816 + chg), wu2 = *(const f32x2v*)(cw + 2 * 5632 + 2816 + chg), bu = *(const f32x2v*)(cb + 2816 + chg);
        const int row0 = u.pm * BM + wr * 64 + fr;
        float rsv[2][4];
#pragma unroll
        for (int ai = 0; ai < 2; ++ai)
#pragma unroll
            for (int m = 0; m < 4; ++m) rsv[ai][m] = ss[row0 + ai * HALF + m * 16];
#pragma unroll
        for (int ai = 0; ai < 2; ++ai)
#pragma unroll
            for (int m = 0; m < 4; ++m) rsv[ai][m] = 1.f / sqrtf(rsv[ai][m] * (1.f / 1024.f) + 1e-6f);
        bf16_t* rawp = raw + ((size_t)u.pm * 4 * 22 + u.pn) * 256 + wc * 64 + 8 * fq;
#pragma unroll
        for (int ai = 0; ai < 2; ++ai) {
            if (fr >= 14) {
                const float rs = rsv[ai][3];
                const int bi = 2 * ai + wr;
#pragma unroll
                for (int bj = 0; bj < 2; ++bj) { u32x4 w; { const f32x4 v0 = acc[ai][bj][3][0] * rs, v1 = acc[ai][bj][3][1] * rs; w.x = cvt_pk_bf16(v0[0], v0[1]); w.y = cvt_pk_bf16(v0[2], v0[3]); w.z = cvt_pk_bf16(v1[0], v1[1]); w.w = cvt_pk_bf16(v1[2], v1[3]); }
                        if (bi < 3) *(PG8_LAS u32x4*)(halo + ((bi * 2 + (fr - 14)) * 256 + wc * 64 + bj * 32 + 8 * fq) * 2) = w;
                        else *(u32x4*)(rawp + (size_t)(2 + fr - 14) * 22 * 256 + bj * 32) = w; }
            }
        }
        if (wr == 0 && fr < 2) {
            const float rs = rsv[0][0];
#pragma unroll
            for (int bj = 0; bj < 2; ++bj) { u32x4 w; { const f32x4 v0 = acc[0][bj][0][0] * rs, v1 = acc[0][bj][0][1] * rs; w.x = cvt_pk_bf16(v0[0], v0[1]); w.y = cvt_pk_bf16(v0[2], v0[3]); w.z = cvt_pk_bf16(v1[0], v1[1]); w.w = cvt_pk_bf16(v1[2], v1[3]); }
                    *(u32x4*)(rawp + (size_t)fr * 22 * 256 + bj * 32) = w; }
        }
        asm volatile("s_waitcnt lgkmcnt(0)" ::: "memory"); __builtin_amdgcn_s_barrier(); asm volatile("" ::: "memory");
#pragma unroll
        for (int ai = 0; ai < 2; ++ai) {
            const int bi = 2 * ai + wr;
            { unsigned hv = 0u; if (bi > 0) hv = *(const PG8_LAS unsigned*)(halo + (((bi - 1) * 2 + hf) * 256 + wc * 64 + 2 * c) * 2);
              *(PG8_LAS unsigned*)(slab + hf * RP + 4 * c) = hv; }
#pragma unroll
            for (int m = 0; m < 4; ++m) {
                const float rs = rsv[ai][m];
#pragma unroll
                for (int bj = 0; bj < 2; ++bj) { u32x4 w; { const f32x4 v0 = acc[ai][bj][m][0] * rs, v1 = acc[ai][bj][m][1] * rs; w.x = cvt_pk_bf16(v0[0], v0[1]); w.y = cvt_pk_bf16(v0[2], v0[3]); w.z = cvt_pk_bf16(v1[0], v1[1]); w.w = cvt_pk_bf16(v1[2], v1[3]); }
                        *(PG8_LAS u32x4*)(slab + (2 + fr) * RP + (bj * 32 + 8 * fq) * 2) = w; }
                asm volatile("" ::: "memory");
                unsigned gw[6], uw[6];
#pragma unroll
                for (int i = 0; i < 6; ++i) { const PG8_LAS unsigned char* rp = slab + (4 * hq + i) * RP + 4 * c2; gw[i] = *(const PG8_LAS unsigned*)rp; uw[i] = *(const PG8_LAS unsigned*)(rp + 64); }
                asm volatile("" ::: "memory");
                if (hq == 3) {
#pragma unroll
                    for (int i = 0; i < 2; ++i) { *(PG8_LAS unsigned*)(slab + i * RP + 4 * c2) = gw[4 + i]; *(PG8_LAS unsigned*)(slab + i * RP + 64 + 4 * c2) = uw[4 + i]; }
                }
                float nl2_ = -1.4426950408889634f; asm volatile("" : "+v"(nl2_)); const f32x2v NL2 = {nl2_, nl2_};
#define CF_PAIR(w_) ((f32x2v){__builtin_bit_cast(float, (w_) << 16), __builtin_bit_cast(float, (w_) & 0xffff0000u)})
                f32x2v xg[6], xu[6];
#pragma unroll
                for (int i = 0; i < 6; ++i) { xg[i] = CF_PAIR(gw[i]); xu[i] = CF_PAIR(uw[i]); }
#pragma unroll
                for (int i = 0; i < 4; ++i) {
                    const f32x2v cg = bg + wg0 * xg[i] + wg1 * xg[i + 1] + wg2 * xg[i + 2];
                    const f32x2v cu = bu + wu0 * xu[i] + wu1 * xu[i + 1] + wu2 * xu[i + 2];
                    const f32x2v ea = cg * NL2;
                    const f32x2v den = (f32x2v){__builtin_amdgcn_exp2f(ea.x), __builtin_amdgcn_exp2f(ea.y)} + (f32x2v){1.f, 1.f};
                    const f32x2v hv = cg * (f32x2v){__builtin_amdgcn_rcpf(den.x), __builtin_amdgcn_rcpf(den.y)} * cu;
                    *(PG8_LAS unsigned*)(slab + (2 + 4 * hq + i) * RP + 4 * c2) = cvt_pk_bf16(hv.x, hv.y);
                }
#undef CF_PAIR
                asm volatile("" ::: "memory");
                { const int row = lane >> 2, c8 = (lane & 3) * 8;
                  const u32x4 w = *(const PG8_LAS u32x4*)(slab + (2 + row) * RP + c8 * 2);
                  *(u32x4*)(H + (size_t)(u.pm * BM + 64 * bi + 16 * m + row) * 2816 + 128 * u.pn + 32 * wc + c8) = w; }
                asm volatile("" ::: "memory");
            }
        }
    }
};

struct EpiInConv {
    static constexpr int PROBE_ID = 1;
    static constexpr bool PERM = true, AFTER_DRAIN = false, KSCALE = false;
    bf16_t* Z; bf16_t* XBC; float* DT; const float* ss; bf16_t* raw; const float* cw; const float* cb; PG8_LAS unsigned char* xl;
    static constexpr int RP = 144, SLAB = 19 * RP, HALO_OFF = 8 * SLAB;
    __device__ __forceinline__ void operator()(const f32x4 (&acc)[2][2][4][2], const Unit& u, int wr, int wc, int fr, int fq) const {
        const int row0 = u.pm * BM + wr * 64 + fr;
        float rsv[2][4];
#pragma unroll
        for (int ai = 0; ai < 2; ++ai)
#pragma unroll
            for (int m = 0; m < 4; ++m) rsv[ai][m] = ss[row0 + ai * HALF + m * 16];
        asm volatile("" : "+v"(rsv[0][0]), "+v"(rsv[0][1]), "+v"(rsv[0][2]), "+v"(rsv[0][3]), "+v"(rsv[1][0]), "+v"(rsv[1][1]), "+v"(rsv[1][2]), "+v"(rsv[1][3]));
#pragma unroll
        for (int ai = 0; ai < 2; ++ai)
#pragma unroll
            for (int m = 0; m < 4; ++m) rsv[ai][m] = 1.f / sqrtf(rsv[ai][m] * (1.f / 1024.f) + 1e-6f);
        if (u.pn < 8) {
#pragma unroll
            for (int ai = 0; ai < 2; ++ai)
#pragma unroll
                for (int m = 0; m < 4; ++m) { bf16_t* zp = Z + (size_t)(row0 + ai * HALF + m * 16) * 2048 + u.pn * 256 + wc * 32 + 8 * fq; const float rs = rsv[ai][m];
#pragma unroll
                    for (int bj = 0; bj < 2; ++bj) { u32x4 w; { const f32x4 v0 = acc[ai][bj][m][0] * rs, v1 = acc[ai][bj][m][1] * rs; w.x = cvt_pk_bf16(v0[0], v0[1]); w.y = cvt_pk_bf16(v0[2], v0[3]); w.z = cvt_pk_bf16(v1[0], v1[1]); w.w = cvt_pk_bf16(v1[2], v1[3]); } *(u32x4*)(zp + bj * HALF) = w; } }
            return;
        }
        if (u.pn == 20) {
            if (wc == 0) {
#pragma unroll
                for (int ai = 0; ai < 2; ++ai)
#pragma unroll
                    for (int m = 0; m < 4; ++m)
#pragma unroll
                        for (int n = 0; n < 2; ++n) *(f32x4*)(DT + (size_t)(row0 + ai * HALF + m * 16) * 32 + 8 * fq + 4 * n) = acc[ai][0][m][n] * rsv[ai][m];
            }
            return;
        }
        const int up = u.pn - 8, lane = opaque_tid() & 63  , c = lane & 31, c2 = lane & 15, hq = lane >> 4, wid = wr * 4 + wc;
        PG8_LAS unsigned char* slab = xl + wid * SLAB;
        PG8_LAS unsigned char* halo = xl + HALO_OFF;
        typedef float f32x2v __attribute__((ext_vector_type(2)));
        const int colA = up * 256 + 32 * wc + 2 * c2, colB = colA + 128;
        f32x2v wA[4], wB[4];
#pragma unroll
        for (int k = 0; k < 4; ++k) { wA[k] = *(const f32x2v*)(cw + k * 3072 + colA); wB[k] = *(const f32x2v*)(cw + k * 3072 + colB); }
        const f32x2v bA = *(const f32x2v*)(cb + colA), bB = *(const f32x2v*)(cb + colB);
        bf16_t* rawp = raw + ((size_t)u.pm * 6 * 12 + up) * 256 + wc * 64 + 8 * fq;
#pragma unroll
        for (int ai = 0; ai < 2; ++ai) {
            if (fr >= 13) {
                const float rs = rsv[ai][3]; const int bi = 2 * ai + wr;
#pragma unroll
                for (int bj = 0; bj < 2; ++bj) { u32x4 w; { const f32x4 v0 = acc[ai][bj][3][0] * rs, v1 = acc[ai][bj][3][1] * rs; w.x = cvt_pk_bf16(v0[0], v0[1]); w.y = cvt_pk_bf16(v0[2], v0[3]); w.z = cvt_pk_bf16(v1[0], v1[1]); w.w = cvt_pk_bf16(v1[2], v1[3]); }
                        if (bi < 3) *(PG8_LAS u32x4*)(halo + ((bi * 3 + (fr - 13)) * 256 + wc * 64 + bj * 32 + 8 * fq) * 2) = w;
                        else *(u32x4*)(rawp + (size_t)(3 + fr - 13) * 12 * 256 + bj * 32) = w; }
            }
        }
        if (wr == 0 && fr < 3) {
            const float rs = rsv[0][0];
#pragma unroll
            for (int bj = 0; bj < 2; ++bj) { u32x4 w; { const f32x4 v0 = acc[0][bj][0][0] * rs, v1 = acc[0][bj][0][1] * rs; w.x = cvt_pk_bf16(v0[0], v0[1]); w.y = cvt_pk_bf16(v0[2], v0[3]); w.z = cvt_pk_bf16(v1[0], v1[1]); w.w = cvt_pk_bf16(v1[2], v1[3]); }
                    *(u32x4*)(rawp + (size_t)fr * 12 * 256 + bj * 32) = w; }
        }
        asm volatile("s_waitcnt lgkmcnt(0)" ::: "memory"); __builtin_amdgcn_s_barrier(); asm volatile("" ::: "memory");
#define CF_LO(w_) __builtin_bit_cast(float, (w_) << 16)
#define CF_HI(w_) __builtin_bit_cast(float, (w_) & 0xffff0000u)
#pragma unroll
        for (int ai = 0; ai < 2; ++ai) {
            const int bi = 2 * ai + wr;
            { unsigned h0 = 0u, h1 = 0u;
              if (bi > 0) { h0 = *(const PG8_LAS unsigned*)(halo + (((bi - 1) * 3 + (lane >> 5)) * 256 + wc * 64 + 2 * c) * 2); if (lane < 32) h1 = *(const PG8_LAS unsigned*)(halo + (((bi - 1) * 3 + 2) * 256 + wc * 64 + 2 * c) * 2); }
              *(PG8_LAS unsigned*)(slab + (lane >> 5) * RP + 4 * c) = h0; if (lane < 32) *(PG8_LAS unsigned*)(slab + 2 * RP + 4 * c) = h1; }
#pragma unroll
            for (int m = 0; m < 4; ++m) {
                const float rs = rsv[ai][m];
#pragma unroll
                for (int bj = 0; bj < 2; ++bj) { u32x4 w; { const f32x4 v0 = acc[ai][bj][m][0] * rs, v1 = acc[ai][bj][m][1] * rs; w.x = cvt_pk_bf16(v0[0], v0[1]); w.y = cvt_pk_bf16(v0[2], v0[3]); w.z = cvt_pk_bf16(v1[0], v1[1]); w.w = cvt_pk_bf16(v1[2], v1[3]); }
                        *(PG8_LAS u32x4*)(slab + (3 + fr) * RP + (bj * 32 + 8 * fq) * 2) = w; }
                asm volatile("" ::: "memory");
                unsigned aw[7], bw[7];
#pragma unroll
                for (int i = 0; i < 7; ++i) { const PG8_LAS unsigned char* rp = slab + (4 * hq + i) * RP + 4 * c2; aw[i] = *(const PG8_LAS unsigned*)rp; bw[i] = *(const PG8_LAS unsigned*)(rp + 64); }
                asm volatile("" ::: "memory");
                if (hq == 3) {
#pragma unroll
                    for (int i = 0; i < 3; ++i) { *(PG8_LAS unsigned*)(slab + i * RP + 4 * c2) = aw[4 + i]; *(PG8_LAS unsigned*)(slab + i * RP + 64 + 4 * c2) = bw[4 + i]; }
                }
                float nl2_ = -1.4426950408889634f; asm volatile("" : "+v"(nl2_)); const f32x2v NL2 = {nl2_, nl2_};
#define CF_PAIR(w_) ((f32x2v){__builtin_bit_cast(float, (w_) << 16), __builtin_bit_cast(float, (w_) & 0xffff0000u)})
                f32x2v xa[7], xb2[7];
#pragma unroll
                for (int i = 0; i < 7; ++i) { xa[i] = CF_PAIR(aw[i]); xb2[i] = CF_PAIR(bw[i]); }
#pragma unroll
                for (int i = 0; i < 4; ++i) {
                    const f32x2v av = bA + wA[0] * xa[i] + wA[1] * xa[i + 1] + wA[2] * xa[i + 2] + wA[3] * xa[i + 3];
                    const f32x2v bv = bB + wB[0] * xb2[i] + wB[1] * xb2[i + 1] + wB[2] * xb2[i + 2] + wB[3] * xb2[i + 3];
                    const f32x2v ea = av * NL2, eb = bv * NL2;
                    const f32x2v da = (f32x2v){__builtin_amdgcn_exp2f(ea.x), __builtin_amdgcn_exp2f(ea.y)} + (f32x2v){1.f, 1.f}, db = (f32x2v){__builtin_amdgcn_exp2f(eb.x), __builtin_amdgcn_exp2f(eb.y)} + (f32x2v){1.f, 1.f};
                    const f32x2v sa = av * (f32x2v){__builtin_amdgcn_rcpf(da.x), __builtin_amdgcn_rcpf(da.y)}, sb = bv * (f32x2v){__builtin_amdgcn_rcpf(db.x), __builtin_amdgcn_rcpf(db.y)};
                    *(PG8_LAS unsigned*)(slab + (3 + 4 * hq + i) * RP + 4 * c2) = cvt_pk_bf16(sa.x, sa.y);
                    *(PG8_LAS unsigned*)(slab + (3 + 4 * hq + i) * RP + 64 + 4 * c2) = cvt_pk_bf16(sb.x, sb.y);
                }
#undef CF_PAIR
                asm volatile("" ::: "memory");
                { const int row = lane >> 2, q = lane & 3;
                  const u32x4 w0 = *(const PG8_LAS u32x4*)(slab + (3 + row) * RP + 32 * q), w1 = *(const PG8_LAS u32x4*)(slab + (3 + row) * RP + 32 * q + 16);
                  bf16_t* op = XBC + (size_t)(u.pm * BM + 64 * bi + 16 * m + row) * 3072 + up * 256 + (q >> 1) * 128 + 32 * wc + 16 * (q & 1);
                  *(u32x4*)op = w0; *(u32x4*)(op + 8) = w1; }
                asm volatile("" ::: "memory");
            }
        }
#undef CF_LO
#undef CF_HI
    }
};
}

constexpr int NWAVES = 8;
constexpr int NBATCH = 16, SEQ = 2048, M_TOK = NBATCH * SEQ, DM = 1024;
constexpr int DIN = 2048, NXBC = 3072, NIN = 5152, NINP = 5376, SSM_H = 32;
constexpr int FF = 2816, FF2 = 5632, MH = M_TOK / 2;
constexpr float EPS = 1e-6f, LOG2E = 1.4426950408889634f;
constexpr float LAM_INIT = 0.35550906759096926f;
constexpr float QSCALE = 0.125f * 1.4426950408889634f;

constexpr size_t MiB = 1u << 20;
constexpr size_t WS_CTL = 0, CTL_ZERO_BYTES = 1 * MiB;
constexpr size_t WS_WIN = 1 * MiB, WS_WOUT = 12 * MiB, WS_WUP0 = 16 * MiB, WS_WUP1 = 27 * MiB, WS_WDN0 = 38 * MiB, WS_WDN1 = 44 * MiB,
                 WS_WKVQ = 50 * MiB, WS_WAO = 56 * MiB, WS_RSTD = 58 * MiB, WS_DT = 59 * MiB;
constexpr size_t WS_XB = 64 * MiB;
constexpr size_t WS_R = 128 * MiB;
constexpr size_t WS_Z = WS_R, WS_XBC = WS_R + 128 * MiB, WS_XRAW = WS_R + 320 * MiB;
constexpr size_t WS_U = WS_R, WS_H = WS_R, WS_FRAW = WS_R + 176 * MiB;
constexpr size_t WS_K = WS_R, WS_V = WS_R + 64 * MiB, WS_Q = WS_R + 128 * MiB, WS_O = WS_R + 192 * MiB;
constexpr size_t WS_GSS = WS_R + 340 * MiB;
constexpr size_t WS_END = 512 * MiB;
constexpr int CW_BAR = 4096;
constexpr size_t WS_SS1 = 256 * 1024, WS_SS2 = 384 * 1024, WS_SS3 = 512 * 1024;

constexpr int RING_BYTES = 131072;
constexpr int LDS_BYTES = 163840;
constexpr int LDSCTL_OFF = LDS_BYTES - 1024, MISC_OFF = LDSCTL_OFF + 320;

#define GAS __attribute__((address_space(1)))
#define LAS __attribute__((address_space(3)))
typedef unsigned short bf16;
typedef unsigned v4u __attribute__((ext_vector_type(4)));
typedef float f32x4 __attribute__((ext_vector_type(4)));
typedef short bf16x8 __attribute__((ext_vector_type(8)));
typedef GAS unsigned gu32;
typedef GAS unsigned long long gu64;
#define RLX_AGENT __ATOMIC_RELAXED, __HIP_MEMORY_SCOPE_AGENT
#define LDS_WAIT() asm volatile("s_waitcnt lgkmcnt(0)" ::: "memory")
#define VM_WAIT() asm volatile("s_waitcnt vmcnt(0)" ::: "memory")
__device__ __forceinline__ unsigned long long rt() { return __builtin_amdgcn_s_memrealtime(); }
typedef float f32x2_cv __attribute__((ext_vector_type(2))); typedef __bf16 bf16x2_cv __attribute__((ext_vector_type(2)));
__device__ __forceinline__ unsigned pk2(float lo, float hi) { f32x2_cv v = {lo, hi}; bf16x2_cv b = __builtin_convertvector(v, bf16x2_cv); return __builtin_bit_cast(unsigned, b); }
__device__ __forceinline__ unsigned f2bf(float f) { return pk2(f, f) & 0xffffu; }
#define XB_TMO      128
#define XB_XCNT(j)  (256  + 64 * (j))
#define XB_XSUB(j)  (1280 + 64 * (j))
#define XB_XGEN(j)  (2304 + 64 * (j))
#define XB_TOP      3328
#define XB_TOPGEN   3392
#define XCD_BAR_WORDS 3456
#define XB_SPIN_CAP (1u << 18)

__device__ __forceinline__ unsigned xb_ld(unsigned* p)              { return __hip_atomic_load(p, __ATOMIC_RELAXED, __HIP_MEMORY_SCOPE_AGENT); }
__device__ __forceinline__ unsigned xb_add(unsigned* p, unsigned v) { return __hip_atomic_fetch_add(p, v, __ATOMIC_RELAXED, __HIP_MEMORY_SCOPE_AGENT); }
__device__ __forceinline__ unsigned xb_xcc_id() { return (unsigned)__builtin_amdgcn_s_getreg((3 << 11) | 20) & 0xFu; }
#define XB_SPIN(cond, bar) do { unsigned _sp = 0; while (cond) { __builtin_amdgcn_s_sleep(1); \
    if ((++_sp & 255u) == 0u) { if (xb_ld(&(bar)[XB_TMO])) break; if (_sp > XB_SPIN_CAP) { atomicAdd(&(bar)[XB_TMO], 1u); break; } } } } while (0)

struct XcdBarrier {
    unsigned* bar; unsigned x;
    volatile LAS unsigned* st;
};

__device__ __forceinline__ XcdBarrier xcd_barrier_post(unsigned* bar, volatile LAS unsigned* st) {
    XcdBarrier b; b.bar = bar; b.x = xb_xcc_id(); b.st = st;
    if (threadIdx.x == 0) (void)xb_add(&bar[XB_XCNT(b.x)], 1u);
    return b;
}
__device__ __forceinline__ void xcd_barrier_complete(unsigned* bar, unsigned x, unsigned& nloc, unsigned& nx) {
    const unsigned G = gridDim.x * gridDim.y * gridDim.z;
    unsigned sum, cnt, mine, sp = 0u;
    for (;;) {
        sum = 0u; cnt = 0u; mine = 0u;
#pragma unroll
        for (unsigned j = 0; j < 16; ++j) { const unsigned c = xb_ld(&bar[XB_XCNT(j)]); sum += c; cnt += (c > 0u) ? 1u : 0u; mine = (j == x) ? c : mine; }
        if (sum == G) break;
        __builtin_amdgcn_s_sleep(1);
        if ((++sp & 255u) == 0u) { if (xb_ld(&bar[XB_TMO])) break; if (sp > XB_SPIN_CAP) { atomicAdd(&bar[XB_TMO], 1u); break; } }
    }
    nloc = mine > 0u ? mine : 1u; nx = cnt > 0u ? cnt : 1u;
}

__device__ __forceinline__ void xcd_barrier(const XcdBarrier& b) {
    asm volatile("s_waitcnt vmcnt(0)" ::: "memory");
    __syncthreads();
    if (threadIdx.x == 0) {
        unsigned* bar = b.bar;
        __builtin_amdgcn_s_waitcnt(0);
        unsigned nloc = b.st[0], nx = b.st[1];
        if (nloc == 0u) { xcd_barrier_complete(bar, b.x, nloc, nx); b.st[0] = nloc; b.st[1] = nx; }
        const unsigned old = xb_add(&bar[XB_XSUB(b.x)], 1u);
        const unsigned gen = old / nloc;
        if (old + 1u == (gen + 1u) * nloc) {
            __builtin_amdgcn_fence(__ATOMIC_RELEASE, "agent");
            asm volatile("s_waitcnt vmcnt(0)" ::: "memory");
            const unsigned og = xb_add(&bar[XB_TOP], 1u);
            const unsigned tg = og / nx;
            if (og + 1u == (tg + 1u) * nx) xb_add(&bar[XB_TOPGEN], 1u);
            else XB_SPIN(xb_ld(&bar[XB_TOPGEN]) == tg, bar);
            __builtin_amdgcn_fence(__ATOMIC_ACQUIRE, "agent");
            xb_add(&bar[XB_XGEN(b.x)], 1u);
            asm volatile("s_waitcnt vmcnt(0)" ::: "memory");
        } else {
            XB_SPIN(xb_ld(&bar[XB_XGEN(b.x)]) == gen, bar);
            __builtin_amdgcn_fence(__ATOMIC_ACQUIRE, "agent");
            asm volatile("s_waitcnt vmcnt(0)" ::: "memory");
        }
    }
    __syncthreads();
}

struct Args { const float* in[25]; float* out; unsigned char* ws; int ph_lo, ph_hi; unsigned char prog[64]; };
template <int K> __device__ __forceinline__ const float* arg_in_() { const float* p_;
    asm volatile("s_load_dwordx2 %0, %1, %2\n\ts_waitcnt lgkmcnt(0)" : "=s"(p_) : "s"(__builtin_amdgcn_kernarg_segment_ptr()), "n"(K * 8)); return p_; }
#define ARG_IN(a_, k_) arg_in_<(k_)>()
__device__ __forceinline__ unsigned char* opaque_ws(const Args& a) { unsigned char* w = a.ws; asm volatile("" : "+s"(w)); return w; }

typedef unsigned u32x4v __attribute__((ext_vector_type(4)));
__device__ __forceinline__ float bf2f(bf16 v) { return __builtin_bit_cast(float, (unsigned)v << 16); }
__device__ __forceinline__ float wave_sum(float v) {
#pragma unroll
    for (int o = 1; o < 64; o <<= 1) v += shfl_xor_f(v, o);
    return v;
}
__device__ __forceinline__ float silu_f(float v) { return v * __builtin_amdgcn_rcpf(1.f + __builtin_amdgcn_exp2f(v * -1.4426950408889634f)); }

__device__ __forceinline__ void wprep_item(const float* W, int K, int Nsrc, int scol0, const float* gain, int gmask, float gscale,
                                           bf16* WT, int drow0, int k0, LAS float* scr, int lane) {
    float wv[32];
    asm volatile("" : "+s"(gscale));
#pragma unroll
    for (int i = 0; i < 32; ++i) { const int kk = 2 * i + (lane >> 5); wv[i] = W ? W[(size_t)(k0 + kk) * Nsrc + scol0 + (lane & 31)] : 0.f; }
#pragma unroll
    for (int i = 0; i < 32; ++i) { const int kk = 2 * i + (lane >> 5);
        const float gn = gain ? gain[(k0 + kk) & gmask] * gscale : gscale;
        scr[kk * 33 + (lane & 31)] = wv[i] * gn; }
    LDS_WAIT(); asm volatile("" ::: "memory");
    const int c = lane & 7;
#pragma unroll
    for (int j = 0; j < 4; ++j) { const int n = (lane >> 3) + 8 * j; const LAS float* s = scr + (8 * c) * 33 + n;
        v4u o; o.x = pk2(s[0 * 33], s[1 * 33]); o.y = pk2(s[2 * 33], s[3 * 33]); o.z = pk2(s[4 * 33], s[5 * 33]); o.w = pk2(s[6 * 33], s[7 * 33]);
        *(GAS v4u*)(WT + (size_t)(drow0 + n) * K + k0 + 8 * c) = o; }
    LDS_WAIT(); asm volatile("" ::: "memory");
}
__device__ __forceinline__ void rowstat_phase(const float* x, bf16* xb, float* rstd, int vcu, int NGW) {
    const int tid_ = opaque_tid(), lane = tid_ & 63, gw = vcu * NWAVES + __builtin_amdgcn_readfirstlane(tid_ >> 6);
    for (int m0 = gw * 2; m0 < M_TOK; m0 += NGW * 2) {
        f32x4 v[2][4]; float s[2];
#pragma unroll
        for (int r = 0; r < 2; ++r) { const GAS f32x4* xr = (const GAS f32x4*)(x + (size_t)(m0 + r) * DM) + lane;
#pragma unroll
            for (int j = 0; j < 4; ++j) v[r][j] = xr[64 * j]; }
#pragma unroll
        for (int r = 0; r < 2; ++r) { float t = 0.f;
#pragma unroll
            for (int j = 0; j < 4; ++j) t += (v[r][j].x * v[r][j].x + v[r][j].y * v[r][j].y) + (v[r][j].z * v[r][j].z + v[r][j].w * v[r][j].w);
            s[r] = wave_sum(t);
            GAS unsigned long long* o8 = (GAS unsigned long long*)(xb + (size_t)(m0 + r) * DM) + lane;
#pragma unroll
            for (int j = 0; j < 4; ++j) o8[64 * j] = (unsigned long long)pk2(v[r][j].x, v[r][j].y) | ((unsigned long long)pk2(v[r][j].z, v[r][j].w) << 32); }
        if (lane < 2) rstd[m0 + lane] = lane ? s[1] : s[0];
    }
}
__device__ __forceinline__ void prep_phase(const Args& a, LAS unsigned char* lds, int vcu, int NGW) {
    const int tid_ = opaque_tid(), lane = tid_ & 63, wave = __builtin_amdgcn_readfirstlane(tid_ >> 6), gw = vcu * NWAVES + wave;
    LAS float* scr = (LAS float*)(lds + wave * 16384);
    unsigned char* ws = opaque_ws(a);
    constexpr int I_IN = 16 * 168, I_OUT = 32 * 32, I_UP = 16 * 176, I_DN = 44 * 32, I_KV = 16 * 64, I_Q = 16 * 32, I_AO = 16 * 32;
    constexpr int NITEMS = I_IN + I_OUT + 2 * I_UP + 2 * I_DN + I_KV + I_Q + I_AO;
    for (int it = gw; it < NITEMS; it += NGW) {
        int r = it;
        if (r < I_IN) { const int kb = r / 168, db = r % 168;
            wprep_item(db < 161 ? ARG_IN(a, 2) : nullptr, 1024, NIN, 32 * db, ARG_IN(a, 1), 1023, 1.f, (bf16*)(ws + WS_WIN), 32 * db, 64 * kb, scr, lane); continue; } r -= I_IN;
        if (r < I_OUT) { const int kb = r / 32, db = r % 32;
            wprep_item(ARG_IN(a, 9), 2048, 1024, 32 * db, ARG_IN(a, 8), 2047, 1.f, (bf16*)(ws + WS_WOUT), 32 * db, 64 * kb, scr, lane); continue; } r -= I_OUT;
        if (r < 2 * I_UP) { const int l = r / I_UP; r -= l * I_UP; const int kb = r / 176, db = r % 176, j = db >> 3, q = db & 7;
            const int scol = (q < 4) ? (128 * j + 32 * q) : (FF + 128 * j + 32 * (q - 4));
            wprep_item(ARG_IN(a, 21) + (size_t)l * 1024 * FF2, 1024, FF2, scol, ARG_IN(a, 20) + l * 1024, 1023, 1.f, (bf16*)(ws + (l ? WS_WUP1 : WS_WUP0)), 32 * db, 64 * kb, scr, lane); continue; } r -= 2 * I_UP;
        if (r < 2 * I_DN) { const int l = r / I_DN; r -= l * I_DN; const int kb = r / 32, db = r % 32;
            wprep_item(ARG_IN(a, 24) + (size_t)l * FF * 1024, FF, 1024, 32 * db, nullptr, 0, 1.f, (bf16*)(ws + (l ? WS_WDN1 : WS_WDN0)), 32 * db, 64 * kb, scr, lane); continue; } r -= 2 * I_DN;
        if (r < I_KV) { const int kb = r / 64, db = r % 64, q = db & 7;
            wprep_item(ARG_IN(a, 11), 1024, 2048, 256 * (db >> 3) + 64 * (q & 3) + 32 * (q >> 2), ARG_IN(a, 10), 1023, 1.f, (bf16*)(ws + WS_WKVQ), 32 * db, 64 * kb, scr, lane); continue; } r -= I_KV;
        if (r < I_Q) { const int kb = r / 32, db = r % 32, q = db & 7;
            wprep_item(ARG_IN(a, 15), 1024, 1024, 256 * (db >> 3) + 64 * (q & 3) + 32 * (q >> 2), ARG_IN(a, 14), 1023, 1.f, (bf16*)(ws + WS_WKVQ), 2048 + 32 * db, 64 * kb, scr, lane); continue; } r -= I_Q;
        { const int kb = r / 32, db = r % 32;
            wprep_item(ARG_IN(a, 19), 1024, 1024, 32 * db, ARG_IN(a, 18), 127, 1.f - LAM_INIT, (bf16*)(ws + WS_WAO), 32 * db, 64 * kb, scr, lane); }
    }
    rowstat_phase(ARG_IN(a, 0), (bf16*)(ws + WS_XB), (float*)(ws + WS_RSTD), vcu, NGW);
}

__device__ __forceinline__ void ssd_naive_phase(const Args& a, LAS unsigned char* lds) {
    const int tid = opaque_tid();
    LAS float* cx = (LAS float*)lds;
    LAS float* cB = cx + 64 * 64;
    LAS float* cC = cB + 64 * 128;
    LAS float* cdA = cC + 64 * 128;
    LAS float* cdt = cdA + 64;
    const bf16* XBC = (const bf16*)(opaque_ws(a) + WS_XBC); bf16* Z = (bf16*)(opaque_ws(a) + WS_Z); const float* DT = (const float*)(opaque_ws(a) + WS_DT);
    const float* conv_w = ARG_IN(a, 3); const float* conv_b = ARG_IN(a, 4);
    const int p = tid >> 3, ns = (tid & 7) * 16;
    for (int item = blockIdx.x; item < NBATCH * SSM_H; item += gridDim.x) {
        const int b = item >> 5, h = item & 31, g = h >> 3;
        const float Aneg = -__expf(ARG_IN(a, 6)[h]), dtb = ARG_IN(a, 5)[h], Dh = ARG_IN(a, 7)[h];
        float hst[16];
#pragma unroll
        for (int i = 0; i < 16; ++i) hst[i] = 0.f;
        for (int t0 = 0; t0 < SEQ; t0 += 64) {
            for (int e = tid; e < 64 * 320; e += 512) {
                const int tt = e / 320, j = e - tt * 320;
                const int col = j < 64 ? 64 * h + j : (j < 192 ? 2048 + 128 * g + (j - 64) : 2560 + 128 * g + (j - 192));
                const int t = t0 + tt;
                float v = conv_b[col];
#pragma unroll
                for (int k = 0; k < 4; ++k) { const int ts = t - 3 + k; if (ts >= 0) v += conv_w[k * NXBC + col] * bf2f(XBC[(size_t)(b * SEQ + ts) * NXBC + col]); }
                v = silu_f(v);
                if (j < 64) cx[tt * 64 + j] = v; else if (j < 192) cB[tt * 128 + (j - 64)] = v; else cC[tt * 128 + (j - 192)] = v;
            }
            if (tid < 64) { const float raw = DT[(size_t)(b * SEQ + t0 + tid) * 32 + h] + dtb; const float dtv = raw > 20.f ? raw : log1pf(__expf(raw)); cdt[tid] = dtv; cdA[tid] = __expf(dtv * Aneg); }
            __syncthreads();
            for (int tt = 0; tt < 64; ++tt) {
                const float xv = cx[tt * 64 + p], dA = cdA[tt], xdt = xv * cdt[tt];
                float acc = 0.f;
#pragma unroll
                for (int i = 0; i < 16; ++i) { hst[i] = dA * hst[i] + xdt * cB[tt * 128 + ns + i]; acc += cC[tt * 128 + ns + i] * hst[i]; }
                acc += shfl_xor_f(acc, 1); acc += shfl_xor_f(acc, 2); acc += shfl_xor_f(acc, 4);
                if ((tid & 7) == 0) { const size_t idx = (size_t)(b * SEQ + t0 + tt) * DIN + 64 * h + p; const float z = bf2f(Z[idx]); Z[idx] = (bf16)f2bf((acc + xv * Dh) * silu_f(z)); }
            }
            __syncthreads();
        }
    }
}
__device__ __forceinline__ void unpack8(const v4u w, float (&f)[8]) {
    f[0] = __builtin_bit_cast(float, w.x << 16); f[1] = __builtin_bit_cast(float, w.x & 0xffff0000u); f[2] = __builtin_bit_cast(float, w.y << 16); f[3] = __builtin_bit_cast(float, w.y & 0xffff0000u);
    f[4] = __builtin_bit_cast(float, w.z << 16); f[5] = __builtin_bit_cast(float, w.z & 0xffff0000u); f[6] = __builtin_bit_cast(float, w.w << 16); f[7] = __builtin_bit_cast(float, w.w & 0xffff0000u);
}
__device__ __forceinline__ void groupnorm_phase(const Args& a, int vcu, int NGW) {
    const int tid_ = opaque_tid(), lane = tid_ & 63, gw = vcu * NWAVES + __builtin_amdgcn_readfirstlane(tid_ >> 6);
    bf16* Z = (bf16*)(opaque_ws(a) + WS_Z);
    for (int i = gw; i < M_TOK * 4; i += NGW) {
        GAS v4u* p = (GAS v4u*)(Z + (size_t)i * 512) + lane;
        float f[8]; unpack8(*p, f);
        float s = 0.f;
#pragma unroll
        for (int j = 0; j < 8; ++j) s += f[j] * f[j];
        s = wave_sum(s);
        const float r = 1.f / sqrtf(s * (1.f / 512.f) + EPS);
        v4u o; o.x = pk2(f[0] * r, f[1] * r); o.y = pk2(f[2] * r, f[3] * r); o.z = pk2(f[4] * r, f[5] * r); o.w = pk2(f[6] * r, f[7] * r);
        *p = o;
    }
}
__device__ __forceinline__ void convact_phase(const Args& a, int layer, int r0) {
    const bf16* U = (const bf16*)(opaque_ws(a) + WS_U); bf16* H = (bf16*)(opaque_ws(a) + WS_H);
    const float* cw = ARG_IN(a, 22) + (size_t)layer * 3 * FF2; const float* cb = ARG_IN(a, 23) + (size_t)layer * FF2;
    constexpr int NG = FF / 8, NITEMS = (MH / 32) * NG;
    const int nthr = gridDim.x * 512;
    for (int item = blockIdx.x * 512 + opaque_tid(); item < NITEMS; item += nthr) {
        const int seg = item / NG, c = (item - seg * NG) * 8, gcol = 256 * (c >> 7) + (c & 127);
        const int t1 = seg * 32, tseq = (r0 + t1) & (SEQ - 1);
        float wg[3][8], wu[3][8], bg[8], bu[8];
#pragma unroll
        for (int q = 0; q < 2; ++q) {
            const f32x4 x = *(const GAS f32x4*)(cb + c + 4 * q), y = *(const GAS f32x4*)(cb + FF + c + 4 * q);
#pragma unroll
            for (int e = 0; e < 4; ++e) { bg[4 * q + e] = x[e]; bu[4 * q + e] = y[e]; }
#pragma unroll
            for (int k = 0; k < 3; ++k) { const f32x4 xg = *(const GAS f32x4*)(cw + k * FF2 + c + 4 * q), xu = *(const GAS f32x4*)(cw + k * FF2 + FF + c + 4 * q);
#pragma unroll
                for (int e = 0; e < 4; ++e) { wg[k][4 * q + e] = xg[e]; wu[k][4 * q + e] = xu[e]; } }
        }
        const bf16* up = U + (size_t)t1 * FF2 + gcol;
        v4u g2 = {0u, 0u, 0u, 0u}, g1 = g2, u2 = g2, u1 = g2;
        if (tseq != 0) { g2 = *(const GAS v4u*)(up - 2 * (ptrdiff_t)FF2); u2 = *(const GAS v4u*)(up - 2 * (ptrdiff_t)FF2 + 128); g1 = *(const GAS v4u*)(up - (ptrdiff_t)FF2); u1 = *(const GAS v4u*)(up - (ptrdiff_t)FF2 + 128); }
        bf16* hp = H + (size_t)t1 * FF + c;
#pragma unroll 8
        for (int rr = 0; rr < 32; ++rr) {
            const v4u g0 = *(const GAS v4u*)(up + (size_t)rr * FF2), u0 = *(const GAS v4u*)(up + (size_t)rr * FF2 + 128);
            float a2[8], a1[8], a0[8], b2[8], b1[8], b0[8];
            unpack8(g2, a2); unpack8(g1, a1); unpack8(g0, a0); unpack8(u2, b2); unpack8(u1, b1); unpack8(u0, b0);
            float hv[8];
#pragma unroll
            for (int e = 0; e < 8; ++e) { const float gg = bg[e] + wg[0][e] * a2[e] + wg[1][e] * a1[e] + wg[2][e] * a0[e], uu = bu[e] + wu[0][e] * b2[e] + wu[1][e] * b1[e] + wu[2][e] * b0[e]; hv[e] = silu_f(gg) * uu; }
            *(GAS v4u*)(hp + (size_t)rr * FF) = (v4u){pk2(hv[0], hv[1]), pk2(hv[2], hv[3]), pk2(hv[4], hv[5]), pk2(hv[6], hv[7])};
            g2 = g1; g1 = g0; u2 = u1; u1 = u0;
        }
    }
}
__device__ __forceinline__ void bcconv_phase(const Args& a) {
    const bf16* XBC = (const bf16*)(opaque_ws(a) + WS_XBC); bf16* BCc = (bf16*)(opaque_ws(a) + WS_XB);
    const float* cw = ARG_IN(a, 3); const float* cb = ARG_IN(a, 4);
    constexpr int NG = 1024 / 8, NITEMS = (M_TOK / 32) * NG;
    const int nthr = gridDim.x * 512;
    for (int item = blockIdx.x * 512 + opaque_tid(); item < NITEMS; item += nthr) {
        const int seg = item / NG, c = (item - seg * NG) * 8, t1 = seg * 32, tseq = t1 & (SEQ - 1);
        float w[4][8], bb[8];
#pragma unroll
        for (int q = 0; q < 2; ++q) { const f32x4 x = *(const GAS f32x4*)(cb + 2048 + c + 4 * q);
#pragma unroll
            for (int e = 0; e < 4; ++e) bb[4 * q + e] = x[e];
#pragma unroll
            for (int k = 0; k < 4; ++k) { const f32x4 y = *(const GAS f32x4*)(cw + k * NXBC + 2048 + c + 4 * q);
#pragma unroll
                for (int e = 0; e < 4; ++e) w[k][4 * q + e] = y[e]; } }
        const bf16* sp = XBC + (size_t)t1 * NXBC + 2048 + c;
        v4u r3 = {0u, 0u, 0u, 0u}, r2 = r3, r1 = r3;
        if (tseq != 0) { r3 = *(const GAS v4u*)(sp - 3 * (ptrdiff_t)NXBC); r2 = *(const GAS v4u*)(sp - 2 * (ptrdiff_t)NXBC); r1 = *(const GAS v4u*)(sp - (ptrdiff_t)NXBC); }
        bf16* dp = BCc + (size_t)t1 * 1024 + c;
#pragma unroll 8
        for (int rr = 0; rr < 32; ++rr) {
            const v4u r0 = *(const GAS v4u*)(sp + (size_t)rr * NXBC);
            float a3[8], a2[8], a1[8], a0[8]; unpack8(r3, a3); unpack8(r2, a2); unpack8(r1, a1); unpack8(r0, a0);
            float o[8];
#pragma unroll
            for (int e = 0; e < 8; ++e) o[e] = silu_f(bb[e] + w[0][e] * a3[e] + w[1][e] * a2[e] + w[2][e] * a1[e] + w[3][e] * a0[e]);
            *(GAS v4u*)(dp + (size_t)rr * 1024) = (v4u){pk2(o[0], o[1]), pk2(o[2], o[3]), pk2(o[4], o[5]), pk2(o[6], o[7])};
            r3 = r2; r2 = r1; r1 = r0;
        }
    }
}
__device__ __forceinline__ void ssmconv_fixup_phase(const Args& a) {
    const bf16* raw = (const bf16*)(opaque_ws(a) + WS_XRAW); bf16* XBC = (bf16*)(opaque_ws(a) + WS_XBC);
    const float* cw = ARG_IN(a, 3); const float* cb = ARG_IN(a, 4);
    const int nthr = gridDim.x * 512;
    for (int e = blockIdx.x * 512 + opaque_tid(); e < (M_TOK / 256) * 3 * NXBC; e += nthr) {
        const int pm = e / (3 * NXBC), rem = e - pm * 3 * NXBC, r = rem / NXBC, col = rem - r * NXBC;
        const int rc = (col >> 8) * 256 + ((col >> 5) & 3) * 64 + ((col >> 7) & 1) * 32 + (col & 31);
        float x[6];
#pragma unroll
        for (int k = 0; k < 3; ++k) {
            x[k] = ((pm & 7) != 0) ? bf2f(raw[((size_t)(pm - 1) * 6 + 3 + k) * NXBC + rc]) : 0.f;
            x[3 + k] = bf2f(raw[((size_t)pm * 6 + k) * NXBC + rc]);
        }
        const float v = cb[col] + cw[col] * x[r] + cw[NXBC + col] * x[r + 1] + cw[2 * NXBC + col] * x[r + 2] + cw[3 * NXBC + col] * x[r + 3];
        XBC[(size_t)(pm * 256 + r) * NXBC + col] = (bf16)f2bf(silu_f(v));
    }
}
__device__ __forceinline__ void convffn_fixup_phase(const Args& a, int layer) {
    const bf16* raw = (const bf16*)(opaque_ws(a) + WS_FRAW); bf16* H = (bf16*)(opaque_ws(a) + WS_H);
    const float* cw = ARG_IN(a, 22) + (size_t)layer * 3 * FF2; const float* cb = ARG_IN(a, 23) + (size_t)layer * FF2;
    const int nthr = gridDim.x * 512;
    for (int e = blockIdx.x * 512 + opaque_tid(); e < (M_TOK / 256) * 2 * FF; e += nthr) {
        const int pm = e / (2 * FF), rem = e - pm * 2 * FF, r = rem / FF, ch = rem - r * FF;
        const int col = (ch >> 7) * 256 + ((ch >> 5) & 3) * 64 + (ch & 31);
        float g[4], u[4];
#pragma unroll
        for (int k = 0; k < 2; ++k) {
            if ((pm & 7) != 0) { const bf16* p = raw + ((size_t)(pm - 1) * 4 + 2 + k) * 22 * 256 + col; g[k] = bf2f(p[0]); u[k] = bf2f(p[32]); } else { g[k] = 0.f; u[k] = 0.f; }
            const bf16* q = raw + ((size_t)pm * 4 + k) * 22 * 256 + col; g[2 + k] = bf2f(q[0]); u[2 + k] = bf2f(q[32]);
        }
        const float cg = cb[ch] + cw[ch] * g[r] + cw[FF2 + ch] * g[r + 1] + cw[2 * FF2 + ch] * g[r + 2];
        const float cu = cb[FF + ch] + cw[FF + ch] * u[r] + cw[FF2 + FF + ch] * u[r + 1] + cw[2 * FF2 + FF + ch] * u[r + 2];
        H[(size_t)(pm * 256 + r) * FF + ch] = (bf16)f2bf(silu_f(cg) * cu);
    }
}
__device__ __forceinline__ void qknorm_phase(const Args& a, int vcu, int NGW) {
    const int tid_ = opaque_tid(), lane = tid_ & 63, gw = vcu * NWAVES + __builtin_amdgcn_readfirstlane(tid_ >> 6);
    for (int i = gw; i < M_TOK * 2; i += NGW) {
        const int tok = i >> 1, isq = i & 1;
        bf16* base = (bf16*)(opaque_ws(a) + (isq ? WS_Q : WS_K)) + (size_t)tok * 1024 + lane * 16;
        const float* g = (isq ? ARG_IN(a, 16) : ARG_IN(a, 12)) + (lane & 3) * 16; const float sc = isq ? QSCALE : 1.f;
        const v4u w0 = *(const GAS v4u*)base, w1 = *(const GAS v4u*)(base + 8);
        const unsigned ww[8] = {w0.x, w0.y, w0.z, w0.w, w1.x, w1.y, w1.z, w1.w};
        float f[16]; float s = 0.f;
#pragma unroll
        for (int q = 0; q < 8; ++q) { f[2 * q] = __builtin_bit_cast(float, ww[q] << 16); f[2 * q + 1] = __builtin_bit_cast(float, ww[q] & 0xffff0000u); s += f[2 * q] * f[2 * q] + f[2 * q + 1] * f[2 * q + 1]; }
        s += shfl_xor_f(s, 1); s += shfl_xor_f(s, 2);
        const float r = sc / sqrtf(s * (1.f / 64.f) + EPS);
        unsigned o[8];
#pragma unroll
        for (int q = 0; q < 8; ++q) o[q] = pk2(f[2 * q] * r * g[2 * q], f[2 * q + 1] * r * g[2 * q + 1]);
        *(GAS v4u*)base = (v4u){o[0], o[1], o[2], o[3]}; *(GAS v4u*)(base + 8) = (v4u){o[4], o[5], o[6], o[7]};
    }
}
__device__ __forceinline__ int t5_bucket(int n) {
    if (n < 16) return n;
    int l = 16 + (int)(__logf((float)n / 16.f) / 2.0794415416798357f * 16.f);
    return l < 31 ? l : 31;
}
__device__ __forceinline__ void attn_naive_phase(const Args& a, LAS unsigned char* lds) {
    const int tid = opaque_tid(), lane = tid & 63;
    LAS float* Qs = (LAS float*)lds;
    LAS float* Ks = Qs + 64 * 129;
    LAS float* Vs = Ks + 64 * 129;
    LAS float* Ws = Vs + 64 * 128;
    LAS float* btab = Ws + 64 * 65;
    const bf16* Kb = (const bf16*)(opaque_ws(a) + WS_K); const bf16* Vb = (const bf16*)(opaque_ws(a) + WS_V); bf16* Qb = (bf16*)(opaque_ws(a) + WS_Q);
    const float* rel_bias = ARG_IN(a, 13); const float* lv = ARG_IN(a, 17);
    const int r = tid >> 3, ks = tid & 7;
    for (int item = blockIdx.x; item < 4096; item += gridDim.x) {
        const int qb = 31 - (item >> 7), bh = item & 127, b = bh >> 3, h = bh & 7;
        const size_t row0 = (size_t)b * SEQ + qb * 64;
        __syncthreads();
        for (int e = tid; e < 64 * 128; e += 512) { const int rr = e >> 7, c = e & 127; Qs[rr * 129 + c] = bf2f(Qb[(row0 + rr) * 1024 + h * 128 + c]); }
        if (tid < 129) { const int bk = t5_bucket(tid); btab[tid] = rel_bias[bk * 8 + h] * LOG2E; }
        if (tid < 64) { float s0 = lv[tid] * lv[64 + tid], s1 = lv[128 + tid] * lv[192 + tid]; s0 = wave_sum(s0); s1 = wave_sum(s1); if (tid == 0) btab[129] = __expf(s0) - __expf(s1) + LAM_INIT; }
        const int qpos = qb * 64 + r;
        float m0 = -1e30f, l0 = 0.f, m1 = -1e30f, l1 = 0.f;
        for (int kt = 0; kt <= qb; ++kt) {
            __syncthreads();
            for (int e = tid; e < 64 * 128; e += 512) { const int kk = e >> 7, c = e & 127; Ks[kk * 129 + c] = bf2f(Kb[((size_t)b * SEQ + kt * 64 + kk) * 1024 + h * 128 + c]); }
            __syncthreads();
            float s0[8], s1[8];
#pragma unroll
            for (int i = 0; i < 8; ++i) { s0[i] = 0.f; s1[i] = 0.f; }
            for (int d = 0; d < 64; ++d) { const float q0 = Qs[r * 129 + d], q1 = Qs[r * 129 + 64 + d];
#pragma unroll
                for (int i = 0; i < 8; ++i) { s0[i] += q0 * Ks[(ks * 8 + i) * 129 + d]; s1[i] += q1 * Ks[(ks * 8 + i) * 129 + 64 + d]; } }
#pragma unroll
            for (int i = 0; i < 8; ++i) { const int kpos = kt * 64 + ks * 8 + i;
                if (kpos <= qpos) { const int dist = qpos - kpos; const float bb = btab[dist < 128 ? dist : 128];
                    const float a0 = s0[i] + bb, a1 = s1[i] + bb;
                    float mn = fmaxf(m0, a0); l0 = l0 * exp2f(m0 - mn) + exp2f(a0 - mn); m0 = mn;
                    mn = fmaxf(m1, a1); l1 = l1 * exp2f(m1 - mn) + exp2f(a1 - mn); m1 = mn; } }
        }
#pragma unroll
        for (int off = 1; off < 8; off <<= 1) {
            float mo = shfl_xor_f(m0, off), lo = shfl_xor_f(l0, off); float mn = fmaxf(m0, mo); l0 = l0 * exp2f(m0 - mn) + lo * exp2f(mo - mn); m0 = mn;
            mo = shfl_xor_f(m1, off); lo = shfl_xor_f(l1, off); mn = fmaxf(m1, mo); l1 = l1 * exp2f(m1 - mn) + lo * exp2f(mo - mn); m1 = mn;
        }
        const float inv0 = 1.f / l0, inv1 = 1.f / l1, lam = btab[129];
        float o[16];
#pragma unroll
        for (int d = 0; d < 16; ++d) o[d] = 0.f;
        for (int kt = 0; kt <= qb; ++kt) {
            __syncthreads();
            for (int e = tid; e < 64 * 128; e += 512) { const int kk = e >> 7, c = e & 127; const size_t gi = ((size_t)b * SEQ + kt * 64 + kk) * 1024 + h * 128 + c;
                Ks[kk * 129 + c] = bf2f(Kb[gi]); Vs[kk * 128 + c] = bf2f(Vb[gi]); }
            __syncthreads();
            float s0[8], s1[8];
#pragma unroll
            for (int i = 0; i < 8; ++i) { s0[i] = 0.f; s1[i] = 0.f; }
            for (int d = 0; d < 64; ++d) { const float q0 = Qs[r * 129 + d], q1 = Qs[r * 129 + 64 + d];
#pragma unroll
                for (int i = 0; i < 8; ++i) { s0[i] += q0 * Ks[(ks * 8 + i) * 129 + d]; s1[i] += q1 * Ks[(ks * 8 + i) * 129 + 64 + d]; } }
#pragma unroll
            for (int i = 0; i < 8; ++i) { const int kpos = kt * 64 + ks * 8 + i; float w = 0.f;
                if (kpos <= qpos) { const int dist = qpos - kpos; const float bb = btab[dist < 128 ? dist : 128];
                    w = exp2f(s0[i] + bb - m0) * inv0 - lam * exp2f(s1[i] + bb - m1) * inv1; }
                Ws[r * 65 + ks * 8 + i] = w; }
            __syncthreads();
            for (int kk = 0; kk < 64; ++kk) { const float w = Ws[r * 65 + kk];
#pragma unroll
                for (int d = 0; d < 16; ++d) o[d] += w * Vs[kk * 128 + ks * 16 + d]; }
        }
        float ss = 0.f;
#pragma unroll
        for (int d = 0; d < 16; ++d) ss += o[d] * o[d];
        ss += shfl_xor_f(ss, 1); ss += shfl_xor_f(ss, 2); ss += shfl_xor_f(ss, 4);
        const float rs = 1.f / sqrtf(ss * (1.f / 128.f) + EPS);
        bf16* op = Qb + (row0 + r) * 1024 + h * 128 + ks * 16;
        *(GAS v4u*)op = (v4u){pk2(o[0] * rs, o[1] * rs), pk2(o[2] * rs, o[3] * rs), pk2(o[4] * rs, o[5] * rs), pk2(o[6] * rs, o[7] * rs)};
        *(GAS v4u*)(op + 8) = (v4u){pk2(o[8] * rs, o[9] * rs), pk2(o[10] * rs, o[11] * rs), pk2(o[12] * rs, o[13] * rs), pk2(o[14] * rs, o[15] * rs)};
        (void)lane;
    }
}

typedef float f32x16 __attribute__((ext_vector_type(16)));
typedef short s16x4 __attribute__((ext_vector_type(4)));
typedef short v4i16_t __attribute__((ext_vector_type(4)));
__device__ __forceinline__ int crow(int r, int hi) { return (r & 3) + 8 * (r >> 2) + 4 * hi; }
__device__ __forceinline__ s16x4 vtr(const LAS unsigned char* p) { return __builtin_bit_cast(s16x4, __builtin_amdgcn_ds_read_tr16_b64_v4i16((LAS v4i16_t*)p)); }
template <int CTRL> __device__ __forceinline__ float dpp_add(float v) { return v + __builtin_bit_cast(float, __builtin_amdgcn_update_dpp(0, __builtin_bit_cast(int, v), CTRL, 0xf, 0xf, true)); }
__device__ __forceinline__ float red32(float v) {
    v = dpp_add<0xB1>(v); v = dpp_add<0x4E>(v); v = dpp_add<0x141>(v); v = dpp_add<0x140>(v);
    return v + __builtin_bit_cast(float, __builtin_amdgcn_ds_swizzle(__builtin_bit_cast(int, v), 0x401F));
}
__device__ __forceinline__ float wave_max(float v) {
#pragma unroll
    for (int o = 1; o < 64; o <<= 1) v = fmaxf(v, shfl_xor_f(v, o));
    return v;
}
__device__ __forceinline__ void glds16(const void* sbase, unsigned voff, unsigned lds_dst) { unsigned keep;
    asm volatile("s_nop 4\n\ts_mov_b32 %0, m0\n\ts_mov_b32 m0, %3\n\ts_nop 0\n\tglobal_load_lds_dwordx4 %1, %2\n\ts_mov_b32 m0, %0" : "=&s"(keep) : "v"(voff), "s"(sbase), "s"(lds_dst) : "memory"); }
__device__ __forceinline__ void attn_fast_phase(const Args& a, LAS unsigned char* lds, int vcu) {
    const int tid = opaque_tid(), lane = tid & 63, wid = __builtin_amdgcn_readfirstlane(tid >> 6), r32 = lane & 31, hi = lane >> 5;
    const int comp = wid >> 2, wq = wid & 3;
    const bf16* Kb = (const bf16*)(opaque_ws(a) + WS_K); const bf16* Vb = (const bf16*)(opaque_ws(a) + WS_V); const bf16* Qb = (const bf16*)(opaque_ws(a) + WS_Q); bf16* Ob = (bf16*)(opaque_ws(a) + WS_O);
    const float* rel_bias = ARG_IN(a, 13); const float* lv = ARG_IN(a, 17);
    LAS float* misc = (LAS float*)(lds + 131072);
    LAS float* wsf = misc + 256 + wid * 32;
    LAS float* X = (LAS float*)lds;
    const unsigned lds0 = (unsigned)(uintptr_t)lds;
    LAS float* tabs = misc + 512;
    { const int k = tid >> 7, d = tid & 127, hk = (4 * (vcu >> 3) + k) & 7;
      tabs[k * 132 + d] = rel_bias[t5_bucket(d) * 8 + hk] * LOG2E;
      if (d == 0) tabs[k * 132 + 128] = rel_bias[31 * 8 + hk] * LOG2E; }
    if (wid < 4) {
        const int hk = (4 * (vcu >> 3) + wid) & 7;
        float s0 = lv[lane] * lv[64 + lane], s1 = lv[128 + lane] * lv[192 + lane]; s0 = wave_sum(s0); s1 = wave_sum(s1);
        const float gq = wave_max(fabsf(ARG_IN(a, 16)[lane])), gk = wave_max(fabsf(ARG_IN(a, 12)[lane]));
        const float bm = wave_max(lane < 32 ? rel_bias[lane * 8 + hk] * LOG2E : -1e30f);
        if (lane == 0) { tabs[wid * 132 + 129] = __expf(s0) - __expf(s1) + LAM_INIT; tabs[wid * 132 + 131] = QSCALE * 64.f * gq * gk + bm; }
    }
    __syncthreads();
    for (int j = 0; j < 8; ++j) {
        const int bh = 4 * (vcu >> 3) + (j >> 1), s8 = vcu & 7, qb = (j & 1) ? 15 - s8 : s8;
        const int b = bh >> 3, h = bh & 7;
        const size_t tok0 = (size_t)b * SEQ;
        const int q0 = qb * 128;
        const LAS float* mt = tabs + (j >> 1) * 132;
        const bf16* qp = Qb + (tok0 + q0 + 32 * wq + r32) * 1024 + h * 128 + comp * 64 + 8 * hi;
        bf16x8 qr[4];
#pragma unroll
        for (int ks = 0; ks < 4; ++ks) qr[ks] = *(const GAS bf16x8*)(qp + 16 * ks);
        f32x16 o[4];
#pragma unroll
        for (int d = 0; d < 4; ++d)
#pragma unroll
            for (int r = 0; r < 16; ++r) o[d][r] = 0.f;
        float lsum = 0.f;
        const int NT = 2 * (qb + 1);
        const bf16* ksrc0 = Kb + tok0 * 1024 + h * 128;
        const unsigned kvoff = ((lane >> 2) * 1024 + 8 * ((lane & 3) ^ ((lane >> 4) & 3))) * 2, vvoff = ((lane >> 2) * 1024 + 8 * (lane & 3)) * 2;
        const bf16* vsrc0 = Vb + tok0 * 1024 + h * 128;
#define ATT_DMA_TILE(t, slot) do { _Pragma("unroll") for (int i_ = 0; i_ < 2; ++i_) { const int pk_ = wid + 8 * i_, d32_ = pk_ >> 2, k16_ = pk_ & 3; \
            glds16(ksrc0 + (size_t)(64 * (t) + 16 * k16_) * 1024 + 32 * d32_, kvoff, (unsigned)__builtin_amdgcn_readfirstlane((int)(lds0 + (slot) * 32768 + pk_ * 1024))); } \
        _Pragma("unroll") for (int i_ = 0; i_ < 2; ++i_) { const int pv_ = wid + 8 * i_, dvb_ = pv_ >> 2, k16_ = pv_ & 3; \
            glds16(vsrc0 + (size_t)(64 * (t) + 16 * k16_) * 1024 + 32 * dvb_, vvoff, (unsigned)__builtin_amdgcn_readfirstlane((int)(lds0 + (slot) * 32768 + 16384 + pv_ * 1024))); } } while (0)
        ATT_DMA_TILE(0, 0); ATT_DMA_TILE(1, 1);
        if (NT > 2) ATT_DMA_TILE(2, 2);
        asm volatile("" : "+v"(qr[0]), "+v"(qr[1]), "+v"(qr[2]), "+v"(qr[3]));
        if (NT > 2) asm volatile("s_waitcnt vmcnt(8) lgkmcnt(0)" ::: "memory"); else asm volatile("s_waitcnt vmcnt(4) lgkmcnt(0)" ::: "memory");
        __builtin_amdgcn_s_barrier(); asm volatile("" ::: "memory");
        const float cfar = mt[128] - mt[131], cnear = -mt[131];
        const int qpos = q0 + 32 * wq + r32;
        f32x16 cfarv;
#pragma unroll
        for (int r = 0; r < 16; ++r) cfarv[r] = cfar;
        asm volatile("" : "+v"(cfarv));
#define ATT_QK(P0, P1, tt, slot_) do { const LAS unsigned char* kb_ = lds + (slot_) * 32768 + (r32 >> 4) * 1024 + (r32 & 15) * 64; \
            bf16x8 kf_[8]; \
            _Pragma("unroll") for (int ks = 0; ks < 4; ++ks) { const int po_ = (comp * 2 + (ks >> 1)) * 4096 + ((((ks & 1) * 2 + hi) ^ ((r32 >> 2) & 3)) * 16); \
                kf_[2 * ks] = *(const LAS bf16x8*)(kb_ + po_); kf_[2 * ks + 1] = *(const LAS bf16x8*)(kb_ + po_ + 2048); } \
              \
            if ((tt) >= NT - 4) { f32x16 cn_; _Pragma("unroll") for (int r = 0; r < 16; ++r) cn_[r] = cnear; \
                P0 = __builtin_amdgcn_mfma_f32_32x32x16_bf16(kf_[0], qr[0], cn_, 0, 0, 0); P1 = __builtin_amdgcn_mfma_f32_32x32x16_bf16(kf_[1], qr[0], cn_, 0, 0, 0); } \
            else { P0 = __builtin_amdgcn_mfma_f32_32x32x16_bf16(kf_[0], qr[0], cfarv, 0, 0, 0); P1 = __builtin_amdgcn_mfma_f32_32x32x16_bf16(kf_[1], qr[0], cfarv, 0, 0, 0); } \
            _Pragma("unroll") for (int ks = 1; ks < 4; ++ks) { \
                P0 = __builtin_amdgcn_mfma_f32_32x32x16_bf16(kf_[2 * ks], qr[ks], P0, 0, 0, 0); \
                P1 = __builtin_amdgcn_mfma_f32_32x32x16_bf16(kf_[2 * ks + 1], qr[ks], P1, 0, 0, 0); } } while (0)
#define ATT_PV(slot_) do { const LAS unsigned char* vbase_ = lds + (slot_) * 32768 + 16384 + ((lane >> 4) & 1) * 32 + (lane & 3) * 8 + (4 * hi + ((lane & 15) >> 2)) * 64; \
            _Pragma("unroll") for (int dvb = 0; dvb < 4; ++dvb) _Pragma("unroll") for (int ks = 0; ks < 4; ++ks) { \
                const s16x4 lo_ = vtr(vbase_ + dvb * 4096 + ks * 1024), hh_ = vtr(vbase_ + dvb * 4096 + ks * 1024 + 512); \
                const bf16x8 vf_ = (bf16x8){lo_[0], lo_[1], lo_[2], lo_[3], hh_[0], hh_[1], hh_[2], hh_[3]}; \
                o[dvb] = __builtin_amdgcn_mfma_f32_32x32x16_bf16(__builtin_bit_cast(bf16x8, pw[ks]), vf_, o[dvb], 0, 0, 0); \
                } } while (0)
        f32x16 p0, p1;
        u32x4v pw[4];
#pragma unroll
        for (int q = 0; q < 4; ++q) pw[q] = (u32x4v){0u, 0u, 0u, 0u};
        int slotp = 3, slot = 0, slotn = 1, slotf = 2;
        for (int t = 0; t < NT; ++t) {
            if (comp == 1 && t > 0) ATT_PV(slotp);
            ATT_QK(p0, p1, t, slot);
            const bool near = t >= NT - 4;
            if (near) {
#define ATT_NEAR(P, koff) do { float bb_[16]; \
                    _Pragma("unroll") for (int r = 0; r < 16; ++r) { const int d_ = qpos - (64 * t + (koff) + crow(r, hi)); bb_[r] = mt[d_ < 0 ? 0 : (d_ < 128 ? d_ : 128)]; } \
                    _Pragma("unroll") for (int r = 0; r < 16; ++r) asm volatile("" : "+v"(bb_[r]));        \
                    _Pragma("unroll") for (int r = 0; r < 16; ++r) { const int d_ = qpos - (64 * t + (koff) + crow(r, hi)); const float x_ = P[r] + bb_[r]; \
                        P[r] = __builtin_amdgcn_exp2f(d_ < 0 ? -INFINITY : x_); } } while (0)
                ATT_NEAR(p0, 0); ATT_NEAR(p1, 32);
#undef ATT_NEAR
            } else {
#pragma unroll
                for (int r = 0; r < 16; ++r) { p0[r] = __builtin_amdgcn_exp2f(p0[r]); p1[r] = __builtin_amdgcn_exp2f(p1[r]); }
            }
            { typedef float f32x2a __attribute__((ext_vector_type(2)));
              f32x2a sa = (f32x2a){p0[0], p0[1]} + (f32x2a){p1[0], p1[1]};
#pragma unroll
              for (int r = 2; r < 16; r += 2) sa += (f32x2a){p0[r], p0[r + 1]} + (f32x2a){p1[r], p1[r + 1]};
              lsum += sa.x + sa.y; }
#pragma unroll
            for (int q = 0; q < 4; ++q) { pw[0][q] = pk2(p0[2 * q], p0[2 * q + 1]); pw[1][q] = pk2(p0[8 + 2 * q], p0[9 + 2 * q]);
                pw[2][q] = pk2(p1[2 * q], p1[2 * q + 1]); pw[3][q] = pk2(p1[8 + 2 * q], p1[9 + 2 * q]); }
            if (comp == 0) ATT_PV(slot);
            if (t + 2 < NT) asm volatile("s_waitcnt vmcnt(4) lgkmcnt(0)" ::: "memory"); else asm volatile("s_waitcnt vmcnt(0) lgkmcnt(0)" ::: "memory");
            __builtin_amdgcn_s_barrier(); asm volatile("" ::: "memory");
            if (t + 3 < NT) ATT_DMA_TILE(t + 3, slotp);
            { const int s_ = slotp; slotp = slot; slot = slotn; slotn = slotf; slotf = s_; }
        }
        if (comp == 1) ATT_PV(slotp);
        asm volatile("s_waitcnt lgkmcnt(0)" ::: "memory"); __builtin_amdgcn_s_barrier(); asm volatile("" ::: "memory");
#undef ATT_PV
#undef ATT_QK
#undef ATT_DMA_TILE
        const float lt = lsum + shfl_xor_f(lsum, 32);
        if (hi == 0) wsf[r32] = lt;
        LDS_WAIT(); asm volatile("" ::: "memory");
        float rli[16];
#pragma unroll
        for (int r = 0; r < 16; ++r) rli[r] = __builtin_amdgcn_rcpf(wsf[crow(r, hi)]);
        if (comp == 1) {
            const float lam = mt[129];
#pragma unroll
            for (int dvb = 0; dvb < 4; ++dvb)
#pragma unroll
                for (int q = 0; q < 4; ++q) {
                    f32x4 w;
#pragma unroll
                    for (int i = 0; i < 4; ++i) w[i] = o[dvb][4 * q + i] * rli[4 * q + i] * lam;
                    *(LAS f32x4*)(X + ((wq * 128 + 32 * dvb + r32) * 36 + 8 * q + 4 * hi)) = w; }
        }
        __syncthreads();
        if (comp == 0) {
            float ss[16];
#pragma unroll
            for (int r = 0; r < 16; ++r) ss[r] = 0.f;
#pragma unroll
            for (int dvb = 0; dvb < 4; ++dvb)
#pragma unroll
                for (int q = 0; q < 4; ++q) { const f32x4 xv = *(const LAS f32x4*)(X + ((wq * 128 + 32 * dvb + r32) * 36 + 8 * q + 4 * hi));
#pragma unroll
                    for (int i = 0; i < 4; ++i) { const int r = 4 * q + i; const float v = o[dvb][r] * rli[r] - xv[i]; o[dvb][r] = v; ss[r] += v * v; } }
#pragma unroll
            for (int r = 0; r < 16; ++r) { float s = ss[r]; s = red32(s); ss[r] = 1.f / sqrtf(s * (1.f / 128.f) + EPS); }
            LDS_WAIT(); asm volatile("" ::: "memory");
            LAS bf16* stg = (LAS bf16*)((LAS unsigned char*)X + 73728 + wq * 8192);
#pragma unroll
            for (int dvb = 0; dvb < 4; ++dvb)
#pragma unroll
                for (int r = 0; r < 16; ++r) stg[crow(r, hi) * 128 + 32 * dvb + r32] = (bf16)f2bf(o[dvb][r] * ss[r]);
            LDS_WAIT(); asm volatile("" ::: "memory");
            const int lane_e = opaque_tid() & 63;
#pragma unroll
            for (int i = 0; i < 8; ++i) { const int row = 4 * i + (lane_e >> 4), ch = lane_e & 15;
                const v4u w = *(const LAS v4u*)(stg + row * 128 + ch * 8);
                *(GAS v4u*)(Ob + (tok0 + q0 + 32 * wq + row) * 1024 + h * 128 + ch * 8) = w; }
        }
        __syncthreads();
    }
}

constexpr int SSD_LD = 272;
constexpr int SSD_BS = 0, SSD_CS = 128 * SSD_LD, SSD_XS = 2 * 128 * SSD_LD, SSD_ST = 3 * 128 * SSD_LD, SSD_VEC = 4 * 128 * SSD_LD,
              SSD_HALO = SSD_VEC + 2048, SSD_STG = SSD_HALO + 2048, SSD_GSL = SSD_STG + 8 * 2048;
static_assert(SSD_GSL + 1024 <= LDSCTL_OFF, "SSD LDS map");
__device__ __forceinline__ bf16x8 frag_tr(const LAS unsigned char* p) {
    const s16x4 lo = vtr(p), hh = vtr(p + 8 * SSD_LD);
    return (bf16x8){lo[0], lo[1], lo[2], lo[3], hh[0], hh[1], hh[2], hh[3]};
}
__device__ __forceinline__ void ssd_fast_phase(const Args& a, LAS unsigned char* lds, int vcu) {
    const int tid = opaque_tid(), lane = tid & 63, wid = __builtin_amdgcn_readfirstlane(tid >> 6), r32 = lane & 31, hi = lane >> 5;
    const unsigned zz_ = (unsigned)tid >> 31; const v4u vzero = {zz_, zz_, zz_, zz_};
    const int hh = wid >> 2, wl = hh ? 3 - (wid & 3) : (wid & 3), wn = wid & 3;
    const int b = vcu >> 4, g = (vcu >> 2) & 3, h0 = 8 * g + 2 * (vcu & 3), hd = h0 + hh;
    float* gss = (float*)(opaque_ws(a) + WS_GSS);
    const bf16* XBC = (const bf16*)(opaque_ws(a) + WS_XBC); const float* DT = (const float*)(opaque_ws(a) + WS_DT);
    const size_t tok0 = (size_t)b * SEQ;
    LAS float* dtv = (LAS float*)(lds + SSD_VEC);
    LAS float* acs = dtv + 256;
#define SSD_ROLES() const int tidr_ = opaque_tid(); const int cg = tidr_ % 48, ls = tidr_ / 48; \
    const int ccol = cg < 16 ? 64 * h0 + 8 * cg : (cg < 32 ? 2048 + 128 * g + 8 * (cg - 16) : 2560 + 128 * g + 8 * (cg - 32)); \
    const int cdst = (cg < 16 ? SSD_XS + 16 * cg : (cg < 32 ? SSD_BS + 16 * (cg - 16) : SSD_CS + 16 * (cg - 32))); (void)cdst; (void)ccol; (void)ls
    const float Aneg = -__expf(ARG_IN(a, 6)[hd]), Dh = ARG_IN(a, 7)[hd];
    f32x16 stq[2];
#pragma unroll
    for (int pb = 0; pb < 2; ++pb)
#pragma unroll
        for (int r = 0; r < 16; ++r) stq[pb][r] = 0.f;
    for (int e = tid; e < 128 * SSD_LD / 16; e += 512) *(LAS v4u*)(lds + SSD_ST + e * 16) = vzero;
    const int g16 = (lane >> 4) & 1, tq = (lane & 15) >> 2, tp = lane & 3;
    v4u pre[16];
#define SSD_PREFETCH(ch_) do { if (tid < 384) { SSD_ROLES(); const bf16* src_ = XBC + (tok0 + (ch_) * 128 + 16 * ls) * NXBC + ccol; \
        _Pragma("unroll") for (int i = 0; i < 16; ++i) pre[i] = *(const GAS v4u*)(src_ + (size_t)i * NXBC); } } while (0)
    float dtp[2] = {0.f, 0.f};
#define SSD_DTPREFETCH(ch_) do { if (wid >= 6) { const int hq_ = h0 + (wid - 6); const int lane_ = opaque_tid() & 63; \
        dtp[0] = DT[(tok0 + (ch_) * 128 + lane_) * 32 + hq_]; dtp[1] = DT[(tok0 + (ch_) * 128 + 64 + lane_) * 32 + hq_]; } } while (0)
    SSD_PREFETCH(0); SSD_DTPREFETCH(0);
    for (int ch = 0; ch < SEQ / 128; ++ch) {
        const int t0 = ch * 128;
        if (tid < 384) {
            SSD_ROLES();
#pragma unroll
            for (int i = 0; i < 16; ++i) *(LAS v4u*)(lds + cdst + (16 * ls + i) * SSD_LD) = pre[i];
        } else {
            const int q = wid - 6, hq = h0 + q; const float An = -__expf(ARG_IN(a, 6)[hq]), dtb = ARG_IN(a, 5)[hq];
            const float r0 = dtp[0] + dtb, r1 = dtp[1] + dtb;
            const float d0 = r0 > 20.f ? r0 : __logf(1.f + __expf(r0)), d1 = r1 > 20.f ? r1 : __logf(1.f + __expf(r1));
            float s0 = d0 * An, s1 = d1 * An;
#define SSD_DPP(v_, ctrl_, rmask_, bc_) __builtin_bit_cast(float, __builtin_amdgcn_update_dpp(0, __builtin_bit_cast(int, v_), ctrl_, rmask_, 0xf, bc_))
#define SSD_SCAN(v_) do { v_ += SSD_DPP(v_, 0x111, 0xf, true); v_ += SSD_DPP(v_, 0x112, 0xf, true); v_ += SSD_DPP(v_, 0x114, 0xf, true); v_ += SSD_DPP(v_, 0x118, 0xf, true); \
                v_ += SSD_DPP(v_, 0x142, 0xa, false); v_ += SSD_DPP(v_, 0x143, 0xc, false); } while (0)
            SSD_SCAN(s0); SSD_SCAN(s1);
#undef SSD_SCAN
#undef SSD_DPP
            s1 += __builtin_bit_cast(float, __builtin_amdgcn_readlane(__builtin_bit_cast(int, s0), 63));
            dtv[q * 128 + lane] = d0; dtv[q * 128 + 64 + lane] = d1; acs[q * 128 + lane] = s0; acs[q * 128 + 64 + lane] = s1;
        }
        __syncthreads();
        {
            const int lane = opaque_tid() & 63, r32 = lane & 31, hi = lane >> 5, g16 = (lane >> 4) & 1, tq = (lane & 15) >> 2, tp = lane & 3;
            bf16* Zb = (bf16*)(opaque_ws(a) + WS_Z);
            v4u zv[2][2];
#pragma unroll
            for (int pb = 0; pb < 2; ++pb)
#pragma unroll
                for (int i = 0; i < 2; ++i) zv[pb][i] = *(const GAS v4u*)(Zb + (tok0 + t0 + 32 * wl + 16 * i + (lane >> 2)) * DIN + 64 * hd + 32 * pb + (lane & 3) * 8);
            bf16x8 cf[8];
            const LAS unsigned char* cp = lds + SSD_CS + (32 * wl + r32) * SSD_LD + 16 * hi;
#pragma unroll
            for (int ks = 0; ks < 8; ++ks) cf[ks] = *(const LAS bf16x8*)(cp + 32 * ks);
            f32x16 acc[2];
#pragma unroll
            for (int pb = 0; pb < 2; ++pb) {
#pragma unroll
                for (int r = 0; r < 16; ++r) acc[pb][r] = 0.f;
                const LAS unsigned char* sp = lds + SSD_ST + (hh * 64 + 32 * pb + r32) * SSD_LD + 16 * hi;
#pragma unroll
                for (int ks = 0; ks < 8; ++ks) acc[pb] = __builtin_amdgcn_mfma_f32_32x32x16_bf16(cf[ks], *(const LAS bf16x8*)(sp + 32 * ks), acc[pb], 0, 0, 0);
            }
            const LAS float* acsh = acs + hh * 128; const LAS float* dth = dtv + hh * 128;
#pragma unroll
            for (int q = 0; q < 4; ++q) { const f32x4 av = *(const LAS f32x4*)(acsh + 32 * wl + 8 * q + 4 * hi);
#pragma unroll
                for (int i = 0; i < 4; ++i) { const float e = __expf(av[i]); acc[0][4 * q + i] *= e; acc[1][4 * q + i] *= e; } }
            const int lrow = 32 * wl + r32; const float acs_l = acsh[lrow];
            for (int sb = 0; sb <= wl; ++sb) {
                f32x16 gt;
#pragma unroll
                for (int r = 0; r < 16; ++r) gt[r] = 0.f;
                const LAS unsigned char* bp = lds + SSD_BS + (32 * sb + r32) * SSD_LD + 16 * hi;
#pragma unroll
                for (int ks = 0; ks < 8; ++ks) gt = __builtin_amdgcn_mfma_f32_32x32x16_bf16(*(const LAS bf16x8*)(bp + 32 * ks), cf[ks], gt, 0, 0, 0);
#pragma unroll
                for (int q = 0; q < 4; ++q) { const f32x4 av = *(const LAS f32x4*)(acsh + 32 * sb + 8 * q + 4 * hi), dv = *(const LAS f32x4*)(dth + 32 * sb + 8 * q + 4 * hi);
#pragma unroll
                    for (int i = 0; i < 4; ++i) { const int r = 4 * q + i, s = 32 * sb + 8 * q + 4 * hi + i;
                        float m = gt[r] * __expf(acs_l - av[i]) * dv[i];
                        if (s == lrow) m += Dh;
                        gt[r] = (s <= lrow) ? m : 0.f; } }
                u32x4v pw0, pw1;
#pragma unroll
                for (int q = 0; q < 4; ++q) { pw0[q] = pg8::cvt_pk_bf16(gt[2 * q], gt[2 * q + 1]); pw1[q] = pg8::cvt_pk_bf16(gt[8 + 2 * q], gt[9 + 2 * q]); }
#pragma unroll
                for (int pb = 0; pb < 2; ++pb) {
                    const LAS unsigned char* xp = lds + SSD_XS + (32 * sb + 4 * hi + tq) * SSD_LD + (64 * hh + 32 * pb + 16 * g16 + 4 * tp) * 2;
                    acc[pb] = __builtin_amdgcn_mfma_f32_32x32x16_bf16(__builtin_bit_cast(bf16x8, pw0), frag_tr(xp), acc[pb], 0, 0, 0);
                    acc[pb] = __builtin_amdgcn_mfma_f32_32x32x16_bf16(__builtin_bit_cast(bf16x8, pw1), frag_tr(xp + 16 * SSD_LD), acc[pb], 0, 0, 0);
                }
            }
            LAS bf16* stg = (LAS bf16*)(lds + SSD_STG + wid * 2048);
            float sqa[2] = {0.f, 0.f};
#pragma unroll
            for (int pb = 0; pb < 2; ++pb) {
#pragma unroll
                for (int r = 0; r < 16; ++r) stg[crow(r, hi) * 32 + r32] = (bf16)f2bf(acc[pb][r]);
                LDS_WAIT(); asm volatile("" ::: "memory");
#pragma unroll
                for (int i = 0; i < 2; ++i) { const int row = 16 * i + (lane >> 2), c8 = (lane & 3) * 8;
                    float y[8], z[8]; unpack8(*(const LAS v4u*)(stg + row * 32 + c8), y); unpack8(zv[pb][i], z);
                    float sq = 0.f;
#pragma unroll
                    for (int e = 0; e < 8; ++e) { y[e] *= silu_f(z[e]); sq += y[e] * y[e]; }
                    *(GAS v4u*)(Zb + (tok0 + t0 + 32 * wl + row) * DIN + 64 * hd + 32 * pb + c8) = (v4u){pk2(y[0], y[1]), pk2(y[2], y[3]), pk2(y[4], y[5]), pk2(y[6], y[7])};
                    sqa[i] += sq; }
                LDS_WAIT(); asm volatile("" ::: "memory");
            }
#pragma unroll
            for (int i = 0; i < 2; ++i) { float sq = sqa[i];
                sq += __builtin_bit_cast(float, __builtin_amdgcn_update_dpp(0, __builtin_bit_cast(int, sq), 0xB1, 0xf, 0xf, true));
                sq += __builtin_bit_cast(float, __builtin_amdgcn_update_dpp(0, __builtin_bit_cast(int, sq), 0x4E, 0xf, 0xf, true));
                if ((lane & 3) == 0) ((LAS float*)(lds + SSD_GSL))[hh * 128 + 32 * wl + 16 * i + (lane >> 2)] = sq; }
        }
        __syncthreads();
        if (ch + 1 < SEQ / 128) { SSD_PREFETCH(ch + 1); SSD_DTPREFETCH(ch + 1); }
        {
            const int tidc = opaque_tid();
            if (tidc < 128) gss[(tok0 + t0 + tidc) * 16 + g * 4 + (vcu & 3)] = ((LAS float*)(lds + SSD_GSL))[tidc] + ((LAS float*)(lds + SSD_GSL))[128 + tidc];
 const int l = tidc >> 2, c0 = (tidc & 3) * 32, hq = c0 >> 6;
            const float f = __expf(acs[hq * 128 + 127] - acs[hq * 128 + l]) * dtv[hq * 128 + l];
            LAS unsigned char* xp = lds + SSD_XS + l * SSD_LD + c0 * 2;
#pragma unroll
            for (int q = 0; q < 4; ++q) { v4u w = *(LAS v4u*)(xp + 16 * q); unsigned ww[4] = {w.x, w.y, w.z, w.w};
#pragma unroll
                for (int i = 0; i < 4; ++i) ww[i] = pk2(__builtin_bit_cast(float, ww[i] << 16) * f, __builtin_bit_cast(float, ww[i] & 0xffff0000u) * f);
                *(LAS v4u*)(xp + 16 * q) = (v4u){ww[0], ww[1], ww[2], ww[3]}; }
        }
        __syncthreads();
        {
            const int lane = opaque_tid() & 63, r32 = lane & 31, hi = lane >> 5, g16 = (lane >> 4) & 1, tq = (lane & 15) >> 2, tp = lane & 3;
            const float eL = __expf(acs[hh * 128 + 127]);
#pragma unroll
            for (int pb = 0; pb < 2; ++pb)
#pragma unroll
                for (int r = 0; r < 16; ++r) stq[pb][r] *= eL;
            const LAS unsigned char* bp = lds + SSD_BS + (4 * hi + tq) * SSD_LD + (32 * wn + 16 * g16 + 4 * tp) * 2;
            const LAS unsigned char* xp = lds + SSD_XS + (4 * hi + tq) * SSD_LD + (64 * hh + 16 * g16 + 4 * tp) * 2;
#pragma unroll
            for (int ks = 0; ks < 8; ++ks) {
                const bf16x8 bt = frag_tr(bp + 16 * ks * SSD_LD);
                stq[0] = __builtin_amdgcn_mfma_f32_32x32x16_bf16(bt, frag_tr(xp + 16 * ks * SSD_LD), stq[0], 0, 0, 0);
                stq[1] = __builtin_amdgcn_mfma_f32_32x32x16_bf16(bt, frag_tr(xp + 16 * ks * SSD_LD + 64), stq[1], 0, 0, 0);
            }
#pragma unroll
            for (int pb = 0; pb < 2; ++pb)
#pragma unroll
                for (int rg = 0; rg < 4; ++rg) {
                    typedef unsigned u32x2v __attribute__((ext_vector_type(2)));
                    u32x2v w; w.x = pg8::cvt_pk_bf16(stq[pb][4 * rg], stq[pb][4 * rg + 1]); w.y = pg8::cvt_pk_bf16(stq[pb][4 * rg + 2], stq[pb][4 * rg + 3]);
                    *(LAS u32x2v*)(lds + SSD_ST + (hh * 64 + 32 * pb + r32) * SSD_LD + (32 * wn + 8 * rg + 4 * hi) * 2) = w;
                }
        }
        __syncthreads();
    }
}


#ifndef MK_ONE_LAUNCH
#define MK_ONE_LAUNCH 1
#endif
constexpr int N_PHASES = 24;
#ifndef MK_PROG
#define MK_PROG {0, 1, 25, 2, 4, 6, 7, 8, 13, 15, 16, 18, 19, 20}
#endif
__global__ void __launch_bounds__(NWAVES * 64, 2) mk_fwd(Args args) {
    extern __shared__ __attribute__((aligned(16))) unsigned char lds_raw[];
    LAS unsigned char* lds = (LAS unsigned char*)lds_raw;
    const int G = gridDim.x;
#ifdef PROBE_PH
    const long long tk0_ = __builtin_amdgcn_s_memrealtime();
#endif
    const int vcu = (G % 8 == 0) ? ((int)blockIdx.x % 8) * (G / 8) + (int)blockIdx.x / 8 : (int)blockIdx.x;
    const int NGW = G * NWAVES;
    gu32* ctl = (gu32*)(args.ws + WS_CTL);
    for (int u = threadIdx.x; u < (LDS_BYTES - LDSCTL_OFF) / 4; u += NWAVES * 64) ((LAS unsigned*)(lds + LDSCTL_OFF))[u] = 0u;
    __syncthreads();
    volatile LAS unsigned* MISC = (volatile LAS unsigned*)(lds + MISC_OFF);
    XcdBarrier bar; bar.bar = (unsigned*)(ctl + CW_BAR); bar.x = 0; bar.st = nullptr;
    const int ph_lo = __builtin_amdgcn_readfirstlane(args.ph_lo), ph_hi = __builtin_amdgcn_readfirstlane(args.ph_hi);
    const bool multi = (ph_hi - ph_lo) > 1;
    if (multi) bar = xcd_barrier_post((unsigned*)(ctl + CW_BAR), MISC + 8);

#ifdef PROBE_PH
#endif
    for (int pi = ph_lo; pi < ph_hi; ++pi) {
        const int ph = args.prog[pi];
        unsigned char* const ws = opaque_ws(args);
        bf16* const XB = (bf16*)(ws + WS_XB); float* const SS0 = (float*)(ws + WS_RSTD);
        float* const SS1 = (float*)(ws + WS_SS1); float* const SS2 = (float*)(ws + WS_SS2); float* const SS3 = (float*)(ws + WS_SS3);
#ifdef PROBE_PH
        const long long tp0_ = __builtin_amdgcn_s_memrealtime();
#endif
        if (ph == 0) prep_phase(args, lds, vcu, NGW);
        else if (ph == 1) {
            pg8::Gemm g{XB, (const bf16*)(ws + WS_WIN), M_TOK, NINP, DM}; pg8::StaticOrder S; S.init(M_TOK, NINP, G, (int)blockIdx.x);
            pg8::EpiInConv E{(bf16*)(ws + WS_Z), (bf16*)(ws + WS_XBC), (float*)(ws + WS_DT), SS0, (bf16*)(ws + WS_XRAW), ARG_IN(args, 3), ARG_IN(args, 4), lds + RING_BYTES};
            pg8::gemm_phase<pg8::EpiInConv, pg8::StaticOrder, true, true>(lds, g, S, E, (float*)(ws + 768 * 1024));
        }
        else if (ph == 25) ssmconv_fixup_phase(args);
        else if (ph == 2) ssd_fast_phase(args, lds, vcu);
        else if (ph == 13) {
            pg8::Gemm g{XB, (const bf16*)(ws + WS_WKVQ), M_TOK, 3072, DM}; pg8::StaticOrder S; S.init(M_TOK, 3072, G, (int)blockIdx.x);
            pg8::EpiKVQ E{(bf16*)(ws + WS_K), (size_t)(WS_V - WS_K) / 2, SS2, ARG_IN(args, 12), ARG_IN(args, 16), QSCALE};
            static_assert(WS_Q - WS_V == WS_V - WS_K, "K, V, Q equally spaced");
            pg8::gemm_phase<pg8::EpiKVQ, pg8::StaticOrder, true, true>(lds, g, S, E, (float*)(ws + 768 * 1024));
        }
        else if (ph == 15) attn_fast_phase(args, lds, vcu);
        else {
            const int ffn_l = (ph >= 18) ? 1 : 0;
            if (ph == 6 || ph == 18) {
                pg8::Gemm g{XB, (const bf16*)(ws + (ffn_l ? WS_WUP1 : WS_WUP0)), M_TOK, FF2, DM}; pg8::StaticOrder S; S.init(M_TOK, FF2, G, (int)blockIdx.x);
                pg8::EpiConvFFN E{(bf16*)(ws + WS_H), (bf16*)(ws + WS_FRAW), ffn_l ? SS3 : SS1, ARG_IN(args, 22) + (size_t)ffn_l * 3 * FF2, ARG_IN(args, 23) + (size_t)ffn_l * FF2, lds + RING_BYTES};
                pg8::gemm_phase<pg8::EpiConvFFN, pg8::StaticOrder, true, true>(lds, g, S, E, (float*)(ws + 768 * 1024));
            } else if (ph == 7 || ph == 19) convffn_fixup_phase(args, ffn_l);
            else {
                const bf16* A; const bf16* Bt; int Kg; const float* basef = nullptr; const bf16* baseb = XB; float* outf = nullptr; bf16* xbp = XB; float* ssp;
                if (ph == 4) { A = (const bf16*)(ws + WS_Z); Bt = (const bf16*)(ws + WS_WOUT); Kg = DIN; basef = ARG_IN(args, 0); baseb = nullptr; ssp = SS1; }
                else if (ph == 16) { A = (const bf16*)(ws + WS_O); Bt = (const bf16*)(ws + WS_WAO); Kg = DM; ssp = SS3; }
                else { A = (const bf16*)(ws + WS_H); Bt = (const bf16*)(ws + (ffn_l ? WS_WDN1 : WS_WDN0)); Kg = FF; ssp = ffn_l ? nullptr : SS2; if (ffn_l) { outf = args.out; xbp = nullptr; } }
                pg8::Gemm g{A, Bt, M_TOK, DM, Kg}; pg8::StaticOrder S; S.init(M_TOK, DM, G, (int)blockIdx.x);
                pg8::EpiRes E{basef, baseb, outf, xbp, ssp, (ph == 20) ? (const float*)(ws + 768 * 1024) : nullptr, (ph == 4) ? (const float*)(ws + WS_GSS) : nullptr, (PG8_LAS float*)(lds + RING_BYTES)};
                pg8::gemm_phase<pg8::EpiRes, pg8::StaticOrder, true, true>(lds, g, S, E, (float*)(ws + 768 * 1024));
            }
        }
        if (pi + 1 < ph_hi) xcd_barrier(bar);
#ifdef PROBE_PH
        if (ph == PROBE_PH) { const long long now_ = __builtin_amdgcn_s_memrealtime(), tgt_ = now_ + PROBE_K * (now_ - tp0_) + PROBE_FIX * 100;
            while ((long long)__builtin_amdgcn_s_memrealtime() < tgt_) __builtin_amdgcn_s_sleep(20); }
#endif
    }
#ifdef PROBE_PH
    if (PROBE_PH == 99) { const long long now_ = __builtin_amdgcn_s_memrealtime(), tgt_ = now_ + (now_ - tk0_); while ((long long)__builtin_amdgcn_s_memrealtime() < tgt_) __builtin_amdgcn_s_sleep(20); }
#endif
}

extern "C" void kernel_launch(void* const* d_in, const int* in_sizes, int n_in, void* d_out, int out_size, void* d_ws, size_t ws_size, hipStream_t stream) {
    static int grid = 0;
    if (grid == 0) {
        if (n_in != 25 || in_sizes[0] != M_TOK * DM || out_size != M_TOK * DM || ws_size < WS_END) {
            fprintf(stderr, "kernel_launch: unexpected problem (n_in %d, in0 %d, out %d, ws %zu)\n", n_in, n_in > 0 ? in_sizes[0] : -1, out_size, ws_size); grid = -1; return; }
        int dev = 0, cus = 0, per_cu = 0;
        if (hipGetDevice(&dev) != hipSuccess || hipDeviceGetAttribute(&cus, hipDeviceAttributeMultiprocessorCount, dev) != hipSuccess) { grid = -1; return; }
        if (hipFuncSetAttribute((const void*)mk_fwd, hipFuncAttributeMaxDynamicSharedMemorySize, LDS_BYTES) != hipSuccess) { fprintf(stderr, "kernel_launch: hipFuncSetAttribute failed\n"); grid = -1; return; }
        if (hipOccupancyMaxActiveBlocksPerMultiprocessor(&per_cu, (const void*)mk_fwd, NWAVES * 64, LDS_BYTES) != hipSuccess || per_cu < 1)
            fprintf(stderr, "kernel_launch: occupancy query reports %d blocks per CU\n", per_cu);
        (void)hipGetLastError();
        grid = cus;
        if (grid != 256) { fprintf(stderr, "kernel_launch: built for a 256-CU device, found %d CUs\n", cus); grid = -1; return; }
    }
    if (grid < 0) return;
    if (hipMemsetAsync((char*)d_ws + WS_CTL, 0, CTL_ZERO_BYTES, stream) != hipSuccess) { fprintf(stderr, "kernel_launch: memset failed\n"); return; }
    Args a{};
    for (int i = 0; i < 25; ++i) a.in[i] = (const float*)d_in[i];
    a.out = (float*)d_out; a.ws = (unsigned char*)d_ws;
#ifndef MK_PROG
#define MK_PROG {0, 1, 2, 3, 4, 5, 6, 7, 8, 9, 10, 11, 12, 13, 14, 15, 16, 17, 18, 19, 20, 21, 22, 23}
#endif
    static const unsigned char prog_[] = MK_PROG; const int nprog = (int)sizeof(prog_);
    for (int i = 0; i < nprog && i < 64; ++i) a.prog[i] = prog_[i];
#if MK_ONE_LAUNCH
    a.ph_lo = 0; a.ph_hi = nprog;
    hipLaunchKernelGGL(mk_fwd, dim3(grid), dim3(NWAVES * 64), LDS_BYTES, stream, a);
#else
    for (int ph = 0; ph < nprog; ++ph) { a.ph_lo = ph; a.ph_hi = ph + 1; hipLaunchKernelGGL(mk_fwd, dim3(grid), dim3(NWAVES * 64), LDS_BYTES, stream, a); }
#endif
    const hipError_t le = hipPeekAtLastError();
    if (le != hipSuccess) fprintf(stderr, "kernel_launch: launch failed: %s\n", hipGetErrorName(le));
}
```

```cpp
#include <hip/hip_runtime.h>
#include <hip/hip_bf16.h>
#include <cstdio>
#include <cstdint>
#include <cmath>
__device__ __forceinline__ int opaque_tid() { int t = threadIdx.x; asm volatile("" : "+v"(t)); return t; }
__device__ __forceinline__ float shfl_xor_f(float v, int m) { int l_; asm volatile("v_mbcnt_lo_u32_b32 %0, -1, 0\n\tv_mbcnt_hi_u32_b32 %0, -1, %0" : "=v"(l_));
    return __builtin_bit_cast(float, __builtin_amdgcn_ds_bpermute((l_ ^ m) << 2, __builtin_bit_cast(int, v))); }
#ifndef ATT_REPS
#define ATT_REPS 2
#endif
#ifndef SSD_Y2XBC
#define SSD_Y2XBC 1
#endif
#ifndef SSD_SKEW_CYCLES
#define SSD_SKEW_CYCLES 25000
#endif
#define MK_ONE_LAUNCH 1

namespace pg8 {
#define PG8_LAS __attribute__((address_space(3)))
typedef unsigned short bf16_t;
typedef short bf16x8 __attribute__((ext_vector_type(8)));
typedef float f32x4 __attribute__((ext_vector_type(4)));
typedef unsigned u32x4 __attribute__((ext_vector_type(4)));
constexpr int BM = 256, BK = 64, HALF = 128, HTB = HALF * BK * 2  , STAGE_BYTES = 8 * HTB, NXCD = 8, WGM = 8;

__host__ __device__ __forceinline__ int lds_byte(int r, int c) { const int st = (r >> 4) * 2 + (c >> 5), rr = r & 15, cc = c & 31, ob = rr * 64 + cc * 2; return st * 1024 + (ob ^ (((ob >> 9) & 1) << 5)); }
__host__ __device__ __forceinline__ void stage_rc(int b, int& R, int& C) { const int st = b / 1024, sb = b % 1024, swz = sb ^ (((sb >> 9) & 1) << 5); R = (st >> 1) * 16 + swz / 64; C = (st & 1) * 32 + (swz % 64) / 2; }
__host__ __device__ __forceinline__ int perm32(int rho) { const int n = rho >> 4, i = rho & 15; return 8 * (i >> 2) + 4 * n + (i & 3); }

struct Unit { int pm, pn, ui; };
struct Gemm { const bf16_t* A; const bf16_t* Bt; int M, N, K; };

struct StaticOrder {
    int nM, nN, nwg, G, c;
    __host__ __device__ void init(int M, int N, int G_, int c_) { nM = M / BM; nN = N / BM; nwg = nM * nN; G = G_; c = c_; }
    __host__ __device__ bool next(int i, Unit& u) const {
        const long L = (long)i * G + c; if (L >= nwg) return false;
        int wgid = (int)L; { const int q = nwg / NXCD, r = nwg % NXCD, xcd = wgid % NXCD, off = wgid / NXCD; wgid = (xcd < r ? xcd * (q + 1) : r * (q + 1) + (xcd - r) * q) + off; }
        const int nig = WGM * nN, gid = wgid / nig, fm = gid * WGM, gsz = (nM - fm) < WGM ? (nM - fm) : WGM;
        u.pm = fm + ((wgid % nig) % gsz); u.pn = (wgid % nig) / gsz; return true;
    }
    __device__ __forceinline__ void a_ready(const Unit&) const {}
    __device__ __forceinline__ void done(const Unit&) const {}
};
__device__ __forceinline__ unsigned cvt_pk_bf16(float lo, float hi) { unsigned r; asm volatile("v_cvt_pk_bf16_f32 %0, %1, %2" : "=v"(r) : "v"(lo), "v"(hi)); return r; }
typedef float f32x2 __attribute__((ext_vector_type(2)));
template <class Epi, class Sched, bool ALIGN_EPI = false, bool SP2 = false>
__device__ __forceinline__ void gemm_phase(PG8_LAS unsigned char* lds, const Gemm g, const Sched& S, const Epi& E, float* probe_slot_ = nullptr) {
    const int tid = opaque_tid(), wid = __builtin_amdgcn_readfirstlane(tid >> 6), lane = tid & 63, wr = wid >> 2, wc = wid & 3, fr = lane & 15, fq = lane >> 4;
    const int K = g.K, nt = K / BK;
    unsigned voffA[2], voffB[2];
#pragma unroll
    for (int i = 0; i < 2; ++i) { int R, C; stage_rc(tid * 16 + i * 8192, R, C); const int Rb = Epi::PERM ? ((R & ~31) + perm32(R & 31)) : R;
        voffA[i] = (unsigned)(R * K + C) * 2u; voffB[i] = (unsigned)(Rb * K + C) * 2u; }
    const size_t kstep = (size_t)(BK * 2);
    const size_t hstep = (size_t)HALF * K * 2;
    const size_t tstep = 2 * hstep;
    const unsigned ldsw = (unsigned)wid * 1024u;
    const unsigned lds0_ = (unsigned)__builtin_amdgcn_readfirstlane((int)((unsigned)(uintptr_t)lds + ldsw));
    const int aoff = lds_byte(wr * 64 + fr, fq * 8), boff = lds_byte(wc * 32 + fr, fq * 8);
#define PG8_SA(b, h) (((b) * 2 + (h)) * HTB)
#define PG8_SB(b, h) ((4 + (b) * 2 + (h)) * HTB)
#define PG8_STAGE(bufoff, gbase, voff) do { _Pragma("unroll") for (int _i = 0; _i < 2; ++_i) { unsigned keep_; \
        asm volatile("s_mov_b32 m0, %2\n\ts_nop 0\n\tglobal_load_lds_dwordx4 %0, %1" \
            :: "v"((voff)[_i]), "s"((const char*)(gbase)), "s"(lds0_ + (unsigned)((bufoff) + _i * 8192)) : "memory", "m0"); (void)keep_; } } while (0)
#define PG8_LDA(dst, b, h) do { _Pragma("unroll") for (int m = 0; m < 4; ++m) _Pragma("unroll") for (int k = 0; k < 2; ++k) dst[m][k] = *(const PG8_LAS bf16x8*)(lds + PG8_SA(b, h) + aoff + m * 2048 + k * 1024); } while (0)
#define PG8_LDB(dst, b, h) do { _Pragma("unroll") for (int n = 0; n < 2; ++n) _Pragma("unroll") for (int k = 0; k < 2; ++k) dst[n][k] = *(const PG8_LAS bf16x8*)(lds + PG8_SB(b, h) + boff + n * 2048 + k * 1024); } while (0)
#define PG8_MMA(ai, bj, At, Bt) do { __builtin_amdgcn_s_setprio(1); _Pragma("unroll") for (int m = 0; m < 4; ++m) _Pragma("unroll") for (int n = 0; n < 2; ++n) _Pragma("unroll") for (int k = 0; k < 2; ++k) \
        acc[ai][bj][m][n] = __builtin_amdgcn_mfma_f32_16x16x32_bf16(Bt[n][k], At[m][k], acc[ai][bj][m][n], 0, 0, 0); __builtin_amdgcn_s_setprio(0); } while (0)
#define PG8_WAIT_V(n) asm volatile("s_waitcnt vmcnt(" #n ")" ::: "memory")
#define PG8_WAIT_L(n) asm volatile("s_waitcnt lgkmcnt(" #n ")" ::: "memory")
#define PG8_BAR __builtin_amdgcn_s_barrier()
#define PG8_SCHED __builtin_amdgcn_sched_barrier(0)
#ifdef PROBE_G
#endif
    Unit cur, nxt; int ui = 0;
    if (!S.next(0, cur)) return;
    cur.ui = 0;
    f32x4 acc[2][2][4][2];
#pragma unroll
    for (int a = 0; a < 2; ++a)
#pragma unroll
        for (int b = 0; b < 2; ++b)
#pragma unroll
            for (int m = 0; m < 4; ++m)
#pragma unroll
                for (int n = 0; n < 2; ++n) acc[a][b][m][n] = (f32x4){0.f, 0.f, 0.f, 0.f};
    bf16x8 At[4][2], B0[2][2], B1[2][2];
    const char* cA = (const char*)g.A + (size_t)cur.pm * tstep; const char* cB = (const char*)g.Bt + (size_t)cur.pn * tstep;
    S.a_ready(cur);
    if constexpr (SP2) {
        PG8_STAGE(PG8_SB(0, 0), cB, voffB); PG8_STAGE(PG8_SB(0, 1), cB + hstep, voffB); PG8_STAGE(PG8_SA(0, 0), cA, voffA); PG8_STAGE(PG8_SA(0, 1), cA + hstep, voffA);
        if (wr == 1) PG8_BAR;
        PG8_WAIT_V(2); PG8_BAR;
        PG8_STAGE(PG8_SB(1, 0), cB + kstep, voffB); PG8_STAGE(PG8_SA(1, 0), cA + kstep, voffA); PG8_STAGE(PG8_SB(1, 1), cB + hstep + kstep, voffB);
        PG8_WAIT_V(6); PG8_BAR;
    } else {
        PG8_STAGE(PG8_SB(0, 0), cB, voffB); PG8_STAGE(PG8_SA(0, 0), cA, voffA); PG8_STAGE(PG8_SB(0, 1), cB + hstep, voffB); PG8_STAGE(PG8_SA(0, 1), cA + hstep, voffA);
        if (wr == 1) PG8_BAR;
        PG8_WAIT_V(4); PG8_BAR;
        PG8_STAGE(PG8_SB(1, 0), cB + kstep, voffB); PG8_STAGE(PG8_SA(1, 0), cA + kstep, voffA); PG8_STAGE(PG8_SB(1, 1), cB + hstep + kstep, voffB);
        PG8_WAIT_V(6); PG8_BAR;
    }
    for (;;) {
        const bool has_next = S.next(ui + 1, nxt); nxt.ui = ui + 1;
        const char* nA = has_next ? (const char*)g.A + (size_t)nxt.pm * tstep : cA; const char* nB = has_next ? (const char*)g.Bt + (size_t)nxt.pn * tstep : cB;
        for (int t = 0; t < nt; t += 2) {
            if constexpr (Epi::KSCALE) { if (t == 0) E.kbegin(cur, tid); else if ((t & 7) == 0) E.krescale(acc, cur, t >> 3, wr, fr); }
            const bool last = (t == nt - 2);
            const char* a1 = cA + (size_t)(t + 1) * kstep;
            const char* a2 = last ? nA : cA + (size_t)(t + 2) * kstep; const char* b2 = last ? nB : cB + (size_t)(t + 2) * kstep;
            const char* a3 = a2 + kstep; const char* b3 = b2 + kstep;
            if (last && has_next) S.a_ready(nxt);
            if constexpr (SP2) {
            PG8_LDB(B0, 0, 0); PG8_LDB(B1, 0, 1); PG8_SCHED; PG8_LDA(At, 0, 0); PG8_STAGE(PG8_SA(1, 1), a1 + hstep, voffA);
            PG8_WAIT_V(8); PG8_WAIT_L(0); PG8_BAR; PG8_MMA(0, 0, At, B0); PG8_MMA(0, 1, At, B1); PG8_BAR; PG8_SCHED;
            PG8_LDA(At, 0, 1); PG8_STAGE(PG8_SB(0, 0), b2, voffB); PG8_STAGE(PG8_SB(0, 1), b2 + hstep, voffB); PG8_STAGE(PG8_SA(0, 0), a2, voffA);
            PG8_WAIT_V(8); PG8_WAIT_L(0); PG8_BAR; PG8_MMA(1, 0, At, B0); PG8_MMA(1, 1, At, B1); PG8_BAR; PG8_SCHED;
            PG8_LDB(B0, 1, 0); PG8_LDB(B1, 1, 1); PG8_SCHED; PG8_LDA(At, 1, 0); PG8_STAGE(PG8_SA(0, 1), a2 + hstep, voffA);
            PG8_WAIT_V(8); PG8_WAIT_L(0); PG8_BAR; PG8_MMA(0, 0, At, B0); PG8_MMA(0, 1, At, B1); PG8_BAR; PG8_SCHED;
            PG8_LDA(At, 1, 1); PG8_STAGE(PG8_SB(1, 0), b3, voffB); PG8_STAGE(PG8_SB(1, 1), b3 + hstep, voffB); PG8_STAGE(PG8_SA(1, 0), a3, voffA);
            PG8_WAIT_V(8); PG8_WAIT_L(0); PG8_BAR; PG8_MMA(1, 0, At, B0); PG8_MMA(1, 1, At, B1); PG8_BAR; PG8_SCHED;
            } else {
            PG8_LDB(B0, 0, 0); PG8_SCHED; PG8_LDA(At, 0, 0); PG8_STAGE(PG8_SA(1, 1), a1 + hstep, voffA);
            PG8_WAIT_L(8); PG8_BAR; PG8_WAIT_L(0); PG8_MMA(0, 0, At, B0); PG8_BAR; PG8_SCHED;
            PG8_LDB(B1, 0, 1); PG8_STAGE(PG8_SB(0, 0), b2, voffB);
            PG8_BAR; PG8_WAIT_L(0); PG8_MMA(0, 1, At, B1); PG8_BAR;
            PG8_LDA(At, 0, 1); PG8_STAGE(PG8_SA(0, 0), a2, voffA);
            PG8_BAR; PG8_WAIT_L(0); PG8_MMA(1, 0, At, B0); PG8_BAR; PG8_SCHED;
            PG8_STAGE(PG8_SB(0, 1), b2 + hstep, voffB);
            PG8_WAIT_V(6); PG8_BAR; PG8_MMA(1, 1, At, B1); PG8_BAR;
            PG8_LDB(B0, 1, 0); PG8_SCHED; PG8_LDA(At, 1, 0); PG8_STAGE(PG8_SA(0, 1), a2 + hstep, voffA);
            PG8_WAIT_L(8); PG8_BAR; PG8_WAIT_L(0); PG8_MMA(0, 0, At, B0); PG8_BAR; PG8_SCHED;
            PG8_LDB(B1, 1, 1); PG8_STAGE(PG8_SB(1, 0), b3, voffB);
            PG8_BAR; PG8_WAIT_L(0); PG8_MMA(0, 1, At, B1); PG8_BAR;
            PG8_LDA(At, 1, 1); PG8_STAGE(PG8_SA(1, 0), a3, voffA);
            PG8_BAR; PG8_WAIT_L(0); PG8_MMA(1, 0, At, B0); PG8_BAR; PG8_SCHED;
            PG8_STAGE(PG8_SB(1, 1), b3 + hstep, voffB);
            PG8_WAIT_V(6); PG8_BAR; PG8_MMA(1, 1, At, B1); PG8_BAR;
            }
        }
        if constexpr (ALIGN_EPI) { if (wr == 0) PG8_BAR; }
#ifdef PROBE_G
        const long long te0_ = __builtin_amdgcn_s_memrealtime();
#endif
        if constexpr (!Epi::AFTER_DRAIN) { E(acc, cur, wr, wc, fr, fq); S.done(cur); }
#ifdef PROBE_G
        if (Epi::PROBE_ID == PROBE_G) { const long long now_ = __builtin_amdgcn_s_memrealtime(), tgt_ = now_ + PROBE_GK * (now_ - te0_);
            while ((long long)__builtin_amdgcn_s_memrealtime() < tgt_) __builtin_amdgcn_s_sleep(4); }
#endif
        if (!has_next) break;
#pragma unroll
        for (int a = 0; a < 2; ++a)
#pragma unroll
            for (int b = 0; b < 2; ++b)
#pragma unroll
                for (int m = 0; m < 4; ++m)
#pragma unroll
                    for (int n = 0; n < 2; ++n) acc[a][b][m][n] = (f32x4){0.f, 0.f, 0.f, 0.f};
        cur = nxt; cA = nA; cB = nB; ++ui;
        if constexpr (ALIGN_EPI) { if (wr == 1) PG8_BAR; }
    }
    PG8_WAIT_V(0);
    if constexpr (!ALIGN_EPI) { if (wr == 0) PG8_BAR; }
    PG8_BAR;
    if constexpr (Epi::AFTER_DRAIN) { E.fused(acc, cur, wr, wc, fr, fq, lds, wid, lane); S.done(cur); }
#ifdef PROBE_G
#endif
#undef PG8_SA
#undef PG8_SB
#undef PG8_STAGE
#undef PG8_LDA
#undef PG8_LDB
#undef PG8_MMA
#undef PG8_WAIT_V
#undef PG8_WAIT_L
#undef PG8_BAR
#undef PG8_SCHED
}
}

namespace pg8 {
typedef unsigned u32x2 __attribute__((ext_vector_type(2)));
__device__ __forceinline__ u32x4 pack8(const f32x4& v0, const f32x4& v1) {
    u32x4 w; w.x = cvt_pk_bf16(v0[0], v0[1]); w.y = cvt_pk_bf16(v0[2], v0[3]); w.z = cvt_pk_bf16(v1[0], v1[1]); w.w = cvt_pk_bf16(v1[2], v1[3]); return w;
}
struct EpiIn {
    static constexpr int PROBE_ID = 1;
    static constexpr bool PERM = true, AFTER_DRAIN = false, KSCALE = false;
    bf16_t* Z; bf16_t* XBC; float* DT; const float* rstd;
    __device__ __forceinline__ void operator()(const f32x4 (&acc)[2][2][4][2], const Unit& u, int wr, int wc, int fr, int fq) const {
        const int row0 = u.pm * BM + wr * 64 + fr, c8 = wc * 32 + 8 * fq;
        float rsv[2][4];
#pragma unroll
        for (int ai = 0; ai < 2; ++ai)
#pragma unroll
            for (int m = 0; m < 4; ++m) rsv[ai][m] = rstd[row0 + ai * HALF + m * 16];
        asm volatile("" : "+v"(rsv[0][0]), "+v"(rsv[0][1]), "+v"(rsv[0][2]), "+v"(rsv[0][3]), "+v"(rsv[1][0]), "+v"(rsv[1][1]), "+v"(rsv[1][2]), "+v"(rsv[1][3]));
#pragma unroll
        for (int ai = 0; ai < 2; ++ai)
#pragma unroll
            for (int m = 0; m < 4; ++m) {
                const int row = row0 + ai * HALF + m * 16; const float rs = 1.f / sqrtf(rsv[ai][m] * (1.f / 1024.f) + 1e-6f);
#pragma unroll
                for (int bj = 0; bj < 2; ++bj) {
                    const f32x4 v0 = acc[ai][bj][m][0] * rs, v1 = acc[ai][bj][m][1] * rs;
                    if (u.pn < 8) *(u32x4*)(Z + (size_t)row * 2048 + u.pn * 256 + bj * HALF + c8) = pack8(v0, v1);
                    else if (u.pn < 20) *(u32x4*)(XBC + (size_t)row * 3072 + (u.pn - 8) * 256 + bj * HALF + c8) = pack8(v0, v1);
                    else if (bj == 0 && wc == 0) { float* d = DT + (size_t)row * 32 + 8 * fq; *(f32x4*)d = v0; *(f32x4*)(d + 4) = v1; }
                }
            }
    }
};
struct EpiRes {
    static constexpr int PROBE_ID = 2;
    static constexpr bool PERM = true, AFTER_DRAIN = false, KSCALE = true;
    const bf16_t* baseb; float* outf; bf16_t* xb; float* ss; const float* probe; const float* gss; PG8_LAS float* gtab;
    __device__ __forceinline__ void kbegin(const Unit& u, int tid) const {
        if (!gss) return;
        tid = opaque_tid();
        const int row = tid & 255, gh = tid >> 8;
        const f32x4* gp = (const f32x4*)(gss + (size_t)(u.pm * BM + row) * 16 + gh * 8);
        const f32x4 p0 = gp[0], p1 = gp[1];
        const float v0 = ((p0[0] + p0[1]) + (p0[2] + p0[3])) * (1.f / 512.f) + 1e-6f, v1 = ((p1[0] + p1[1]) + (p1[2] + p1[3])) * (1.f / 512.f) + 1e-6f;
        PG8_LAS float* tp = gtab + (((u.ui & 1) * 4 + 2 * gh) * 256 + row) * 2;
        tp[0] = __builtin_amdgcn_sqrtf(v0); tp[1] = __builtin_amdgcn_rsqf(v0); tp[512] = __builtin_amdgcn_sqrtf(v1); tp[513] = __builtin_amdgcn_rsqf(v1);
    }
    __device__ __forceinline__ void krescale(f32x4 (&acc)[2][2][4][2], const Unit& u, int g, int wr, int fr) const {
        if (!gss) return;
        const PG8_LAS float* tp = gtab + (((u.ui & 1) * 4 + g) * 256 + wr * 64 + fr) * 2;
#pragma unroll
        for (int ai = 0; ai < 2; ++ai)
#pragma unroll
            for (int m = 0; m < 4; ++m) { const float ratio = tp[(ai * HALF + m * 16) * 2] * tp[(ai * HALF + m * 16) * 2 - 511];
#pragma unroll
                for (int bj = 0; bj < 2; ++bj)
#pragma unroll
                    for (int n = 0; n < 2; ++n) acc[ai][bj][m][n] *= ratio; }
    }
    __device__ __forceinline__ void operator()(const f32x4 (&acc)[2][2][4][2], const Unit& u, int wr, int wc, int fr, int fq) const {
        const int row0 = u.pm * BM + wr * 64 + fr, col0 = u.pn * BM + wc * 32 + 8 * fq;
        u32x4 raw[8][2];
#pragma unroll
        for (int gi = 0; gi < 8; ++gi)
#pragma unroll
            for (int bj = 0; bj < 2; ++bj) raw[gi][bj] = *(const u32x4*)(baseb + (size_t)(row0 + (gi >> 2) * HALF + (gi & 3) * 16) * 1024 + col0 + bj * HALF);
#pragma unroll
        for (int gi = 0; gi < 8; ++gi) {
            const int ai = gi >> 2, m = gi & 3;
            const size_t off = (size_t)(row0 + ai * HALF + m * 16) * 1024 + col0;
            float s = 0.f;
            const float r3 = gss ? gtab[(((u.ui & 1) * 4 + 3) * 256 + wr * 64 + fr + ai * HALF + m * 16) * 2 + 1] : 1.f;
#pragma unroll
            for (int bj = 0; bj < 2; ++bj) {
                const u32x4 w_ = raw[gi][bj];
                const f32x4 lo = {__builtin_bit_cast(float, w_.x << 16), __builtin_bit_cast(float, w_.x & 0xffff0000u), __builtin_bit_cast(float, w_.y << 16), __builtin_bit_cast(float, w_.y & 0xffff0000u)};
                const f32x4 hi = {__builtin_bit_cast(float, w_.z << 16), __builtin_bit_cast(float, w_.z & 0xffff0000u), __builtin_bit_cast(float, w_.w << 16), __builtin_bit_cast(float, w_.w & 0xffff0000u)};
                f32x4 o0 = lo + acc[ai][bj][m][0] * r3, o1 = hi + acc[ai][bj][m][1] * r3;
#ifdef PROBE_T
                if (probe && gi == 0 && bj == 0 && row0 == 0 && col0 == 0) o0[0] += 0.08f + 0.2f * probe[0];
#endif
                if (outf) { *(f32x4*)(outf + off + bj * HALF) = o0; *(f32x4*)(outf + off + bj * HALF + 4) = o1; }
                if (xb) { u32x4 w; w.x = cvt_pk_bf16(o0[0], o0[1]); w.y = cvt_pk_bf16(o0[2], o0[3]); w.z = cvt_pk_bf16(o1[0], o1[1]); w.w = cvt_pk_bf16(o1[2], o1[3]); *(u32x4*)(xb + off + bj * HALF) = w; }
                s += ((o0[0] * o0[0] + o0[1] * o0[1]) + (o0[2] * o0[2] + o0[3] * o0[3])) + ((o1[0] * o1[0] + o1[1] * o1[1]) + (o1[2] * o1[2] + o1[3] * o1[3])); }
            if (ss) { s += shfl_xor_f(s, 16); s += shfl_xor_f(s, 32); if (fq == 0) atomicAdd(ss + row0 + ai * HALF + m * 16, s);
#ifdef PROBE_ATOM
                if (fq == 0) atomicAdd((float*)((char*)ss + (480u << 20)) + row0 + ai * HALF + m * 16, s);
#endif
            }
        }
    }
};
struct EpiScale {
    static constexpr int PROBE_ID = 3;
    static constexpr bool PERM = true, AFTER_DRAIN = false, KSCALE = false;
    bf16_t* O; int ldc; const float* rstd;
    __device__ __forceinline__ void operator()(const f32x4 (&acc)[2][2][4][2], const Unit& u, int wr, int wc, int fr, int fq) const {
        const int row0 = u.pm * BM + wr * 64 + fr, c8 = u.pn * BM + wc * 32 + 8 * fq;
#pragma unroll
        for (int ai = 0; ai < 2; ++ai)
#pragma unroll
            for (int m = 0; m < 4; ++m) {
                const int row = row0 + ai * HALF + m * 16; const float rs = 1.f / sqrtf(rstd[row] * (1.f / 1024.f) + 1e-6f);
#pragma unroll
                for (int bj = 0; bj < 2; ++bj) *(u32x4*)(O + (size_t)row * ldc + bj * HALF + c8) = pack8(acc[ai][bj][m][0] * rs, acc[ai][bj][m][1] * rs);
            }
    }
};
struct EpiKVQ {
    static constexpr int PROBE_ID = 4;
    static constexpr bool PERM = true, AFTER_DRAIN = false, KSCALE = false;
    bf16_t* Kb; size_t tstride; const float* rstd; const float* kg; const float* qg; float qscale;
    __device__ __forceinline__ void operator()(const f32x4 (&acc)[2][2][4][2], const Unit& u, int wr, int wc, int fr, int fq) const {
        const int row0 = u.pm * BM + wr * 64 + fr, t = u.pn >> 2;
        bf16_t* base = Kb + (size_t)t * tstride + (u.pn & 3) * BM + 64 * wc + 8 * fq;
        f32x4 g[2][2];
        const float* gp = (t == 2) ? qg : kg; const float sc = (t == 2) ? qscale : 1.f;
#pragma unroll
        for (int bj = 0; bj < 2; ++bj)
#pragma unroll
            for (int n = 0; n < 2; ++n) g[bj][n] = (t == 1) ? (f32x4){1.f, 1.f, 1.f, 1.f} : *(const f32x4*)(gp + 32 * bj + 8 * fq + 4 * n) * sc;
        float rsv[2][4];
#pragma unroll
        for (int ai = 0; ai < 2; ++ai)
#pragma unroll
            for (int m = 0; m < 4; ++m) rsv[ai][m] = rstd[row0 + ai * HALF + m * 16];
        asm volatile("" : "+v"(rsv[0][0]), "+v"(rsv[0][1]), "+v"(rsv[0][2]), "+v"(rsv[0][3]), "+v"(rsv[1][0]), "+v"(rsv[1][1]), "+v"(rsv[1][2]), "+v"(rsv[1][3]));
#pragma unroll
        for (int ai = 0; ai < 2; ++ai)
#pragma unroll
            for (int m = 0; m < 4; ++m) {
                const int row = row0 + ai * HALF + m * 16; const float rs = 1.f / sqrtf(rsv[ai][m] * (1.f / 1024.f) + 1e-6f);
                f32x4 v[2][2]; float s = 0.f;
#pragma unroll
                for (int bj = 0; bj < 2; ++bj)
#pragma unroll
                    for (int n = 0; n < 2; ++n) { v[bj][n] = acc[ai][bj][m][n] * rs; s += (v[bj][n][0] * v[bj][n][0] + v[bj][n][1] * v[bj][n][1]) + (v[bj][n][2] * v[bj][n][2] + v[bj][n][3] * v[bj][n][3]); }
                s += shfl_xor_f(s, 16); s += shfl_xor_f(s, 32);
                const float rq = (t == 1) ? 1.f : 1.f / sqrtf(s * (1.f / 64.f) + 1e-6f);
#pragma unroll
                for (int bj = 0; bj < 2; ++bj) *(u32x4*)(base + (size_t)row * 1024 + 32 * bj) = pack8(v[bj][0] * rq * g[bj][0], v[bj][1] * rq * g[bj][1]);
            }
    }
};

struct EpiConvFFN {
    static constexpr int PROBE_ID = 5;
    static constexpr bool PERM = true, AFTER_DRAIN = false, KSCALE = false;
    bf16_t* H; bf16_t* raw; const float* ss; const float* cw; const float* cb; PG8_LAS unsigned char* xl;
    static constexpr int RP = 144, SLAB = 18 * RP, HALO_OFF = 8 * SLAB;
    __device__ __forceinline__ void operator()(const f32x4 (&acc)[2][2][4][2], const Unit& u, int wr, int wc, int fr, int fq) const {
        const int lane = opaque_tid() & 63  , c = lane & 31, hf = lane >> 5, c2 = lane & 15, hq = lane >> 4, wid = wr * 4 + wc;
        PG8_LAS unsigned char* slab = xl + wid * SLAB;
        PG8_LAS unsigned char* halo = xl + HALO_OFF;
        const int chg = 128 * u.pn + 32 * wc + 2 * c2;
        typedef float f32x2v __attribute__((ext_vector_type(2)));
        const f32x2v wg0 = *(const f32x2v*)(cw + chg), wg1 = *(const f32x2v*)(cw + 5632 + chg), wg2 = *(const f32x2v*)(cw + 2 * 5632 + chg), bg = *(const f32x2v*)(cb + chg);
        const f32x2v wu0 = *(const f32x2v*)(cw + 2816 + chg), wu1 = *(const f32x2v*)(cw + 5632 + 2816 + chg), wu2 = *(const f32x2v*)(cw + 2 * 5632 + 2816 + chg), bu = *(const f32x2v*)(cb + 2816 + chg);
        const int row0 = u.pm * BM + wr * 64 + fr;
        float rsv[2][4];
#pragma unroll
        for (int ai = 0; ai < 2; ++ai)
#pragma unroll
            for (int m = 0; m < 4; ++m) rsv[ai][m] = ss[row0 + ai * HALF + m * 16];
#pragma unroll
        for (int ai = 0; ai < 2; ++ai)
#pragma unroll
            for (int m = 0; m < 4; ++m) rsv[ai][m] = 1.f / sqrtf(rsv[ai][m] * (1.f / 1024.f) + 1e-6f);
        bf16_t* rawp = raw + ((size_t)u.pm * 4 * 22 + u.pn) * 256 + wc * 64 + 8 * fq;
#pragma unroll
        for (int ai = 0; ai < 2; ++ai) {
            if (fr >= 14) {
                const float rs = rsv[ai][3];
                const int bi = 2 * ai + wr;
#pragma unroll
                for (int bj = 0; bj < 2; ++bj) { u32x4 w; { const f32x4 v0 = acc[ai][bj][3][0] * rs, v1 = acc[ai][bj][3][1] * rs; w.x = cvt_pk_bf16(v0[0], v0[1]); w.y = cvt_pk_bf16(v0[2], v0[3]); w.z = cvt_pk_bf16(v1[0], v1[1]); w.w = cvt_pk_bf16(v1[2], v1[3]); }
                        if (bi < 3) *(PG8_LAS u32x4*)(halo + ((bi * 2 + (fr - 14)) * 256 + wc * 64 + bj * 32 + 8 * fq) * 2) = w;
                        else *(u32x4*)(rawp + (size_t)(2 + fr - 14) * 22 * 256 + bj * 32) = w; }
            }
        }
        if (wr == 0 && fr < 2) {
            const float rs = rsv[0][0];
#pragma unroll
            for (int bj = 0; bj < 2; ++bj) { u32x4 w; { const f32x4 v0 = acc[0][bj][0][0] * rs, v1 = acc[0][bj][0][1] * rs; w.x = cvt_pk_bf16(v0[0], v0[1]); w.y = cvt_pk_bf16(v0[2], v0[3]); w.z = cvt_pk_bf16(v1[0], v1[1]); w.w = cvt_pk_bf16(v1[2], v1[3]); }
                    *(u32x4*)(rawp + (size_t)fr * 22 * 256 + bj * 32) = w; }
        }
        asm volatile("s_waitcnt lgkmcnt(0)" ::: "memory"); __builtin_amdgcn_s_barrier(); asm volatile("" ::: "memory");
#pragma unroll
        for (int ai = 0; ai < 2; ++ai) {
            const int bi = 2 * ai + wr;
            { unsigned hv = 0u; if (bi > 0) hv = *(const PG8_LAS unsigned*)(halo + (((bi - 1) * 2 + hf) * 256 + wc * 64 + 2 * c) * 2);
              *(PG8_LAS unsigned*)(slab + hf * RP + 4 * c) = hv; }
#pragma unroll
            for (int m = 0; m < 4; ++m) {
                const float rs = rsv[ai][m];
#pragma unroll
                for (int bj = 0; bj < 2; ++bj) { u32x4 w; { const f32x4 v0 = acc[ai][bj][m][0] * rs, v1 = acc[ai][bj][m][1] * rs; w.x = cvt_pk_bf16(v0[0], v0[1]); w.y = cvt_pk_bf16(v0[2], v0[3]); w.z = cvt_pk_bf16(v1[0], v1[1]); w.w = cvt_pk_bf16(v1[2], v1[3]); }
                        *(PG8_LAS u32x4*)(slab + (2 + fr) * RP + (bj * 32 + 8 * fq) * 2) = w; }
                asm volatile("" ::: "memory");
                unsigned gw[6], uw[6];
#pragma unroll
                for (int i = 0; i < 6; ++i) { const PG8_LAS unsigned char* rp = slab + (4 * hq + i) * RP + 4 * c2; gw[i] = *(const PG8_LAS unsigned*)rp; uw[i] = *(const PG8_LAS unsigned*)(rp + 64); }
                asm volatile("" ::: "memory");
                if (hq == 3) {
#pragma unroll
                    for (int i = 0; i < 2; ++i) { *(PG8_LAS unsigned*)(slab + i * RP + 4 * c2) = gw[4 + i]; *(PG8_LAS unsigned*)(slab + i * RP + 64 + 4 * c2) = uw[4 + i]; }
                }
                float nl2_ = -1.4426950408889634f; asm volatile("" : "+v"(nl2_)); const f32x2v NL2 = {nl2_, nl2_};
#define CF_PAIR(w_) ((f32x2v){__builtin_bit_cast(float, (w_) << 16), __builtin_bit_cast(float, (w_) & 0xffff0000u)})
                f32x2v xg[6], xu[6];
#pragma unroll
                for (int i = 0; i < 6; ++i) { xg[i] = CF_PAIR(gw[i]); xu[i] = CF_PAIR(uw[i]); }
#pragma unroll
                for (int i = 0; i < 4; ++i) {
                    const f32x2v cg = bg + wg0 * xg[i] + wg1 * xg[i + 1] + wg2 * xg[i + 2];
                    const f32x2v cu = bu + wu0 * xu[i] + wu1 * xu[i + 1] + wu2 * xu[i + 2];
                    const f32x2v ea = cg * NL2;
                    const f32x2v den = (f32x2v){__builtin_amdgcn_exp2f(ea.x), __builtin_amdgcn_exp2f(ea.y)} + (f32x2v){1.f, 1.f};
                    const f32x2v hv = cg * (f32x2v){__builtin_amdgcn_rcpf(den.x), __builtin_amdgcn_rcpf(den.y)} * cu;
                    *(PG8_LAS unsigned*)(slab + (2 + 4 * hq + i) * RP + 4 * c2) = cvt_pk_bf16(hv.x, hv.y);
                }
#undef CF_PAIR
                asm volatile("" ::: "memory");
                { const int row = lane >> 2, c8 = (lane & 3) * 8;
                  const u32x4 w = *(const PG8_LAS u32x4*)(slab + (2 + row) * RP + c8 * 2);
                  *(u32x4*)(H + (size_t)(u.pm * BM + 64 * bi + 16 * m + row) * 2816 + 128 * u.pn + 32 * wc + c8) = w; }
                asm volatile("" ::: "memory");
            }
        }
    }
};

struct EpiInConv {
    static constexpr int PROBE_ID = 1;
    static constexpr bool PERM = true, AFTER_DRAIN = false, KSCALE = false;
    bf16_t* Z; bf16_t* XBC; float* DT; const float* ss; bf16_t* raw; const float* cw; const float* cb; PG8_LAS unsigned char* xl;
    static constexpr int RP = 144, SLAB = 19 * RP, HALO_OFF = 8 * SLAB;
    __device__ __forceinline__ void operator()(const f32x4 (&acc)[2][2][4][2], const Unit& u, int wr, int wc, int fr, int fq) const {
        const int row0 = u.pm * BM + wr * 64 + fr;
        float rsv[2][4];
#pragma unroll
        for (int ai = 0; ai < 2; ++ai)
#pragma unroll
            for (int m = 0; m < 4; ++m) rsv[ai][m] = ss[row0 + ai * HALF + m * 16];
        asm volatile("" : "+v"(rsv[0][0]), "+v"(rsv[0][1]), "+v"(rsv[0][2]), "+v"(rsv[0][3]), "+v"(rsv[1][0]), "+v"(rsv[1][1]), "+v"(rsv[1][2]), "+v"(rsv[1][3]));
#pragma unroll
        for (int ai = 0; ai < 2; ++ai)
#pragma unroll
            for (int m = 0; m < 4; ++m) rsv[ai][m] = 1.f / sqrtf(rsv[ai][m] * (1.f / 1024.f) + 1e-6f);
        if (u.pn < 8) {
#pragma unroll
            for (int ai = 0; ai < 2; ++ai)
#pragma unroll
                for (int m = 0; m < 4; ++m) { bf16_t* zp = Z + (size_t)(row0 + ai * HALF + m * 16) * 2048 + u.pn * 256 + wc * 32 + 8 * fq; const float rs = rsv[ai][m];
#pragma unroll
                    for (int bj = 0; bj < 2; ++bj) { u32x4 w; { const f32x4 v0 = acc[ai][bj][m][0] * rs, v1 = acc[ai][bj][m][1] * rs; w.x = cvt_pk_bf16(v0[0], v0[1]); w.y = cvt_pk_bf16(v0[2], v0[3]); w.z = cvt_pk_bf16(v1[0], v1[1]); w.w = cvt_pk_bf16(v1[2], v1[3]); } *(u32x4*)(zp + bj * HALF) = w; } }
            return;
        }
        if (u.pn == 20) {
            if (wc == 0) {
#pragma unroll
                for (int ai = 0; ai < 2; ++ai)
#pragma unroll
                    for (int m = 0; m < 4; ++m)
#pragma unroll
                        for (int n = 0; n < 2; ++n) *(f32x4*)(DT + (size_t)(row0 + ai * HALF + m * 16) * 32 + 8 * fq + 4 * n) = acc[ai][0][m][n] * rsv[ai][m];
            }
            return;
        }
        const int up = u.pn - 8, lane = opaque_tid() & 63  , c = lane & 31, c2 = lane & 15, hq = lane >> 4, wid = wr * 4 + wc;
        PG8_LAS unsigned char* slab = xl + wid * SLAB;
        PG8_LAS unsigned char* halo = xl + HALO_OFF;
        typedef float f32x2v __attribute__((ext_vector_type(2)));
        const int colA = up * 256 + 32 * wc + 2 * c2, colB = colA + 128;
        f32x2v wA[4], wB[4];
#pragma unroll
        for (int k = 0; k < 4; ++k) { wA[k] = *(const f32x2v*)(cw + k * 3072 + colA); wB[k] = *(const f32x2v*)(cw + k * 3072 + colB); }
        const f32x2v bA = *(const f32x2v*)(cb + colA), bB = *(const f32x2v*)(cb + colB);
        bf16_t* rawp = raw + ((size_t)u.pm * 6 * 12 + up) * 256 + wc * 64 + 8 * fq;
#pragma unroll
        for (int ai = 0; ai < 2; ++ai) {
            if (fr >= 13) {
                const float rs = rsv[ai][3]; const int bi = 2 * ai + wr;
#pragma unroll
                for (int bj = 0; bj < 2; ++bj) { u32x4 w; { const f32x4 v0 = acc[ai][bj][3][0] * rs, v1 = acc[ai][bj][3][1] * rs; w.x = cvt_pk_bf16(v0[0], v0[1]); w.y = cvt_pk_bf16(v0[2], v0[3]); w.z = cvt_pk_bf16(v1[0], v1[1]); w.w = cvt_pk_bf16(v1[2], v1[3]); }
                        if (bi < 3) *(PG8_LAS u32x4*)(halo + ((bi * 3 + (fr - 13)) * 256 + wc * 64 + bj * 32 + 8 * fq) * 2) = w;
                        else *(u32x4*)(rawp + (size_t)(3 + fr - 13) * 12 * 256 + bj * 32) = w; }
            }
        }
        if (wr == 0 && fr < 3) {
            const float rs = rsv[0][0];
#pragma unroll
            for (int bj = 0; bj < 2; ++bj) { u32x4 w; { const f32x4 v0 = acc[0][bj][0][0] * rs, v1 = acc[0][bj][0][1] * rs; w.x = cvt_pk_bf16(v0[0], v0[1]); w.y = cvt_pk_bf16(v0[2], v0[3]); w.z = cvt_pk_bf16(v1[0], v1[1]); w.w = cvt_pk_bf16(v1[2], v1[3]); }
                    *(u32x4*)(rawp + (size_t)fr * 12 * 256 + bj * 32) = w; }
        }
        asm volatile("s_waitcnt lgkmcnt(0)" ::: "memory"); __builtin_amdgcn_s_barrier(); asm volatile("" ::: "memory");
#define CF_LO(w_) __builtin_bit_cast(float, (w_) << 16)
#define CF_HI(w_) __builtin_bit_cast(float, (w_) & 0xffff0000u)
#pragma unroll
        for (int ai = 0; ai < 2; ++ai) {
            const int bi = 2 * ai + wr;
            { unsigned h0 = 0u, h1 = 0u;
              if (bi > 0) { h0 = *(const PG8_LAS unsigned*)(halo + (((bi - 1) * 3 + (lane >> 5)) * 256 + wc * 64 + 2 * c) * 2); if (lane < 32) h1 = *(const PG8_LAS unsigned*)(halo + (((bi - 1) * 3 + 2) * 256 + wc * 64 + 2 * c) * 2); }
              *(PG8_LAS unsigned*)(slab + (lane >> 5) * RP + 4 * c) = h0; if (lane < 32) *(PG8_LAS unsigned*)(slab + 2 * RP + 4 * c) = h1; }
#pragma unroll
            for (int m = 0; m < 4; ++m) {
                const float rs = rsv[ai][m];
#pragma unroll
                for (int bj = 0; bj < 2; ++bj) { u32x4 w; { const f32x4 v0 = acc[ai][bj][m][0] * rs, v1 = acc[ai][bj][m][1] * rs; w.x = cvt_pk_bf16(v0[0], v0[1]); w.y = cvt_pk_bf16(v0[2], v0[3]); w.z = cvt_pk_bf16(v1[0], v1[1]); w.w = cvt_pk_bf16(v1[2], v1[3]); }
                        *(PG8_LAS u32x4*)(slab + (3 + fr) * RP + (bj * 32 + 8 * fq) * 2) = w; }
                asm volatile("" ::: "memory");
                unsigned aw[7], bw[7];
#pragma unroll
                for (int i = 0; i < 7; ++i) { const PG8_LAS unsigned char* rp = slab + (4 * hq + i) * RP + 4 * c2; aw[i] = *(const PG8_LAS unsigned*)rp; bw[i] = *(const PG8_LAS unsigned*)(rp + 64); }
                asm volatile("" ::: "memory");
                if (hq == 3) {
#pragma unroll
                    for (int i = 0; i < 3; ++i) { *(PG8_LAS unsigned*)(slab + i * RP + 4 * c2) = aw[4 + i]; *(PG8_LAS unsigned*)(slab + i * RP + 64 + 4 * c2) = bw[4 + i]; }
                }
                float nl2_ = -1.4426950408889634f; asm volatile("" : "+v"(nl2_)); const f32x2v NL2 = {nl2_, nl2_};
#define CF_PAIR(w_) ((f32x2v){__builtin_bit_cast(float, (w_) << 16), __builtin_bit_cast(float, (w_) & 0xffff0000u)})
                f32x2v xa[7], xb2[7];
#pragma unroll
                for (int i = 0; i < 7; ++i) { xa[i] = CF_PAIR(aw[i]); xb2[i] = CF_PAIR(bw[i]); }
#pragma unroll
                for (int i = 0; i < 4; ++i) {
                    const f32x2v av = bA + wA[0] * xa[i] + wA[1] * xa[i + 1] + wA[2] * xa[i + 2] + wA[3] * xa[i + 3];
                    const f32x2v bv = bB + wB[0] * xb2[i] + wB[1] * xb2[i + 1] + wB[2] * xb2[i + 2] + wB[3] * xb2[i + 3];
                    const f32x2v ea = av * NL2, eb = bv * NL2;
                    const f32x2v da = (f32x2v){__builtin_amdgcn_exp2f(ea.x), __builtin_amdgcn_exp2f(ea.y)} + (f32x2v){1.f, 1.f}, db = (f32x2v){__builtin_amdgcn_exp2f(eb.x), __builtin_amdgcn_exp2f(eb.y)} + (f32x2v){1.f, 1.f};
                    const f32x2v sa = av * (f32x2v){__builtin_amdgcn_rcpf(da.x), __builtin_amdgcn_rcpf(da.y)}, sb = bv * (f32x2v){__builtin_amdgcn_rcpf(db.x), __builtin_amdgcn_rcpf(db.y)};
                    *(PG8_LAS unsigned*)(slab + (3 + 4 * hq + i) * RP + 4 * c2) = cvt_pk_bf16(sa.x, sa.y);
                    *(PG8_LAS unsigned*)(slab + (3 + 4 * hq + i) * RP + 64 + 4 * c2) = cvt_pk_bf16(sb.x, sb.y);
                }
#undef CF_PAIR
                asm volatile("" ::: "memory");
                { const int row = lane >> 2, q = lane & 3;
                  const u32x4 w0 = *(const PG8_LAS u32x4*)(slab + (3 + row) * RP + 32 * q), w1 = *(const PG8_LAS u32x4*)(slab + (3 + row) * RP + 32 * q + 16);
                  bf16_t* op = XBC + (size_t)(u.pm * BM + 64 * bi + 16 * m + row) * 3072 + up * 256 + (q >> 1) * 128 + 32 * wc + 16 * (q & 1);
                  *(u32x4*)op = w0; *(u32x4*)(op + 8) = w1; }
                asm volatile("" ::: "memory");
            }
        }
#undef CF_LO
#undef CF_HI
    }
};
}

constexpr int NWAVES = 8;
constexpr int NBATCH = 16, SEQ = 2048, M_TOK = NBATCH * SEQ, DM = 1024;
constexpr int DIN = 2048, NXBC = 3072, NIN = 5152, NINP = 5376, SSM_H = 32;
constexpr int FF = 2816, FF2 = 5632, MH = M_TOK / 2;
constexpr float EPS = 1e-6f, LOG2E = 1.4426950408889634f;
constexpr float LAM_INIT = 0.35550906759096926f;
constexpr float QSCALE = 0.125f * 1.4426950408889634f;

constexpr size_t MiB = 1u << 20;
constexpr size_t WS_CTL = 0, CTL_ZERO_BYTES = 1 * MiB;
constexpr size_t WS_WIN = 1 * MiB, WS_WOUT = 12 * MiB, WS_WUP0 = 16 * MiB, WS_WUP1 = 27 * MiB, WS_WDN0 = 38 * MiB, WS_WDN1 = 44 * MiB,
                 WS_WKVQ = 50 * MiB, WS_WAO = 56 * MiB, WS_RSTD = 58 * MiB, WS_DT = 59 * MiB;
constexpr size_t WS_XB = 64 * MiB;
constexpr size_t WS_R = 128 * MiB;
constexpr size_t WS_Z = WS_R, WS_XBC = WS_R + 128 * MiB, WS_XRAW = WS_R + 320 * MiB;
constexpr size_t WS_U = WS_R, WS_H = WS_R, WS_FRAW = WS_R + 176 * MiB;
constexpr size_t WS_K = WS_R, WS_V = WS_R + 64 * MiB, WS_Q = WS_R + 128 * MiB, WS_O = WS_R + 192 * MiB;
constexpr size_t WS_GSS = WS_R + 340 * MiB;
constexpr size_t WS_END = 512 * MiB;
constexpr int CW_BAR = 4096;
constexpr size_t WS_SS1 = 256 * 1024, WS_SS2 = 384 * 1024, WS_SS3 = 512 * 1024;

constexpr int RING_BYTES = 131072;
constexpr int LDS_BYTES = 163840;
constexpr int LDSCTL_OFF = LDS_BYTES - 1024, MISC_OFF = LDSCTL_OFF + 320;

#define GAS __attribute__((address_space(1)))
#define LAS __attribute__((address_space(3)))
typedef unsigned short bf16;
typedef unsigned v4u __attribute__((ext_vector_type(4)));
typedef float f32x4 __attribute__((ext_vector_type(4)));
typedef short bf16x8 __attribute__((ext_vector_type(8)));
typedef GAS unsigned gu32;
typedef GAS unsigned long long gu64;
#define RLX_AGENT __ATOMIC_RELAXED, __HIP_MEMORY_SCOPE_AGENT
#define LDS_WAIT() asm volatile("s_waitcnt lgkmcnt(0)" ::: "memory")
#define VM_WAIT() asm volatile("s_waitcnt vmcnt(0)" ::: "memory")
__device__ __forceinline__ unsigned long long rt() { return __builtin_amdgcn_s_memrealtime(); }
typedef float f32x2_cv __attribute__((ext_vector_type(2))); typedef __bf16 bf16x2_cv __attribute__((ext_vector_type(2)));
__device__ __forceinline__ unsigned pk2(float lo, float hi) { f32x2_cv v = {lo, hi}; bf16x2_cv b = __builtin_convertvector(v, bf16x2_cv); return __builtin_bit_cast(unsigned, b); }
__device__ __forceinline__ unsigned f2bf(float f) { return pk2(f, f) & 0xffffu; }
#define XB_TMO      128
#define XB_XCNT(j)  (256  + 64 * (j))
#define XB_XSUB(j)  (1280 + 64 * (j))
#define XB_XGEN(j)  (2304 + 64 * (j))
#define XB_TOP      3328
#define XB_TOPGEN   3392
#define XCD_BAR_WORDS 3456
#define XB_SPIN_CAP (1u << 18)

__device__ __forceinline__ unsigned xb_ld(unsigned* p)              { return __hip_atomic_load(p, __ATOMIC_RELAXED, __HIP_MEMORY_SCOPE_AGENT); }
__device__ __forceinline__ unsigned xb_add(unsigned* p, unsigned v) { return __hip_atomic_fetch_add(p, v, __ATOMIC_RELAXED, __HIP_MEMORY_SCOPE_AGENT); }
__device__ __forceinline__ unsigned xb_xcc_id() { return (unsigned)__builtin_amdgcn_s_getreg((3 << 11) | 20) & 0xFu; }
#define XB_SPIN(cond, bar) do { unsigned _sp = 0; while (cond) { __builtin_amdgcn_s_sleep(1); \
    if ((++_sp & 255u) == 0u) { if (xb_ld(&(bar)[XB_TMO])) break; if (_sp > XB_SPIN_CAP) { atomicAdd(&(bar)[XB_TMO], 1u); break; } } } } while (0)

struct XcdBarrier {
    unsigned* bar; unsigned x;
    volatile LAS unsigned* st;
};

__device__ __forceinline__ XcdBarrier xcd_barrier_post(unsigned* bar, volatile LAS unsigned* st) {
    XcdBarrier b; b.bar = bar; b.x = xb_xcc_id(); b.st = st;
    if (threadIdx.x == 0) (void)xb_add(&bar[XB_XCNT(b.x)], 1u);
    return b;
}
__device__ __forceinline__ void xcd_barrier_complete(unsigned* bar, unsigned x, unsigned& nloc, unsigned& nx) {
    const unsigned G = gridDim.x * gridDim.y * gridDim.z;
    unsigned sum, cnt, mine, sp = 0u;
    for (;;) {
        sum = 0u; cnt = 0u; mine = 0u;
#pragma unroll
        for (unsigned j = 0; j < 16; ++j) { const unsigned c = xb_ld(&bar[XB_XCNT(j)]); sum += c; cnt += (c > 0u) ? 1u : 0u; mine = (j == x) ? c : mine; }
        if (sum == G) break;
        __builtin_amdgcn_s_sleep(1);
        if ((++sp & 255u) == 0u) { if (xb_ld(&bar[XB_TMO])) break; if (sp > XB_SPIN_CAP) { atomicAdd(&bar[XB_TMO], 1u); break; } }
    }
    nloc = mine > 0u ? mine : 1u; nx = cnt > 0u ? cnt : 1u;
}

__device__ __forceinline__ void xcd_barrier(const XcdBarrier& b) {
    asm volatile("s_waitcnt vmcnt(0)" ::: "memory");
    __syncthreads();
    if (threadIdx.x == 0) {
        unsigned* bar = b.bar;
        __builtin_amdgcn_s_waitcnt(0);
        unsigned nloc = b.st[0], nx = b.st[1];
        if (nloc == 0u) { xcd_barrier_complete(bar, b.x, nloc, nx); b.st[0] = nloc; b.st[1] = nx; }
        const unsigned old = xb_add(&bar[XB_XSUB(b.x)], 1u);
        const unsigned gen = old / nloc;
        if (old + 1u == (gen + 1u) * nloc) {
            __builtin_amdgcn_fence(__ATOMIC_RELEASE, "agent");
            asm volatile("s_waitcnt vmcnt(0)" ::: "memory");
            const unsigned og = xb_add(&bar[XB_TOP], 1u);
            const unsigned tg = og / nx;
            if (og + 1u == (tg + 1u) * nx) xb_add(&bar[XB_TOPGEN], 1u);
            else XB_SPIN(xb_ld(&bar[XB_TOPGEN]) == tg, bar);
            __builtin_amdgcn_fence(__ATOMIC_ACQUIRE, "agent");
            xb_add(&bar[XB_XGEN(b.x)], 1u);
            asm volatile("s_waitcnt vmcnt(0)" ::: "memory");
        } else {
            XB_SPIN(xb_ld(&bar[XB_XGEN(b.x)]) == gen, bar);
            __builtin_amdgcn_fence(__ATOMIC_ACQUIRE, "agent");
            asm volatile("s_waitcnt vmcnt(0)" ::: "memory");
        }
    }
    __syncthreads();
}

struct Args { const float* in[25]; float* out; unsigned char* ws; int ph_lo, ph_hi; unsigned char prog[64]; };
template <int K> __device__ __forceinline__ const float* arg_in_() { const float* p_;
    asm volatile("s_load_dwordx2 %0, %1, %2\n\ts_waitcnt lgkmcnt(0)" : "=s"(p_) : "s"(__builtin_amdgcn_kernarg_segment_ptr()), "n"(K * 8)); return p_; }
#define ARG_IN(a_, k_) arg_in_<(k_)>()
__device__ __forceinline__ unsigned char* opaque_ws(const Args& a) { unsigned char* w = a.ws; asm volatile("" : "+s"(w)); return w; }

typedef unsigned u32x4v __attribute__((ext_vector_type(4)));
__device__ __forceinline__ float bf2f(bf16 v) { return __builtin_bit_cast(float, (unsigned)v << 16); }
__device__ __forceinline__ float wave_sum(float v) {
#pragma unroll
    for (int o = 1; o < 64; o <<= 1) v += shfl_xor_f(v, o);
    return v;
}
__device__ __forceinline__ float silu_f(float v) { return v * __builtin_amdgcn_rcpf(1.f + __builtin_amdgcn_exp2f(v * -1.4426950408889634f)); }

__device__ __forceinline__ void wprep_item(const float* W, int K, int Nsrc, int scol0, const float* gain, int gmask, float gscale,
                                           bf16* WT, int drow0, int k0, LAS float* scr, int lane) {
    float wv[32];
    asm volatile("" : "+s"(gscale));
#pragma unroll
    for (int i = 0; i < 32; ++i) { const int kk = 2 * i + (lane >> 5); wv[i] = W ? W[(size_t)(k0 + kk) * Nsrc + scol0 + (lane & 31)] : 0.f; }
#pragma unroll
    for (int i = 0; i < 32; ++i) { const int kk = 2 * i + (lane >> 5);
        const float gn = gain ? gain[(k0 + kk) & gmask] * gscale : gscale;
        scr[kk * 33 + (lane & 31)] = wv[i] * gn; }
    LDS_WAIT(); asm volatile("" ::: "memory");
    const int c = lane & 7;
#pragma unroll
    for (int j = 0; j < 4; ++j) { const int n = (lane >> 3) + 8 * j; const LAS float* s = scr + (8 * c) * 33 + n;
        v4u o; o.x = pk2(s[0 * 33], s[1 * 33]); o.y = pk2(s[2 * 33], s[3 * 33]); o.z = pk2(s[4 * 33], s[5 * 33]); o.w = pk2(s[6 * 33], s[7 * 33]);
        *(GAS v4u*)(WT + (size_t)(drow0 + n) * K + k0 + 8 * c) = o; }
    LDS_WAIT(); asm volatile("" ::: "memory");
}
__device__ __forceinline__ void rowstat_phase(const float* x, bf16* xb, float* rstd, int vcu, int NGW) {
    const int tid_ = opaque_tid(), lane = tid_ & 63, gw = vcu * NWAVES + __builtin_amdgcn_readfirstlane(tid_ >> 6);
    for (int m0 = gw * 2; m0 < M_TOK; m0 += NGW * 2) {
        f32x4 v[2][4]; float s[2];
#pragma unroll
        for (int r = 0; r < 2; ++r) { const GAS f32x4* xr = (const GAS f32x4*)(x + (size_t)(m0 + r) * DM) + lane;
#pragma unroll
            for (int j = 0; j < 4; ++j) v[r][j] = xr[64 * j]; }
#pragma unroll
        for (int r = 0; r < 2; ++r) { float t = 0.f;
#pragma unroll
            for (int j = 0; j < 4; ++j) t += (v[r][j].x * v[r][j].x + v[r][j].y * v[r][j].y) + (v[r][j].z * v[r][j].z + v[r][j].w * v[r][j].w);
            s[r] = wave_sum(t);
            GAS unsigned long long* o8 = (GAS unsigned long long*)(xb + (size_t)(m0 + r) * DM) + lane;
#pragma unroll
            for (int j = 0; j < 4; ++j) o8[64 * j] = (unsigned long long)pk2(v[r][j].x, v[r][j].y) | ((unsigned long long)pk2(v[r][j].z, v[r][j].w) << 32); }
        if (lane < 2) rstd[m0 + lane] = lane ? s[1] : s[0];
    }
}
__device__ __forceinline__ void prep_phase(const Args& a, LAS unsigned char* lds, int vcu, int NGW) {
    const int tid_ = opaque_tid(), lane = tid_ & 63, wave = __builtin_amdgcn_readfirstlane(tid_ >> 6), gw = vcu * NWAVES + wave;
    LAS float* scr = (LAS float*)(lds + wave * 16384);
    unsigned char* ws = opaque_ws(a);
    constexpr int I_IN = 16 * 168, I_OUT = 32 * 32, I_UP = 16 * 176, I_DN = 44 * 32, I_KV = 16 * 64, I_Q = 16 * 32, I_AO = 16 * 32;
    constexpr int NITEMS = I_IN + I_OUT + 2 * I_UP + 2 * I_DN + I_KV + I_Q + I_AO;
    for (int it = gw; it < NITEMS; it += NGW) {
        int r = it;
        if (r < I_IN) { const int kb = r / 168, db = r % 168;
            wprep_item(db < 161 ? ARG_IN(a, 2) : nullptr, 1024, NIN, 32 * db, ARG_IN(a, 1), 1023, 1.f, (bf16*)(ws + WS_WIN), 32 * db, 64 * kb, scr, lane); continue; } r -= I_IN;
        if (r < I_OUT) { const int kb = r / 32, db = r % 32;
            wprep_item(ARG_IN(a, 9), 2048, 1024, 32 * db, ARG_IN(a, 8), 2047, 1.f, (bf16*)(ws + WS_WOUT), 32 * db, 64 * kb, scr, lane); continue; } r -= I_OUT;
        if (r < 2 * I_UP) { const int l = r / I_UP; r -= l * I_UP; const int kb = r / 176, db = r % 176, j = db >> 3, q = db & 7;
            const int scol = (q < 4) ? (128 * j + 32 * q) : (FF + 128 * j + 32 * (q - 4));
            wprep_item(ARG_IN(a, 21) + (size_t)l * 1024 * FF2, 1024, FF2, scol, ARG_IN(a, 20) + l * 1024, 1023, 1.f, (bf16*)(ws + (l ? WS_WUP1 : WS_WUP0)), 32 * db, 64 * kb, scr, lane); continue; } r -= 2 * I_UP;
        if (r < 2 * I_DN) { const int l = r / I_DN; r -= l * I_DN; const int kb = r / 32, db = r % 32;
            wprep_item(ARG_IN(a, 24) + (size_t)l * FF * 1024, FF, 1024, 32 * db, nullptr, 0, 1.f, (bf16*)(ws + (l ? WS_WDN1 : WS_WDN0)), 32 * db, 64 * kb, scr, lane); continue; } r -= 2 * I_DN;
        if (r < I_KV) { const int kb = r / 64, db = r % 64, q = db & 7;
            wprep_item(ARG_IN(a, 11), 1024, 2048, 256 * (db >> 3) + 64 * (q & 3) + 32 * (q >> 2), ARG_IN(a, 10), 1023, 1.f, (bf16*)(ws + WS_WKVQ), 32 * db, 64 * kb, scr, lane); continue; } r -= I_KV;
        if (r < I_Q) { const int kb = r / 32, db = r % 32, q = db & 7;
            wprep_item(ARG_IN(a, 15), 1024, 1024, 256 * (db >> 3) + 64 * (q & 3) + 32 * (q >> 2), ARG_IN(a, 14), 1023, 1.f, (bf16*)(ws + WS_WKVQ), 2048 + 32 * db, 64 * kb, scr, lane); continue; } r -= I_Q;
        { const int kb = r / 32, db = r % 32;
            wprep_item(ARG_IN(a, 19), 1024, 1024, 32 * db, ARG_IN(a, 18), 127, 1.f - LAM_INIT, (bf16*)(ws + WS_WAO), 32 * db, 64 * kb, scr, lane); }
    }
    rowstat_phase(ARG_IN(a, 0), (bf16*)(ws + WS_XB), (float*)(ws + WS_RSTD), vcu, NGW);
}

__device__ __forceinline__ void ssd_naive_phase(const Args& a, LAS unsigned char* lds) {
    const int tid = opaque_tid();
    LAS float* cx = (LAS float*)lds;
    LAS float* cB = cx + 64 * 64;
    LAS float* cC = cB + 64 * 128;
    LAS float* cdA = cC + 64 * 128;
    LAS float* cdt = cdA + 64;
    const bf16* XBC = (const bf16*)(opaque_ws(a) + WS_XBC); bf16* Z = (bf16*)(opaque_ws(a) + WS_Z); const float* DT = (const float*)(opaque_ws(a) + WS_DT);
    const float* conv_w = ARG_IN(a, 3); const float* conv_b = ARG_IN(a, 4);
    const int p = tid >> 3, ns = (tid & 7) * 16;
    for (int item = blockIdx.x; item < NBATCH * SSM_H; item += gridDim.x) {
        const int b = item >> 5, h = item & 31, g = h >> 3;
        const float Aneg = -__expf(ARG_IN(a, 6)[h]), dtb = ARG_IN(a, 5)[h], Dh = ARG_IN(a, 7)[h];
        float hst[16];
#pragma unroll
        for (int i = 0; i < 16; ++i) hst[i] = 0.f;
        for (int t0 = 0; t0 < SEQ; t0 += 64) {
            for (int e = tid; e < 64 * 320; e += 512) {
                const int tt = e / 320, j = e - tt * 320;
                const int col = j < 64 ? 64 * h + j : (j < 192 ? 2048 + 128 * g + (j - 64) : 2560 + 128 * g + (j - 192));
                const int t = t0 + tt;
                float v = conv_b[col];
#pragma unroll
                for (int k = 0; k < 4; ++k) { const int ts = t - 3 + k; if (ts >= 0) v += conv_w[k * NXBC + col] * bf2f(XBC[(size_t)(b * SEQ + ts) * NXBC + col]); }
                v = silu_f(v);
                if (j < 64) cx[tt * 64 + j] = v; else if (j < 192) cB[tt * 128 + (j - 64)] = v; else cC[tt * 128 + (j - 192)] = v;
            }
            if (tid < 64) { const float raw = DT[(size_t)(b * SEQ + t0 + tid) * 32 + h] + dtb; const float dtv = raw > 20.f ? raw : log1pf(__expf(raw)); cdt[tid] = dtv; cdA[tid] = __expf(dtv * Aneg); }
            __syncthreads();
            for (int tt = 0; tt < 64; ++tt) {
                const float xv = cx[tt * 64 + p], dA = cdA[tt], xdt = xv * cdt[tt];
                float acc = 0.f;
#pragma unroll
                for (int i = 0; i < 16; ++i) { hst[i] = dA * hst[i] + xdt * cB[tt * 128 + ns + i]; acc += cC[tt * 128 + ns + i] * hst[i]; }
                acc += shfl_xor_f(acc, 1); acc += shfl_xor_f(acc, 2); acc += shfl_xor_f(acc, 4);
                if ((tid & 7) == 0) { const size_t idx = (size_t)(b * SEQ + t0 + tt) * DIN + 64 * h + p; const float z = bf2f(Z[idx]); Z[idx] = (bf16)f2bf((acc + xv * Dh) * silu_f(z)); }
            }
            __syncthreads();
        }
    }
}
__device__ __forceinline__ void unpack8(const v4u w, float (&f)[8]) {
    f[0] = __builtin_bit_cast(float, w.x << 16); f[1] = __builtin_bit_cast(float, w.x & 0xffff0000u); f[2] = __builtin_bit_cast(float, w.y << 16); f[3] = __builtin_bit_cast(float, w.y & 0xffff0000u);
    f[4] = __builtin_bit_cast(float, w.z << 16); f[5] = __builtin_bit_cast(float, w.z & 0xffff0000u); f[6] = __builtin_bit_cast(float, w.w << 16); f[7] = __builtin_bit_cast(float, w.w & 0xffff0000u);
}
__device__ __forceinline__ void groupnorm_phase(const Args& a, int vcu, int NGW) {
    const int tid_ = opaque_tid(), lane = tid_ & 63, gw = vcu * NWAVES + __builtin_amdgcn_readfirstlane(tid_ >> 6);
    bf16* Z = (bf16*)(opaque_ws(a) + WS_Z);
    for (int i = gw; i < M_TOK * 4; i += NGW) {
        GAS v4u* p = (GAS v4u*)(Z + (size_t)i * 512) + lane;
        float f[8]; unpack8(*p, f);
        float s = 0.f;
#pragma unroll
        for (int j = 0; j < 8; ++j) s += f[j] * f[j];
        s = wave_sum(s);
        const float r = 1.f / sqrtf(s * (1.f / 512.f) + EPS);
        v4u o; o.x = pk2(f[0] * r, f[1] * r); o.y = pk2(f[2] * r, f[3] * r); o.z = pk2(f[4] * r, f[5] * r); o.w = pk2(f[6] * r, f[7] * r);
        *p = o;
    }
}
__device__ __forceinline__ void convact_phase(const Args& a, int layer, int r0) {
    const bf16* U = (const bf16*)(opaque_ws(a) + WS_U); bf16* H = (bf16*)(opaque_ws(a) + WS_H);
    const float* cw = ARG_IN(a, 22) + (size_t)layer * 3 * FF2; const float* cb = ARG_IN(a, 23) + (size_t)layer * FF2;
    constexpr int NG = FF / 8, NITEMS = (MH / 32) * NG;
    const int nthr = gridDim.x * 512;
    for (int item = blockIdx.x * 512 + opaque_tid(); item < NITEMS; item += nthr) {
        const int seg = item / NG, c = (item - seg * NG) * 8, gcol = 256 * (c >> 7) + (c & 127);
        const int t1 = seg * 32, tseq = (r0 + t1) & (SEQ - 1);
        float wg[3][8], wu[3][8], bg[8], bu[8];
#pragma unroll
        for (int q = 0; q < 2; ++q) {
            const f32x4 x = *(const GAS f32x4*)(cb + c + 4 * q), y = *(const GAS f32x4*)(cb + FF + c + 4 * q);
#pragma unroll
            for (int e = 0; e < 4; ++e) { bg[4 * q + e] = x[e]; bu[4 * q + e] = y[e]; }
#pragma unroll
            for (int k = 0; k < 3; ++k) { const f32x4 xg = *(const GAS f32x4*)(cw + k * FF2 + c + 4 * q), xu = *(const GAS f32x4*)(cw + k * FF2 + FF + c + 4 * q);
#pragma unroll
                for (int e = 0; e < 4; ++e) { wg[k][4 * q + e] = xg[e]; wu[k][4 * q + e] = xu[e]; } }
        }
        const bf16* up = U + (size_t)t1 * FF2 + gcol;
        v4u g2 = {0u, 0u, 0u, 0u}, g1 = g2, u2 = g2, u1 = g2;
        if (tseq != 0) { g2 = *(const GAS v4u*)(up - 2 * (ptrdiff_t)FF2); u2 = *(const GAS v4u*)(up - 2 * (ptrdiff_t)FF2 + 128); g1 = *(const GAS v4u*)(up - (ptrdiff_t)FF2); u1 = *(const GAS v4u*)(up - (ptrdiff_t)FF2 + 128); }
        bf16* hp = H + (size_t)t1 * FF + c;
#pragma unroll 8
        for (int rr = 0; rr < 32; ++rr) {
            const v4u g0 = *(const GAS v4u*)(up + (size_t)rr * FF2), u0 = *(const GAS v4u*)(up + (size_t)rr * FF2 + 128);
            float a2[8], a1[8], a0[8], b2[8], b1[8], b0[8];
            unpack8(g2, a2); unpack8(g1, a1); unpack8(g0, a0); unpack8(u2, b2); unpack8(u1, b1); unpack8(u0, b0);
            float hv[8];
#pragma unroll
            for (int e = 0; e < 8; ++e) { const float gg = bg[e] + wg[0][e] * a2[e] + wg[1][e] * a1[e] + wg[2][e] * a0[e], uu = bu[e] + wu[0][e] * b2[e] + wu[1][e] * b1[e] + wu[2][e] * b0[e]; hv[e] = silu_f(gg) * uu; }
            *(GAS v4u*)(hp + (size_t)rr * FF) = (v4u){pk2(hv[0], hv[1]), pk2(hv[2], hv[3]), pk2(hv[4], hv[5]), pk2(hv[6], hv[7])};
            g2 = g1; g1 = g0; u2 = u1; u1 = u0;
        }
    }
}
__device__ __forceinline__ void bcconv_phase(const Args& a) {
    const bf16* XBC = (const bf16*)(opaque_ws(a) + WS_XBC); bf16* BCc = (bf16*)(opaque_ws(a) + WS_XB);
    const float* cw = ARG_IN(a, 3); const float* cb = ARG_IN(a, 4);
    constexpr int NG = 1024 / 8, NITEMS = (M_TOK / 32) * NG;
    const int nthr = gridDim.x * 512;
    for (int item = blockIdx.x * 512 + opaque_tid(); item < NITEMS; item += nthr) {
        const int seg = item / NG, c = (item - seg * NG) * 8, t1 = seg * 32, tseq = t1 & (SEQ - 1);
        float w[4][8], bb[8];
#pragma unroll
        for (int q = 0; q < 2; ++q) { const f32x4 x = *(const GAS f32x4*)(cb + 2048 + c + 4 * q);
#pragma unroll
            for (int e = 0; e < 4; ++e) bb[4 * q + e] = x[e];
#pragma unroll
            for (int k = 0; k < 4; ++k) { const f32x4 y = *(const GAS f32x4*)(cw + k * NXBC + 2048 + c + 4 * q);
#pragma unroll
                for (int e = 0; e < 4; ++e) w[k][4 * q + e] = y[e]; } }
        const bf16* sp = XBC + (size_t)t1 * NXBC + 2048 + c;
        v4u r3 = {0u, 0u, 0u, 0u}, r2 = r3, r1 = r3;
        if (tseq != 0) { r3 = *(const GAS v4u*)(sp - 3 * (ptrdiff_t)NXBC); r2 = *(const GAS v4u*)(sp - 2 * (ptrdiff_t)NXBC); r1 = *(const GAS v4u*)(sp - (ptrdiff_t)NXBC); }
        bf16* dp = BCc + (size_t)t1 * 1024 + c;
#pragma unroll 8
        for (int rr = 0; rr < 32; ++rr) {
            const v4u r0 = *(const GAS v4u*)(sp + (size_t)rr * NXBC);
            float a3[8], a2[8], a1[8], a0[8]; unpack8(r3, a3); unpack8(r2, a2); unpack8(r1, a1); unpack8(r0, a0);
            float o[8];
#pragma unroll
            for (int e = 0; e < 8; ++e) o[e] = silu_f(bb[e] + w[0][e] * a3[e] + w[1][e] * a2[e] + w[2][e] * a1[e] + w[3][e] * a0[e]);
            *(GAS v4u*)(dp + (size_t)rr * 1024) = (v4u){pk2(o[0], o[1]), pk2(o[2], o[3]), pk2(o[4], o[5]), pk2(o[6], o[7])};
            r3 = r2; r2 = r1; r1 = r0;
        }
    }
}
__device__ __forceinline__ void ssmconv_fixup_phase(const Args& a) {
    const bf16* raw = (const bf16*)(opaque_ws(a) + WS_XRAW); bf16* XBC = (bf16*)(opaque_ws(a) + WS_XBC);
    const float* cw = ARG_IN(a, 3); const float* cb = ARG_IN(a, 4);
    const int nthr = gridDim.x * 512;
    for (int e = blockIdx.x * 512 + opaque_tid(); e < (M_TOK / 256) * 3 * NXBC; e += nthr) {
        const int pm = e / (3 * NXBC), rem = e - pm * 3 * NXBC, r = rem / NXBC, col = rem - r * NXBC;
        const int rc = (col >> 8) * 256 + ((col >> 5) & 3) * 64 + ((col >> 7) & 1) * 32 + (col & 31);
        float x[6];
#pragma unroll
        for (int k = 0; k < 3; ++k) {
            x[k] = ((pm & 7) != 0) ? bf2f(raw[((size_t)(pm - 1) * 6 + 3 + k) * NXBC + rc]) : 0.f;
            x[3 + k] = bf2f(raw[((size_t)pm * 6 + k) * NXBC + rc]);
        }
        const float v = cb[col] + cw[col] * x[r] + cw[NXBC + col] * x[r + 1] + cw[2 * NXBC + col] * x[r + 2] + cw[3 * NXBC + col] * x[r + 3];
        XBC[(size_t)(pm * 256 + r) * NXBC + col] = (bf16)f2bf(silu_f(v));
    }
}
__device__ __forceinline__ void convffn_fixup_phase(const Args& a, int layer) {
    const bf16* raw = (const bf16*)(opaque_ws(a) + WS_FRAW); bf16* H = (bf16*)(opaque_ws(a) + WS_H);
    const float* cw = ARG_IN(a, 22) + (size_t)layer * 3 * FF2; const float* cb = ARG_IN(a, 23) + (size_t)layer * FF2;
    const int nthr = gridDim.x * 512;
    for (int e = blockIdx.x * 512 + opaque_tid(); e < (M_TOK / 256) * 2 * FF; e += nthr) {
        const int pm = e / (2 * FF), rem = e - pm * 2 * FF, r = rem / FF, ch = rem - r * FF;
        const int col = (ch >> 7) * 256 + ((ch >> 5) & 3) * 64 + (ch & 31);
        float g[4], u[4];
#pragma unroll
        for (int k = 0; k < 2; ++k) {
            if ((pm & 7) != 0) { const bf16* p = raw + ((size_t)(pm - 1) * 4 + 2 + k) * 22 * 256 + col; g[k] = bf2f(p[0]); u[k] = bf2f(p[32]); } else { g[k] = 0.f; u[k] = 0.f; }
            const bf16* q = raw + ((size_t)pm * 4 + k) * 22 * 256 + col; g[2 + k] = bf2f(q[0]); u[2 + k] = bf2f(q[32]);
        }
        const float cg = cb[ch] + cw[ch] * g[r] + cw[FF2 + ch] * g[r + 1] + cw[2 * FF2 + ch] * g[r + 2];
        const float cu = cb[FF + ch] + cw[FF + ch] * u[r] + cw[FF2 + FF + ch] * u[r + 1] + cw[2 * FF2 + FF + ch] * u[r + 2];
        H[(size_t)(pm * 256 + r) * FF + ch] = (bf16)f2bf(silu_f(cg) * cu);
    }
}
__device__ __forceinline__ void qknorm_phase(const Args& a, int vcu, int NGW) {
    const int tid_ = opaque_tid(), lane = tid_ & 63, gw = vcu * NWAVES + __builtin_amdgcn_readfirstlane(tid_ >> 6);
    for (int i = gw; i < M_TOK * 2; i += NGW) {
        const int tok = i >> 1, isq = i & 1;
        bf16* base = (bf16*)(opaque_ws(a) + (isq ? WS_Q : WS_K)) + (size_t)tok * 1024 + lane * 16;
        const float* g = (isq ? ARG_IN(a, 16) : ARG_IN(a, 12)) + (lane & 3) * 16; const float sc = isq ? QSCALE : 1.f;
        const v4u w0 = *(const GAS v4u*)base, w1 = *(const GAS v4u*)(base + 8);
        const unsigned ww[8] = {w0.x, w0.y, w0.z, w0.w, w1.x, w1.y, w1.z, w1.w};
        float f[16]; float s = 0.f;
#pragma unroll
        for (int q = 0; q < 8; ++q) { f[2 * q] = __builtin_bit_cast(float, ww[q] << 16); f[2 * q + 1] = __builtin_bit_cast(float, ww[q] & 0xffff0000u); s += f[2 * q] * f[2 * q] + f[2 * q + 1] * f[2 * q + 1]; }
        s += shfl_xor_f(s, 1); s += shfl_xor_f(s, 2);
        const float r = sc / sqrtf(s * (1.f / 64.f) + EPS);
        unsigned o[8];
#pragma unroll
        for (int q = 0; q < 8; ++q) o[q] = pk2(f[2 * q] * r * g[2 * q], f[2 * q + 1] * r * g[2 * q + 1]);
        *(GAS v4u*)base = (v4u){o[0], o[1], o[2], o[3]}; *(GAS v4u*)(base + 8) = (v4u){o[4], o[5], o[6], o[7]};
    }
}
__device__ __forceinline__ int t5_bucket(int n) {
    if (n < 16) return n;
    int l = 16 + (int)(__logf((float)n / 16.f) / 2.0794415416798357f * 16.f);
    return l < 31 ? l : 31;
}
__device__ __forceinline__ void attn_naive_phase(const Args& a, LAS unsigned char* lds) {
    const int tid = opaque_tid(), lane = tid & 63;
    LAS float* Qs = (LAS float*)lds;
    LAS float* Ks = Qs + 64 * 129;
    LAS float* Vs = Ks + 64 * 129;
    LAS float* Ws = Vs + 64 * 128;
    LAS float* btab = Ws + 64 * 65;
    const bf16* Kb = (const bf16*)(opaque_ws(a) + WS_K); const bf16* Vb = (const bf16*)(opaque_ws(a) + WS_V); bf16* Qb = (bf16*)(opaque_ws(a) + WS_Q);
    const float* rel_bias = ARG_IN(a, 13); const float* lv = ARG_IN(a, 17);
    const int r = tid >> 3, ks = tid & 7;
    for (int item = blockIdx.x; item < 4096; item += gridDim.x) {
        const int qb = 31 - (item >> 7), bh = item & 127, b = bh >> 3, h = bh & 7;
        const size_t row0 = (size_t)b * SEQ + qb * 64;
        __syncthreads();
        for (int e = tid; e < 64 * 128; e += 512) { const int rr = e >> 7, c = e & 127; Qs[rr * 129 + c] = bf2f(Qb[(row0 + rr) * 1024 + h * 128 + c]); }
        if (tid < 129) { const int bk = t5_bucket(tid); btab[tid] = rel_bias[bk * 8 + h] * LOG2E; }
        if (tid < 64) { float s0 = lv[tid] * lv[64 + tid], s1 = lv[128 + tid] * lv[192 + tid]; s0 = wave_sum(s0); s1 = wave_sum(s1); if (tid == 0) btab[129] = __expf(s0) - __expf(s1) + LAM_INIT; }
        const int qpos = qb * 64 + r;
        float m0 = -1e30f, l0 = 0.f, m1 = -1e30f, l1 = 0.f;
        for (int kt = 0; kt <= qb; ++kt) {
            __syncthreads();
            for (int e = tid; e < 64 * 128; e += 512) { const int kk = e >> 7, c = e & 127; Ks[kk * 129 + c] = bf2f(Kb[((size_t)b * SEQ + kt * 64 + kk) * 1024 + h * 128 + c]); }
            __syncthreads();
            float s0[8], s1[8];
#pragma unroll
            for (int i = 0; i < 8; ++i) { s0[i] = 0.f; s1[i] = 0.f; }
            for (int d = 0; d < 64; ++d) { const float q0 = Qs[r * 129 + d], q1 = Qs[r * 129 + 64 + d];
#pragma unroll
                for (int i = 0; i < 8; ++i) { s0[i] += q0 * Ks[(ks * 8 + i) * 129 + d]; s1[i] += q1 * Ks[(ks * 8 + i) * 129 + 64 + d]; } }
#pragma unroll
            for (int i = 0; i < 8; ++i) { const int kpos = kt * 64 + ks * 8 + i;
                if (kpos <= qpos) { const int dist = qpos - kpos; const float bb = btab[dist < 128 ? dist : 128];
                    const float a0 = s0[i] + bb, a1 = s1[i] + bb;
                    float mn = fmaxf(m0, a0); l0 = l0 * exp2f(m0 - mn) + exp2f(a0 - mn); m0 = mn;
                    mn = fmaxf(m1, a1); l1 = l1 * exp2f(m1 - mn) + exp2f(a1 - mn); m1 = mn; } }
        }
#pragma unroll
        for (int off = 1; off < 8; off <<= 1) {
            float mo = shfl_xor_f(m0, off), lo = shfl_xor_f(l0, off); float mn = fmaxf(m0, mo); l0 = l0 * exp2f(m0 - mn) + lo * exp2f(mo - mn); m0 = mn;
            mo = shfl_xor_f(m1, off); lo = shfl_xor_f(l1, off); mn = fmaxf(m1, mo); l1 = l1 * exp2f(m1 - mn) + lo * exp2f(mo - mn); m1 = mn;
        }
        const float inv0 = 1.f / l0, inv1 = 1.f / l1, lam = btab[129];
        float o[16];
#pragma unroll
        for (int d = 0; d < 16; ++d) o[d] = 0.f;
        for (int kt = 0; kt <= qb; ++kt) {
            __syncthreads();
            for (int e = tid; e < 64 * 128; e += 512) { const int kk = e >> 7, c = e & 127; const size_t gi = ((size_t)b * SEQ + kt * 64 + kk) * 1024 + h * 128 + c;
                Ks[kk * 129 + c] = bf2f(Kb[gi]); Vs[kk * 128 + c] = bf2f(Vb[gi]); }
            __syncthreads();
            float s0[8], s1[8];
#pragma unroll
            for (int i = 0; i < 8; ++i) { s0[i] = 0.f; s1[i] = 0.f; }
            for (int d = 0; d < 64; ++d) { const float q0 = Qs[r * 129 + d], q1 = Qs[r * 129 + 64 + d];
#pragma unroll
                for (int i = 0; i < 8; ++i) { s0[i] += q0 * Ks[(ks * 8 + i) * 129 + d]; s1[i] += q1 * Ks[(ks * 8 + i) * 129 + 64 + d]; } }
#pragma unroll
            for (int i = 0; i < 8; ++i) { const int kpos = kt * 64 + ks * 8 + i; float w = 0.f;
                if (kpos <= qpos) { const int dist = qpos - kpos; const float bb = btab[dist < 128 ? dist : 128];
                    w = exp2f(s0[i] + bb - m0) * inv0 - lam * exp2f(s1[i] + bb - m1) * inv1; }
                Ws[r * 65 + ks * 8 + i] = w; }
            __syncthreads();
            for (int kk = 0; kk < 64; ++kk) { const float w = Ws[r * 65 + kk];
#pragma unroll
                for (int d = 0; d < 16; ++d) o[d] += w * Vs[kk * 128 + ks * 16 + d]; }
        }
        float ss = 0.f;
#pragma unroll
        for (int d = 0; d < 16; ++d) ss += o[d] * o[d];
        ss += shfl_xor_f(ss, 1); ss += shfl_xor_f(ss, 2); ss += shfl_xor_f(ss, 4);
        const float rs = 1.f / sqrtf(ss * (1.f / 128.f) + EPS);
        bf16* op = Qb + (row0 + r) * 1024 + h * 128 + ks * 16;
        *(GAS v4u*)op = (v4u){pk2(o[0] * rs, o[1] * rs), pk2(o[2] * rs, o[3] * rs), pk2(o[4] * rs, o[5] * rs), pk2(o[6] * rs, o[7] * rs)};
        *(GAS v4u*)(op + 8) = (v4u){pk2(o[8] * rs, o[9] * rs), pk2(o[10] * rs, o[11] * rs), pk2(o[12] * rs, o[13] * rs), pk2(o[14] * rs, o[15] * rs)};
        (void)lane;
    }
}

typedef float f32x16 __attribute__((ext_vector_type(16)));
typedef short s16x4 __attribute__((ext_vector_type(4)));
typedef short v4i16_t __attribute__((ext_vector_type(4)));
__device__ __forceinline__ int crow(int r, int hi) { return (r & 3) + 8 * (r >> 2) + 4 * hi; }
__device__ __forceinline__ s16x4 vtr(const LAS unsigned char* p) { return __builtin_bit_cast(s16x4, __builtin_amdgcn_ds_read_tr16_b64_v4i16((LAS v4i16_t*)p)); }
template <int CTRL> __device__ __forceinline__ float dpp_add(float v) { return v + __builtin_bit_cast(float, __builtin_amdgcn_update_dpp(0, __builtin_bit_cast(int, v), CTRL, 0xf, 0xf, true)); }
__device__ __forceinline__ float red32(float v) {
    v = dpp_add<0xB1>(v); v = dpp_add<0x4E>(v); v = dpp_add<0x141>(v); v = dpp_add<0x140>(v);
    return v + __builtin_bit_cast(float, __builtin_amdgcn_ds_swizzle(__builtin_bit_cast(int, v), 0x401F));
}
__device__ __forceinline__ float wave_max(float v) {
#pragma unroll
    for (int o = 1; o < 64; o <<= 1) v = fmaxf(v, shfl_xor_f(v, o));
    return v;
}
__device__ __forceinline__ void glds16(const void* sbase, unsigned voff, unsigned lds_dst) { unsigned keep;
    asm volatile("s_nop 4\n\ts_mov_b32 %0, m0\n\ts_mov_b32 m0, %3\n\ts_nop 0\n\tglobal_load_lds_dwordx4 %1, %2\n\ts_mov_b32 m0, %0" : "=&s"(keep) : "v"(voff), "s"(sbase), "s"(lds_dst) : "memory"); }
__device__ __forceinline__ void attn_fast_phase(const Args& a, LAS unsigned char* lds, int vcu) {
    const int tid = opaque_tid(), lane = tid & 63, wid = __builtin_amdgcn_readfirstlane(tid >> 6), r32 = lane & 31, hi = lane >> 5;
    const int comp = wid >> 2, wq = wid & 3;
    const bf16* Kb = (const bf16*)(opaque_ws(a) + WS_K); const bf16* Vb = (const bf16*)(opaque_ws(a) + WS_V); const bf16* Qb = (const bf16*)(opaque_ws(a) + WS_Q); bf16* Ob = (bf16*)(opaque_ws(a) + WS_O);
    const float* rel_bias = ARG_IN(a, 13); const float* lv = ARG_IN(a, 17);
    LAS float* misc = (LAS float*)(lds + 131072);
    LAS float* wsf = misc + 256 + wid * 32;
    LAS float* X = (LAS float*)lds;
    const unsigned lds0 = (unsigned)(uintptr_t)lds;
    LAS float* tabs = misc + 512;
    { const int k = tid >> 7, d = tid & 127, hk = (4 * (vcu >> 3) + k) & 7;
      tabs[k * 132 + d] = rel_bias[t5_bucket(d) * 8 + hk] * LOG2E;
      if (d == 0) tabs[k * 132 + 128] = rel_bias[31 * 8 + hk] * LOG2E; }
    if (wid < 4) {
        const int hk = (4 * (vcu >> 3) + wid) & 7;
        float s0 = lv[lane] * lv[64 + lane], s1 = lv[128 + lane] * lv[192 + lane]; s0 = wave_sum(s0); s1 = wave_sum(s1);
        const float gq = wave_max(fabsf(ARG_IN(a, 16)[lane])), gk = wave_max(fabsf(ARG_IN(a, 12)[lane]));
        const float bm = wave_max(lane < 32 ? rel_bias[lane * 8 + hk] * LOG2E : -1e30f);
        if (lane == 0) { tabs[wid * 132 + 129] = __expf(s0) - __expf(s1) + LAM_INIT; tabs[wid * 132 + 131] = QSCALE * 64.f * gq * gk + bm; }
    }
    __syncthreads();
    for (int j = 0; j < 8; ++j) {
        const int bh = 4 * (vcu >> 3) + (j >> 1), s8 = vcu & 7, qb = (j & 1) ? 15 - s8 : s8;
        const int b = bh >> 3, h = bh & 7;
        const size_t tok0 = (size_t)b * SEQ;
        const int q0 = qb * 128;
        const LAS float* mt = tabs + (j >> 1) * 132;
        const bf16* qp = Qb + (tok0 + q0 + 32 * wq + r32) * 1024 + h * 128 + comp * 64 + 8 * hi;
        bf16x8 qr[4];
#pragma unroll
        for (int ks = 0; ks < 4; ++ks) qr[ks] = *(const GAS bf16x8*)(qp + 16 * ks);
        f32x16 o[4];
#pragma unroll
        for (int d = 0; d < 4; ++d)
#pragma unroll
            for (int r = 0; r < 16; ++r) o[d][r] = 0.f;
        float lsum = 0.f;
        const int NT = 2 * (qb + 1);
        const bf16* ksrc0 = Kb + tok0 * 1024 + h * 128;
        const unsigned kvoff = ((lane >> 2) * 1024 + 8 * ((lane & 3) ^ ((lane >> 4) & 3))) * 2, vvoff = ((lane >> 2) * 1024 + 8 * (lane & 3)) * 2;
        const bf16* vsrc0 = Vb + tok0 * 1024 + h * 128;
#define ATT_DMA_TILE(t, slot) do { _Pragma("unroll") for (int i_ = 0; i_ < 2; ++i_) { const int pk_ = wid + 8 * i_, d32_ = pk_ >> 2, k16_ = pk_ & 3; \
            glds16(ksrc0 + (size_t)(64 * (t) + 16 * k16_) * 1024 + 32 * d32_, kvoff, (unsigned)__builtin_amdgcn_readfirstlane((int)(lds0 + (slot) * 32768 + pk_ * 1024))); } \
        _Pragma("unroll") for (int i_ = 0; i_ < 2; ++i_) { const int pv_ = wid + 8 * i_, dvb_ = pv_ >> 2, k16_ = pv_ & 3; \
            glds16(vsrc0 + (size_t)(64 * (t) + 16 * k16_) * 1024 + 32 * dvb_, vvoff, (unsigned)__builtin_amdgcn_readfirstlane((int)(lds0 + (slot) * 32768 + 16384 + pv_ * 1024))); } } while (0)
        ATT_DMA_TILE(0, 0); ATT_DMA_TILE(1, 1);
        if (NT > 2) ATT_DMA_TILE(2, 2);
        asm volatile("" : "+v"(qr[0]), "+v"(qr[1]), "+v"(qr[2]), "+v"(qr[3]));
        if (NT > 2) asm volatile("s_waitcnt vmcnt(8) lgkmcnt(0)" ::: "memory"); else asm volatile("s_waitcnt vmcnt(4) lgkmcnt(0)" ::: "memory");
        __builtin_amdgcn_s_barrier(); asm volatile("" ::: "memory");
        const float cfar = mt[128] - mt[131], cnear = -mt[131];
        const int qpos = q0 + 32 * wq + r32;
        f32x16 cfarv;
#pragma unroll
        for (int r = 0; r < 16; ++r) cfarv[r] = cfar;
        asm volatile("" : "+v"(cfarv));
#define ATT_QK(P0, P1, tt, slot_) do { const LAS unsigned char* kb_ = lds + (slot_) * 32768 + (r32 >> 4) * 1024 + (r32 & 15) * 64; \
            bf16x8 kf_[8]; \
            _Pragma("unroll") for (int ks = 0; ks < 4; ++ks) { const int po_ = (comp * 2 + (ks >> 1)) * 4096 + ((((ks & 1) * 2 + hi) ^ ((r32 >> 2) & 3)) * 16); \
                kf_[2 * ks] = *(const LAS bf16x8*)(kb_ + po_); kf_[2 * ks + 1] = *(const LAS bf16x8*)(kb_ + po_ + 2048); } \
              \
            if ((tt) >= NT - 4) { f32x16 cn_; _Pragma("unroll") for (int r = 0; r < 16; ++r) cn_[r] = cnear; \
                P0 = __builtin_amdgcn_mfma_f32_32x32x16_bf16(kf_[0], qr[0], cn_, 0, 0, 0); P1 = __builtin_amdgcn_mfma_f32_32x32x16_bf16(kf_[1], qr[0], cn_, 0, 0, 0); } \
            else { P0 = __builtin_amdgcn_mfma_f32_32x32x16_bf16(kf_[0], qr[0], cfarv, 0, 0, 0); P1 = __builtin_amdgcn_mfma_f32_32x32x16_bf16(kf_[1], qr[0], cfarv, 0, 0, 0); } \
            _Pragma("unroll") for (int ks = 1; ks < 4; ++ks) { \
                P0 = __builtin_amdgcn_mfma_f32_32x32x16_bf16(kf_[2 * ks], qr[ks], P0, 0, 0, 0); \
                P1 = __builtin_amdgcn_mfma_f32_32x32x16_bf16(kf_[2 * ks + 1], qr[ks], P1, 0, 0, 0); } } while (0)
#define ATT_PV(slot_) do { const LAS unsigned char* vbase_ = lds + (slot_) * 32768 + 16384 + ((lane >> 4) & 1) * 32 + (lane & 3) * 8 + (4 * hi + ((lane & 15) >> 2)) * 64; \
            _Pragma("unroll") for (int dvb = 0; dvb < 4; ++dvb) _Pragma("unroll") for (int ks = 0; ks < 4; ++ks) { \
                const s16x4 lo_ = vtr(vbase_ + dvb * 4096 + ks * 1024), hh_ = vtr(vbase_ + dvb * 4096 + ks * 1024 + 512); \
                const bf16x8 vf_ = (bf16x8){lo_[0], lo_[1], lo_[2], lo_[3], hh_[0], hh_[1], hh_[2], hh_[3]}; \
                o[dvb] = __builtin_amdgcn_mfma_f32_32x32x16_bf16(__builtin_bit_cast(bf16x8, pw[ks]), vf_, o[dvb], 0, 0, 0); \
                } } while (0)
        f32x16 p0, p1;
        u32x4v pw[4];
#pragma unroll
        for (int q = 0; q < 4; ++q) pw[q] = (u32x4v){0u, 0u, 0u, 0u};
        int slotp = 3, slot = 0, slotn = 1, slotf = 2;
        for (int t = 0; t < NT; ++t) {
            if (comp == 1 && t > 0) ATT_PV(slotp);
            ATT_QK(p0, p1, t, slot);
            const bool near = t >= NT - 4;
            if (near) {
#define ATT_NEAR(P, koff) do { float bb_[16]; \
                    _Pragma("unroll") for (int r = 0; r < 16; ++r) { const int d_ = qpos - (64 * t + (koff) + crow(r, hi)); bb_[r] = mt[d_ < 0 ? 0 : (d_ < 128 ? d_ : 128)]; } \
                    _Pragma("unroll") for (int r = 0; r < 16; ++r) asm volatile("" : "+v"(bb_[r]));        \
                    _Pragma("unroll") for (int r = 0; r < 16; ++r) { const int d_ = qpos - (64 * t + (koff) + crow(r, hi)); const float x_ = P[r] + bb_[r]; \
                        P[r] = __builtin_amdgcn_exp2f(d_ < 0 ? -INFINITY : x_); } } while (0)
                ATT_NEAR(p0, 0); ATT_NEAR(p1, 32);
#undef ATT_NEAR
            } else {
#pragma unroll
                for (int r = 0; r < 16; ++r) { p0[r] = __builtin_amdgcn_exp2f(p0[r]); p1[r] = __builtin_amdgcn_exp2f(p1[r]); }
            }
            { typedef float f32x2a __attribute__((ext_vector_type(2)));
              f32x2a sa = (f32x2a){p0[0], p0[1]} + (f32x2a){p1[0], p1[1]};
#pragma unroll
              for (int r = 2; r < 16; r += 2) sa += (f32x2a){p0[r], p0[r + 1]} + (f32x2a){p1[r], p1[r + 1]};
              lsum += sa.x + sa.y; }
#pragma unroll
            for (int q = 0; q < 4; ++q) { pw[0][q] = pk2(p0[2 * q], p0[2 * q + 1]); pw[1][q] = pk2(p0[8 + 2 * q], p0[9 + 2 * q]);
                pw[2][q] = pk2(p1[2 * q], p1[2 * q + 1]); pw[3][q] = pk2(p1[8 + 2 * q], p1[9 + 2 * q]); }
            if (comp == 0) ATT_PV(slot);
            if (t + 2 < NT) asm volatile("s_waitcnt vmcnt(4) lgkmcnt(0)" ::: "memory"); else asm volatile("s_waitcnt vmcnt(0) lgkmcnt(0)" ::: "memory");
            __builtin_amdgcn_s_barrier(); asm volatile("" ::: "memory");
            if (t + 3 < NT) ATT_DMA_TILE(t + 3, slotp);
            { const int s_ = slotp; slotp = slot; slot = slotn; slotn = slotf; slotf = s_; }
        }
        if (comp == 1) ATT_PV(slotp);
        asm volatile("s_waitcnt lgkmcnt(0)" ::: "memory"); __builtin_amdgcn_s_barrier(); asm volatile("" ::: "memory");
#undef ATT_PV
#undef ATT_QK
#undef ATT_DMA_TILE
        const float lt = lsum + shfl_xor_f(lsum, 32);
        if (hi == 0) wsf[r32] = lt;
        LDS_WAIT(); asm volatile("" ::: "memory");
        float rli[16];
#pragma unroll
        for (int r = 0; r < 16; ++r) rli[r] = __builtin_amdgcn_rcpf(wsf[crow(r, hi)]);
        if (comp == 1) {
            const float lam = mt[129];
#pragma unroll
            for (int dvb = 0; dvb < 4; ++dvb)
#pragma unroll
                for (int q = 0; q < 4; ++q) {
                    f32x4 w;
#pragma unroll
                    for (int i = 0; i < 4; ++i) w[i] = o[dvb][4 * q + i] * rli[4 * q + i] * lam;
                    *(LAS f32x4*)(X + ((wq * 128 + 32 * dvb + r32) * 36 + 8 * q + 4 * hi)) = w; }
        }
        __syncthreads();
        if (comp == 0) {
            float ss[16];
#pragma unroll
            for (int r = 0; r < 16; ++r) ss[r] = 0.f;
#pragma unroll
            for (int dvb = 0; dvb < 4; ++dvb)
#pragma unroll
                for (int q = 0; q < 4; ++q) { const f32x4 xv = *(const LAS f32x4*)(X + ((wq * 128 + 32 * dvb + r32) * 36 + 8 * q + 4 * hi));
#pragma unroll
                    for (int i = 0; i < 4; ++i) { const int r = 4 * q + i; const float v = o[dvb][r] * rli[r] - xv[i]; o[dvb][r] = v; ss[r] += v * v; } }
#pragma unroll
            for (int r = 0; r < 16; ++r) { float s = ss[r]; s = red32(s); ss[r] = 1.f / sqrtf(s * (1.f / 128.f) + EPS); }
            LDS_WAIT(); asm volatile("" ::: "memory");
            LAS bf16* stg = (LAS bf16*)((LAS unsigned char*)X + 73728 + wq * 8192);
#pragma unroll
            for (int dvb = 0; dvb < 4; ++dvb)
#pragma unroll
                for (int r = 0; r < 16; ++r) stg[crow(r, hi) * 128 + 32 * dvb + r32] = (bf16)f2bf(o[dvb][r] * ss[r]);
            LDS_WAIT(); asm volatile("" ::: "memory");
            const int lane_e = opaque_tid() & 63;
#pragma unroll
            for (int i = 0; i < 8; ++i) { const int row = 4 * i + (lane_e >> 4), ch = lane_e & 15;
                const v4u w = *(const LAS v4u*)(stg + row * 128 + ch * 8);
                *(GAS v4u*)(Ob + (tok0 + q0 + 32 * wq + row) * 1024 + h * 128 + ch * 8) = w; }
        }
        __syncthreads();
    }
}

constexpr int SSD_LD = 272;
constexpr int SSD_BS = 0, SSD_CS = 128 * SSD_LD, SSD_XS = 2 * 128 * SSD_LD, SSD_ST = 3 * 128 * SSD_LD, SSD_VEC = 4 * 128 * SSD_LD,
              SSD_HALO = SSD_VEC + 2048, SSD_STG = SSD_HALO + 2048, SSD_GSL = SSD_STG + 8 * 2048;
static_assert(SSD_GSL + 1024 <= LDSCTL_OFF, "SSD LDS map");
__device__ __forceinline__ bf16x8 frag_tr(const LAS unsigned char* p) {
    const s16x4 lo = vtr(p), hh = vtr(p + 8 * SSD_LD);
    return (bf16x8){lo[0], lo[1], lo[2], lo[3], hh[0], hh[1], hh[2], hh[3]};
}
__device__ __forceinline__ void ssd_fast_phase(const Args& a, LAS unsigned char* lds, int vcu) {
    const int tid = opaque_tid(), lane = tid & 63, wid = __builtin_amdgcn_readfirstlane(tid >> 6), r32 = lane & 31, hi = lane >> 5;
    const unsigned zz_ = (unsigned)tid >> 31; const v4u vzero = {zz_, zz_, zz_, zz_};
    const int hh = wid >> 2, wl = hh ? 3 - (wid & 3) : (wid & 3), wn = wid & 3;
    const int b = vcu >> 4, g = (vcu >> 2) & 3, h0 = 8 * g + 2 * (vcu & 3), hd = h0 + hh;
    float* gss = (float*)(opaque_ws(a) + WS_GSS);
    const bf16* XBC = (const bf16*)(opaque_ws(a) + WS_XBC); const float* DT = (const float*)(opaque_ws(a) + WS_DT);
    const size_t tok0 = (size_t)b * SEQ;
    LAS float* dtv = (LAS float*)(lds + SSD_VEC);
    LAS float* acs = dtv + 256;
#define SSD_ROLES() const int tidr_ = opaque_tid(); const int cg = tidr_ % 48, ls = tidr_ / 48; \
    const int ccol = cg < 16 ? 64 * h0 + 8 * cg : (cg < 32 ? 2048 + 128 * g + 8 * (cg - 16) : 2560 + 128 * g + 8 * (cg - 32)); \
    const int cdst = (cg < 16 ? SSD_XS + 16 * cg : (cg < 32 ? SSD_BS + 16 * (cg - 16) : SSD_CS + 16 * (cg - 32))); (void)cdst; (void)ccol; (void)ls
    const float Aneg = -__expf(ARG_IN(a, 6)[hd]), Dh = ARG_IN(a, 7)[hd];
    f32x16 stq[2];
#pragma unroll
    for (int pb = 0; pb < 2; ++pb)
#pragma unroll
        for (int r = 0; r < 16; ++r) stq[pb][r] = 0.f;
    for (int e = tid; e < 128 * SSD_LD / 16; e += 512) *(LAS v4u*)(lds + SSD_ST + e * 16) = vzero;
    const int g16 = (lane >> 4) & 1, tq = (lane & 15) >> 2, tp = lane & 3;
    v4u pre[16];
#define SSD_PREFETCH(ch_) do { if (tid < 384) { SSD_ROLES(); const bf16* src_ = XBC + (tok0 + (ch_) * 128 + 16 * ls) * NXBC + ccol; \
        _Pragma("unroll") for (int i = 0; i < 16; ++i) pre[i] = *(const GAS v4u*)(src_ + (size_t)i * NXBC); } } while (0)
    float dtp[2] = {0.f, 0.f};
#define SSD_DTPREFETCH(ch_) do { if (wid >= 6) { const int hq_ = h0 + (wid - 6); const int lane_ = opaque_tid() & 63; \
        dtp[0] = DT[(tok0 + (ch_) * 128 + lane_) * 32 + hq_]; dtp[1] = DT[(tok0 + (ch_) * 128 + 64 + lane_) * 32 + hq_]; } } while (0)
    SSD_PREFETCH(0); SSD_DTPREFETCH(0);
    for (int ch = 0; ch < SEQ / 128; ++ch) {
        const int t0 = ch * 128;
        if (tid < 384) {
            SSD_ROLES();
#pragma unroll
            for (int i = 0; i < 16; ++i) *(LAS v4u*)(lds + cdst + (16 * ls + i) * SSD_LD) = pre[i];
        } else {
            const int q = wid - 6, hq = h0 + q; const float An = -__expf(ARG_IN(a, 6)[hq]), dtb = ARG_IN(a, 5)[hq];
            const float r0 = dtp[0] + dtb, r1 = dtp[1] + dtb;
            const float d0 = r0 > 20.f ? r0 : __logf(1.f + __expf(r0)), d1 = r1 > 20.f ? r1 : __logf(1.f + __expf(r1));
            float s0 = d0 * An, s1 = d1 * An;
#define SSD_DPP(v_, ctrl_, rmask_, bc_) __builtin_bit_cast(float, __builtin_amdgcn_update_dpp(0, __builtin_bit_cast(int, v_), ctrl_, rmask_, 0xf, bc_))
#define SSD_SCAN(v_) do { v_ += SSD_DPP(v_, 0x111, 0xf, true); v_ += SSD_DPP(v_, 0x112, 0xf, true); v_ += SSD_DPP(v_, 0x114, 0xf, true); v_ += SSD_DPP(v_, 0x118, 0xf, true); \
                v_ += SSD_DPP(v_, 0x142, 0xa, false); v_ += SSD_DPP(v_, 0x143, 0xc, false); } while (0)
            SSD_SCAN(s0); SSD_SCAN(s1);
#undef SSD_SCAN
#undef SSD_DPP
            s1 += __builtin_bit_cast(float, __builtin_amdgcn_readlane(__builtin_bit_cast(int, s0), 63));
            dtv[q * 128 + lane] = d0; dtv[q * 128 + 64 + lane] = d1; acs[q * 128 + lane] = s0; acs[q * 128 + 64 + lane] = s1;
        }
        __syncthreads();
        {
            const int lane = opaque_tid() & 63, r32 = lane & 31, hi = lane >> 5, g16 = (lane >> 4) & 1, tq = (lane & 15) >> 2, tp = lane & 3;
            bf16* Zb = (bf16*)(opaque_ws(a) + WS_Z);
            v4u zv[2][2];
#pragma unroll
            for (int pb = 0; pb < 2; ++pb)
#pragma unroll
                for (int i = 0; i < 2; ++i) zv[pb][i] = *(const GAS v4u*)(Zb + (tok0 + t0 + 32 * wl + 16 * i + (lane >> 2)) * DIN + 64 * hd + 32 * pb + (lane & 3) * 8);
            bf16x8 cf[8];
            const LAS unsigned char* cp = lds + SSD_CS + (32 * wl + r32) * SSD_LD + 16 * hi;
#pragma unroll
            for (int ks = 0; ks < 8; ++ks) cf[ks] = *(const LAS bf16x8*)(cp + 32 * ks);
            f32x16 acc[2];
#pragma unroll
            for (int pb = 0; pb < 2; ++pb) {
#pragma unroll
                for (int r = 0; r < 16; ++r) acc[pb][r] = 0.f;
                const LAS unsigned char* sp = lds + SSD_ST + (hh * 64 + 32 * pb + r32) * SSD_LD + 16 * hi;
#pragma unroll
                for (int ks = 0; ks < 8; ++ks) acc[pb] = __builtin_amdgcn_mfma_f32_32x32x16_bf16(cf[ks], *(const LAS bf16x8*)(sp + 32 * ks), acc[pb], 0, 0, 0);
            }
            const LAS float* acsh = acs + hh * 128; const LAS float* dth = dtv + hh * 128;
#pragma unroll
            for (int q = 0; q < 4; ++q) { const f32x4 av = *(const LAS f32x4*)(acsh + 32 * wl + 8 * q + 4 * hi);
#pragma unroll
                for (int i = 0; i < 4; ++i) { const float e = __expf(av[i]); acc[0][4 * q + i] *= e; acc[1][4 * q + i] *= e; } }
            const int lrow = 32 * wl + r32; const float acs_l = acsh[lrow];
            for (int sb = 0; sb <= wl; ++sb) {
                f32x16 gt;
#pragma unroll
                for (int r = 0; r < 16; ++r) gt[r] = 0.f;
                const LAS unsigned char* bp = lds + SSD_BS + (32 * sb + r32) * SSD_LD + 16 * hi;
#pragma unroll
                for (int ks = 0; ks < 8; ++ks) gt = __builtin_amdgcn_mfma_f32_32x32x16_bf16(*(const LAS bf16x8*)(bp + 32 * ks), cf[ks], gt, 0, 0, 0);
#pragma unroll
                for (int q = 0; q < 4; ++q) { const f32x4 av = *(const LAS f32x4*)(acsh + 32 * sb + 8 * q + 4 * hi), dv = *(const LAS f32x4*)(dth + 32 * sb + 8 * q + 4 * hi);
#pragma unroll
                    for (int i = 0; i < 4; ++i) { const int r = 4 * q + i, s = 32 * sb + 8 * q + 4 * hi + i;
                        float m = gt[r] * __expf(acs_l - av[i]) * dv[i];
                        if (s == lrow) m += Dh;
                        gt[r] = (s <= lrow) ? m : 0.f; } }
                u32x4v pw0, pw1;
#pragma unroll
                for (int q = 0; q < 4; ++q) { pw0[q] = pg8::cvt_pk_bf16(gt[2 * q], gt[2 * q + 1]); pw1[q] = pg8::cvt_pk_bf16(gt[8 + 2 * q], gt[9 + 2 * q]); }
#pragma unroll
                for (int pb = 0; pb < 2; ++pb) {
                    const LAS unsigned char* xp = lds + SSD_XS + (32 * sb + 4 * hi + tq) * SSD_LD + (64 * hh + 32 * pb + 16 * g16 + 4 * tp) * 2;
                    acc[pb] = __builtin_amdgcn_mfma_f32_32x32x16_bf16(__builtin_bit_cast(bf16x8, pw0), frag_tr(xp), acc[pb], 0, 0, 0);
                    acc[pb] = __builtin_amdgcn_mfma_f32_32x32x16_bf16(__builtin_bit_cast(bf16x8, pw1), frag_tr(xp + 16 * SSD_LD), acc[pb], 0, 0, 0);
                }
            }
            LAS bf16* stg = (LAS bf16*)(lds + SSD_STG + wid * 2048);
            float sqa[2] = {0.f, 0.f};
#pragma unroll
            for (int pb = 0; pb < 2; ++pb) {
#pragma unroll
                for (int r = 0; r < 16; ++r) stg[crow(r, hi) * 32 + r32] = (bf16)f2bf(acc[pb][r]);
                LDS_WAIT(); asm volatile("" ::: "memory");
#pragma unroll
                for (int i = 0; i < 2; ++i) { const int row = 16 * i + (lane >> 2), c8 = (lane & 3) * 8;
                    float y[8], z[8]; unpack8(*(const LAS v4u*)(stg + row * 32 + c8), y); unpack8(zv[pb][i], z);
                    float sq = 0.f;
#pragma unroll
                    for (int e = 0; e < 8; ++e) { y[e] *= silu_f(z[e]); sq += y[e] * y[e]; }
                    *(GAS v4u*)(Zb + (tok0 + t0 + 32 * wl + row) * DIN + 64 * hd + 32 * pb + c8) = (v4u){pk2(y[0], y[1]), pk2(y[2], y[3]), pk2(y[4], y[5]), pk2(y[6], y[7])};
                    sqa[i] += sq; }
                LDS_WAIT(); asm volatile("" ::: "memory");
            }
#pragma unroll
            for (int i = 0; i < 2; ++i) { float sq = sqa[i];
                sq += __builtin_bit_cast(float, __builtin_amdgcn_update_dpp(0, __builtin_bit_cast(int, sq), 0xB1, 0xf, 0xf, true));
                sq += __builtin_bit_cast(float, __builtin_amdgcn_update_dpp(0, __builtin_bit_cast(int, sq), 0x4E, 0xf, 0xf, true));
                if ((lane & 3) == 0) ((LAS float*)(lds + SSD_GSL))[hh * 128 + 32 * wl + 16 * i + (lane >> 2)] = sq; }
        }
        __syncthreads();
        if (ch + 1 < SEQ / 128) { SSD_PREFETCH(ch + 1); SSD_DTPREFETCH(ch + 1); }
        {
            const int tidc = opaque_tid();
            if (tidc < 128) gss[(tok0 + t0 + tidc) * 16 + g * 4 + (vcu & 3)] = ((LAS float*)(lds + SSD_GSL))[tidc] + ((LAS float*)(lds + SSD_GSL))[128 + tidc];
 const int l = tidc >> 2, c0 = (tidc & 3) * 32, hq = c0 >> 6;
            const float f = __expf(acs[hq * 128 + 127] - acs[hq * 128 + l]) * dtv[hq * 128 + l];
            LAS unsigned char* xp = lds + SSD_XS + l * SSD_LD + c0 * 2;
#pragma unroll
            for (int q = 0; q < 4; ++q) { v4u w = *(LAS v4u*)(xp + 16 * q); unsigned ww[4] = {w.x, w.y, w.z, w.w};
#pragma unroll
                for (int i = 0; i < 4; ++i) ww[i] = pk2(__builtin_bit_cast(float, ww[i] << 16) * f, __builtin_bit_cast(float, ww[i] & 0xffff0000u) * f);
                *(LAS v4u*)(xp + 16 * q) = (v4u){ww[0], ww[1], ww[2], ww[3]}; }
        }
        __syncthreads();
        {
            const int lane = opaque_tid() & 63, r32 = lane & 31, hi = lane >> 5, g16 = (lane >> 4) & 1, tq = (lane & 15) >> 2, tp = lane & 3;
            const float eL = __expf(acs[hh * 128 + 127]);
#pragma unroll
            for (int pb = 0; pb < 2; ++pb)
#pragma unroll
                for (int r = 0; r < 16; ++r) stq[pb][r] *= eL;
            const LAS unsigned char* bp = lds + SSD_BS + (4 * hi + tq) * SSD_LD + (32 * wn + 16 * g16 + 4 * tp) * 2;
            const LAS unsigned char* xp = lds + SSD_XS + (4 * hi + tq) * SSD_LD + (64 * hh + 16 * g16 + 4 * tp) * 2;
#pragma unroll
            for (int ks = 0; ks < 8; ++ks) {
                const bf16x8 bt = frag_tr(bp + 16 * ks * SSD_LD);
                stq[0] = __builtin_amdgcn_mfma_f32_32x32x16_bf16(bt, frag_tr(xp + 16 * ks * SSD_LD), stq[0], 0, 0, 0);
                stq[1] = __builtin_amdgcn_mfma_f32_32x32x16_bf16(bt, frag_tr(xp + 16 * ks * SSD_LD + 64), stq[1], 0, 0, 0);
            }
#pragma unroll
            for (int pb = 0; pb < 2; ++pb)
#pragma unroll
                for (int rg = 0; rg < 4; ++rg) {
                    typedef unsigned u32x2v __attribute__((ext_vector_type(2)));
                    u32x2v w; w.x = pg8::cvt_pk_bf16(stq[pb][4 * rg], stq[pb][4 * rg + 1]); w.y = pg8::cvt_pk_bf16(stq[pb][4 * rg + 2], stq[pb][4 * rg + 3]);
                    *(LAS u32x2v*)(lds + SSD_ST + (hh * 64 + 32 * pb + r32) * SSD_LD + (32 * wn + 8 * rg + 4 * hi) * 2) = w;
                }
        }
        __syncthreads();
    }
}


#ifndef MK_ONE_LAUNCH
#define MK_ONE_LAUNCH 1
#endif
constexpr int N_PHASES = 24;
#ifndef MK_PROG
#define MK_PROG {0, 1, 25, 2, 4, 6, 7, 8, 13, 15, 16, 18, 19, 20}
#endif
#ifndef STAG_IN
#define STAG_IN 0
#endif
#ifndef STAG_RES
#define STAG_RES 0
#endif
#ifndef STAG_UP
#define STAG_UP 0
#endif
#ifndef STAG_KVQ
#define STAG_KVQ 0
#endif
__device__ __forceinline__ void stagger_spin(int ticks) {
    if (ticks > 0) { const long long t0_ = __builtin_amdgcn_s_memrealtime(); while ((long long)__builtin_amdgcn_s_memrealtime() - t0_ < ticks) __builtin_amdgcn_s_sleep(8); }
}
__global__ void __launch_bounds__(NWAVES * 64, 2) mk_fwd(Args args) {
    extern __shared__ __attribute__((aligned(16))) unsigned char lds_raw[];
    LAS unsigned char* lds = (LAS unsigned char*)lds_raw;
    const int G = gridDim.x;
#ifdef PROBE_PH
    const long long tk0_ = __builtin_amdgcn_s_memrealtime();
#endif
    const int vcu = (G % 8 == 0) ? ((int)blockIdx.x % 8) * (G / 8) + (int)blockIdx.x / 8 : (int)blockIdx.x;
    const int NGW = G * NWAVES;
    gu32* ctl = (gu32*)(args.ws + WS_CTL);
    for (int u = threadIdx.x; u < (LDS_BYTES - LDSCTL_OFF) / 4; u += NWAVES * 64) ((LAS unsigned*)(lds + LDSCTL_OFF))[u] = 0u;
    __syncthreads();
    volatile LAS unsigned* MISC = (volatile LAS unsigned*)(lds + MISC_OFF);
    XcdBarrier bar; bar.bar = (unsigned*)(ctl + CW_BAR); bar.x = 0; bar.st = nullptr;
    const int ph_lo = __builtin_amdgcn_readfirstlane(args.ph_lo), ph_hi = __builtin_amdgcn_readfirstlane(args.ph_hi);
    const bool multi = (ph_hi - ph_lo) > 1;
    if (multi) bar = xcd_barrier_post((unsigned*)(ctl + CW_BAR), MISC + 8);

#ifdef PROBE_PH
#endif
    for (int pi = ph_lo; pi < ph_hi; ++pi) {
        const int ph = args.prog[pi];
        unsigned char* const ws = opaque_ws(args);
        bf16* const XB = (bf16*)(ws + WS_XB); float* const SS0 = (float*)(ws + WS_RSTD);
        float* const SS1 = (float*)(ws + WS_SS1); float* const SS2 = (float*)(ws + WS_SS2); float* const SS3 = (float*)(ws + WS_SS3);
#ifdef PROBE_PH
        const long long tp0_ = __builtin_amdgcn_s_memrealtime();
#endif
        if (ph == 0) prep_phase(args, lds, vcu, NGW);
        else if (ph == 1) {
            pg8::Gemm g{XB, (const bf16*)(ws + WS_WIN), M_TOK, NINP, DM}; pg8::StaticOrder S; S.init(M_TOK, NINP, G, (int)blockIdx.x);
            pg8::EpiInConv E{(bf16*)(ws + WS_Z), (bf16*)(ws + WS_XBC), (float*)(ws + WS_DT), SS0, (bf16*)(ws + WS_XRAW), ARG_IN(args, 3), ARG_IN(args, 4), lds + RING_BYTES};
            stagger_spin((int)blockIdx.x >= 128 ? STAG_IN : 0);
            pg8::gemm_phase<pg8::EpiInConv, pg8::StaticOrder, true, true>(lds, g, S, E, (float*)(ws + 768 * 1024));
        }
        else if (ph == 25) ssmconv_fixup_phase(args);
        else if (ph == 2) ssd_fast_phase(args, lds, vcu);
        else if (ph == 13) {
            pg8::Gemm g{XB, (const bf16*)(ws + WS_WKVQ), M_TOK, 3072, DM}; pg8::StaticOrder S; S.init(M_TOK, 3072, G, (int)blockIdx.x);
            pg8::EpiKVQ E{(bf16*)(ws + WS_K), (size_t)(WS_V - WS_K) / 2, SS2, ARG_IN(args, 12), ARG_IN(args, 16), QSCALE};
            static_assert(WS_Q - WS_V == WS_V - WS_K, "K, V, Q equally spaced");
            stagger_spin((((int)blockIdx.x >> 3) & 3) * STAG_KVQ);
            pg8::gemm_phase<pg8::EpiKVQ, pg8::StaticOrder, true, true>(lds, g, S, E, (float*)(ws + 768 * 1024));
        }
        else if (ph == 15) attn_fast_phase(args, lds, vcu);
        else {
            const int ffn_l = (ph >= 18) ? 1 : 0;
            if (ph == 6 || ph == 18) {
                pg8::Gemm g{XB, (const bf16*)(ws + (ffn_l ? WS_WUP1 : WS_WUP0)), M_TOK, FF2, DM}; pg8::StaticOrder S; S.init(M_TOK, FF2, G, (int)blockIdx.x);
                pg8::EpiConvFFN E{(bf16*)(ws + WS_H), (bf16*)(ws + WS_FRAW), ffn_l ? SS3 : SS1, ARG_IN(args, 22) + (size_t)ffn_l * 3 * FF2, ARG_IN(args, 23) + (size_t)ffn_l * FF2, lds + RING_BYTES};
                stagger_spin((((int)blockIdx.x >> 3) & 3) * STAG_UP);
                pg8::gemm_phase<pg8::EpiConvFFN, pg8::StaticOrder, true, true>(lds, g, S, E, (float*)(ws + 768 * 1024));
            } else if (ph == 7 || ph == 19) convffn_fixup_phase(args, ffn_l);
            else {
                const bf16* A; const bf16* Bt; int Kg; const bf16* baseb = XB; float* outf = nullptr; bf16* xbp = XB; float* ssp;
                if (ph == 4) { A = (const bf16*)(ws + WS_Z); Bt = (const bf16*)(ws + WS_WOUT); Kg = DIN; ssp = SS1; }
                else if (ph == 16) { A = (const bf16*)(ws + WS_O); Bt = (const bf16*)(ws + WS_WAO); Kg = DM; ssp = SS3; }
                else { A = (const bf16*)(ws + WS_H); Bt = (const bf16*)(ws + (ffn_l ? WS_WDN1 : WS_WDN0)); Kg = FF; ssp = ffn_l ? nullptr : SS2; if (ffn_l) { outf = args.out; xbp = nullptr; } }
                pg8::Gemm g{A, Bt, M_TOK, DM, Kg}; pg8::StaticOrder S; S.init(M_TOK, DM, G, (int)blockIdx.x);
                pg8::EpiRes E{baseb, outf, xbp, ssp, (ph == 20) ? (const float*)(ws + 768 * 1024) : nullptr, (ph == 4) ? (const float*)(ws + WS_GSS) : nullptr, (PG8_LAS float*)(lds + RING_BYTES)};
                stagger_spin((((int)blockIdx.x >> 3) & 1) * STAG_RES);
                pg8::gemm_phase<pg8::EpiRes, pg8::StaticOrder, true, true>(lds, g, S, E, (float*)(ws + 768 * 1024));
            }
        }
        if (pi + 1 < ph_hi) xcd_barrier(bar);
#ifdef PROBE_PH
        if (ph == PROBE_PH) { const long long now_ = __builtin_amdgcn_s_memrealtime(), tgt_ = now_ + PROBE_K * (now_ - tp0_) + PROBE_FIX * 100;
            while ((long long)__builtin_amdgcn_s_memrealtime() < tgt_) __builtin_amdgcn_s_sleep(20); }
#endif
    }
#ifdef PROBE_PH
    if (PROBE_PH == 99) { const long long now_ = __builtin_amdgcn_s_memrealtime(), tgt_ = now_ + (now_ - tk0_); while ((long long)__builtin_amdgcn_s_memrealtime() < tgt_) __builtin_amdgcn_s_sleep(20); }
#endif
}

extern "C" void kernel_launch(void* const* d_in, const int* in_sizes, int n_in, void* d_out, int out_size, void* d_ws, size_t ws_size, hipStream_t stream) {
    static int grid = 0;
    if (grid == 0) {
        if (n_in != 25 || in_sizes[0] != M_TOK * DM || out_size != M_TOK * DM || ws_size < WS_END) {
            fprintf(stderr, "kernel_launch: unexpected problem (n_in %d, in0 %d, out %d, ws %zu)\n", n_in, n_in > 0 ? in_sizes[0] : -1, out_size, ws_size); grid = -1; return; }
        int dev = 0, cus = 0, per_cu = 0;
        if (hipGetDevice(&dev) != hipSuccess || hipDeviceGetAttribute(&cus, hipDeviceAttributeMultiprocessorCount, dev) != hipSuccess) { grid = -1; return; }
        if (hipFuncSetAttribute((const void*)mk_fwd, hipFuncAttributeMaxDynamicSharedMemorySize, LDS_BYTES) != hipSuccess) { fprintf(stderr, "kernel_launch: hipFuncSetAttribute failed\n"); grid = -1; return; }
        if (hipOccupancyMaxActiveBlocksPerMultiprocessor(&per_cu, (const void*)mk_fwd, NWAVES * 64, LDS_BYTES) != hipSuccess || per_cu < 1)
            fprintf(stderr, "kernel_launch: occupancy query reports %d blocks per CU\n", per_cu);
        (void)hipGetLastError();
        grid = cus;
        if (grid != 256) { fprintf(stderr, "kernel_launch: built for a 256-CU device, found %d CUs\n", cus); grid = -1; return; }
    }
    if (grid < 0) return;
    if (hipMemsetAsync((char*)d_ws + WS_CTL, 0, CTL_ZERO_BYTES, stream) != hipSuccess) { fprintf(stderr, "kernel_launch: memset failed\n"); return; }
    Args a{};
    for (int i = 0; i < 25; ++i) a.in[i] = (const float*)d_in[i];
    a.out = (float*)d_out; a.ws = (unsigned char*)d_ws;
#ifndef MK_PROG
#define MK_PROG {0, 1, 2, 3, 4, 5, 6, 7, 8, 9, 10, 11, 12, 13, 14, 15, 16, 17, 18, 19, 20, 21, 22, 23}
#endif
    static const unsigned char prog_[] = MK_PROG; const int nprog = (int)sizeof(prog_);
    for (int i = 0; i < nprog && i < 64; ++i) a.prog[i] = prog_[i];
#if MK_ONE_LAUNCH
    a.ph_lo = 0; a.ph_hi = nprog;
    hipLaunchKernelGGL(mk_fwd, dim3(grid), dim3(NWAVES * 64), LDS_BYTES, stream, a);
#else
    for (int ph = 0; ph < nprog; ++ph) { a.ph_lo = ph; a.ph_hi = ph + 1; hipLaunchKernelGGL(mk_fwd, dim3(grid), dim3(NWAVES * 64), LDS_BYTES, stream, a); }
#endif
    const hipError_t le = hipPeekAtLastError();
    if (le != hipSuccess) fprintf(stderr, "kernel_launch: launch failed: %s\n", hipGetErrorName(le));
}
```

```cpp
#include <hip/hip_runtime.h>
#include <hip/hip_bf16.h>
#include <cstdio>
#include <cstdint>
#include <cmath>
__device__ __forceinline__ int opaque_tid() { int t = threadIdx.x; asm volatile("" : "+v"(t)); return t; }
__device__ __forceinline__ float shfl_xor_f(float v, int m) { int l_; asm volatile("v_mbcnt_lo_u32_b32 %0, -1, 0\n\tv_mbcnt_hi_u32_b32 %0, -1, %0" : "=v"(l_));
    return __builtin_bit_cast(float, __builtin_amdgcn_ds_bpermute((l_ ^ m) << 2, __builtin_bit_cast(int, v))); }
#ifndef ATT_REPS
#define ATT_REPS 2
#endif
#ifndef SSD_Y2XBC
#define SSD_Y2XBC 1
#endif
#ifndef SSD_SKEW_CYCLES
#define SSD_SKEW_CYCLES 25000
#endif
#define MK_ONE_LAUNCH 1

namespace pg8 {
#define PG8_LAS __attribute__((address_space(3)))
typedef unsigned short bf16_t;
typedef short bf16x8 __attribute__((ext_vector_type(8)));
typedef float f32x4 __attribute__((ext_vector_type(4)));
typedef unsigned u32x4 __attribute__((ext_vector_type(4)));
constexpr int BM = 256, BK = 64, HALF = 128, HTB = HALF * BK * 2  , STAGE_BYTES = 8 * HTB, NXCD = 8, WGM = 8;

__host__ __device__ __forceinline__ int lds_byte(int r, int c) { const int st = (r >> 4) * 2 + (c >> 5), rr = r & 15, cc = c & 31, ob = rr * 64 + cc * 2; return st * 1024 + (ob ^ (((ob >> 9) & 1) << 5)); }
__host__ __device__ __forceinline__ void stage_rc(int b, int& R, int& C) { const int st = b / 1024, sb = b % 1024, swz = sb ^ (((sb >> 9) & 1) << 5); R = (st >> 1) * 16 + swz / 64; C = (st & 1) * 32 + (swz % 64) / 2; }
__host__ __device__ __forceinline__ int perm32(int rho) { const int n = rho >> 4, i = rho & 15; return 8 * (i >> 2) + 4 * n + (i & 3); }

struct Unit { int pm, pn, ui; };
struct Gemm { const bf16_t* A; const bf16_t* Bt; int M, N, K; };

struct StaticOrder {
    int nM, nN, nwg, G, c;
    __host__ __device__ void init(int M, int N, int G_, int c_) { nM = M / BM; nN = N / BM; nwg = nM * nN; G = G_; c = c_; }
    __host__ __device__ bool next(int i, Unit& u) const {
        const long L = (long)i * G + c; if (L >= nwg) return false;
        int wgid = (int)L; { const int q = nwg / NXCD, r = nwg % NXCD, xcd = wgid % NXCD, off = wgid / NXCD; wgid = (xcd < r ? xcd * (q + 1) : r * (q + 1) + (xcd - r) * q) + off; }
        const int nig = WGM * nN, gid = wgid / nig, fm = gid * WGM, gsz = (nM - fm) < WGM ? (nM - fm) : WGM;
        u.pm = fm + ((wgid % nig) % gsz); u.pn = (wgid % nig) / gsz; return true;
    }
    __device__ __forceinline__ void a_ready(const Unit&) const {}
    __device__ __forceinline__ void done(const Unit&) const {}
};
__device__ __forceinline__ unsigned cvt_pk_bf16(float lo, float hi) { unsigned r; asm volatile("v_cvt_pk_bf16_f32 %0, %1, %2" : "=v"(r) : "v"(lo), "v"(hi)); return r; }
typedef float f32x2 __attribute__((ext_vector_type(2)));
template <class Epi, class Sched, bool ALIGN_EPI = false, bool SP2 = false>
__device__ __forceinline__ void gemm_phase(PG8_LAS unsigned char* lds, const Gemm g, const Sched& S, const Epi& E, float* probe_slot_ = nullptr) {
    const int tid = opaque_tid(), wid = __builtin_amdgcn_readfirstlane(tid >> 6), lane = tid & 63, wr = wid >> 2, wc = wid & 3, fr = lane & 15, fq = lane >> 4;
    const int K = g.K, nt = K / BK;
    unsigned voffA[2], voffB[2];
#pragma unroll
    for (int i = 0; i < 2; ++i) { int R, C; stage_rc(tid * 16 + i * 8192, R, C); const int Rb = Epi::PERM ? ((R & ~31) + perm32(R & 31)) : R;
        voffA[i] = (unsigned)(R * K + C) * 2u; voffB[i] = (unsigned)(Rb * K + C) * 2u; }
    const size_t kstep = (size_t)(BK * 2);
    const size_t hstep = (size_t)HALF * K * 2;
    const size_t tstep = 2 * hstep;
    const unsigned ldsw = (unsigned)wid * 1024u;
    const unsigned lds0_ = (unsigned)__builtin_amdgcn_readfirstlane((int)((unsigned)(uintptr_t)lds + ldsw));
    const int aoff = lds_byte(wr * 64 + fr, fq * 8), boff = lds_byte(wc * 32 + fr, fq * 8);
#define PG8_SA(b, h) (((b) * 2 + (h)) * HTB)
#define PG8_SB(b, h) ((4 + (b) * 2 + (h)) * HTB)
#define PG8_STAGE(bufoff, gbase, voff) do { _Pragma("unroll") for (int _i = 0; _i < 2; ++_i) { unsigned keep_; \
        asm volatile("s_mov_b32 m0, %2\n\ts_nop 0\n\tglobal_load_lds_dwordx4 %0, %1" \
            :: "v"((voff)[_i]), "s"((const char*)(gbase)), "s"(lds0_ + (unsigned)((bufoff) + _i * 8192)) : "memory", "m0"); (void)keep_; } } while (0)
#define PG8_LDA(dst, b, h) do { _Pragma("unroll") for (int m = 0; m < 4; ++m) _Pragma("unroll") for (int k = 0; k < 2; ++k) dst[m][k] = *(const PG8_LAS bf16x8*)(lds + PG8_SA(b, h) + aoff + m * 2048 + k * 1024); } while (0)
#define PG8_LDB(dst, b, h) do { _Pragma("unroll") for (int n = 0; n < 2; ++n) _Pragma("unroll") for (int k = 0; k < 2; ++k) dst[n][k] = *(const PG8_LAS bf16x8*)(lds + PG8_SB(b, h) + boff + n * 2048 + k * 1024); } while (0)
#define PG8_MMA(ai, bj, At, Bt) do { __builtin_amdgcn_s_setprio(1); _Pragma("unroll") for (int m = 0; m < 4; ++m) _Pragma("unroll") for (int n = 0; n < 2; ++n) _Pragma("unroll") for (int k = 0; k < 2; ++k) \
        acc[ai][bj][m][n] = __builtin_amdgcn_mfma_f32_16x16x32_bf16(Bt[n][k], At[m][k], acc[ai][bj][m][n], 0, 0, 0); __builtin_amdgcn_s_setprio(0); } while (0)
#define PG8_WAIT_V(n) asm volatile("s_waitcnt vmcnt(" #n ")" ::: "memory")
#define PG8_WAIT_L(n) asm volatile("s_waitcnt lgkmcnt(" #n ")" ::: "memory")
#define PG8_BAR __builtin_amdgcn_s_barrier()
#define PG8_SCHED __builtin_amdgcn_sched_barrier(0)
#ifdef PROBE_G
#endif
    Unit cur, nxt; int ui = 0;
    if (!S.next(0, cur)) return;
    cur.ui = 0;
    f32x4 acc[2][2][4][2];
#pragma unroll
    for (int a = 0; a < 2; ++a)
#pragma unroll
        for (int b = 0; b < 2; ++b)
#pragma unroll
            for (int m = 0; m < 4; ++m)
#pragma unroll
                for (int n = 0; n < 2; ++n) acc[a][b][m][n] = (f32x4){0.f, 0.f, 0.f, 0.f};
    bf16x8 At[4][2], B0[2][2], B1[2][2];
    const char* cA = (const char*)g.A + (size_t)cur.pm * tstep; const char* cB = (const char*)g.Bt + (size_t)cur.pn * tstep;
    S.a_ready(cur);
    if constexpr (SP2) {
        PG8_STAGE(PG8_SB(0, 0), cB, voffB); PG8_STAGE(PG8_SB(0, 1), cB + hstep, voffB); PG8_STAGE(PG8_SA(0, 0), cA, voffA); PG8_STAGE(PG8_SA(0, 1), cA + hstep, voffA);
        if (wr == 1) PG8_BAR;
        PG8_WAIT_V(2); PG8_BAR;
        PG8_STAGE(PG8_SB(1, 0), cB + kstep, voffB); PG8_STAGE(PG8_SA(1, 0), cA + kstep, voffA); PG8_STAGE(PG8_SB(1, 1), cB + hstep + kstep, voffB);
        PG8_WAIT_V(6); PG8_BAR;
    } else {
        PG8_STAGE(PG8_SB(0, 0), cB, voffB); PG8_STAGE(PG8_SA(0, 0), cA, voffA); PG8_STAGE(PG8_SB(0, 1), cB + hstep, voffB); PG8_STAGE(PG8_SA(0, 1), cA + hstep, voffA);
        if (wr == 1) PG8_BAR;
        PG8_WAIT_V(4); PG8_BAR;
        PG8_STAGE(PG8_SB(1, 0), cB + kstep, voffB); PG8_STAGE(PG8_SA(1, 0), cA + kstep, voffA); PG8_STAGE(PG8_SB(1, 1), cB + hstep + kstep, voffB);
        PG8_WAIT_V(6); PG8_BAR;
    }
    for (;;) {
        const bool has_next = S.next(ui + 1, nxt); nxt.ui = ui + 1;
        const char* nA = has_next ? (const char*)g.A + (size_t)nxt.pm * tstep : cA; const char* nB = has_next ? (const char*)g.Bt + (size_t)nxt.pn * tstep : cB;
        for (int t = 0; t < nt; t += 2) {
            if constexpr (Epi::KSCALE) { if (t == 0) E.kbegin(cur, tid); else if ((t & 7) == 0) E.krescale(acc, cur, t >> 3, wr, fr); }
            const bool last = (t == nt - 2);
            const char* a1 = cA + (size_t)(t + 1) * kstep;
            const char* a2 = last ? nA : cA + (size_t)(t + 2) * kstep; const char* b2 = last ? nB : cB + (size_t)(t + 2) * kstep;
            const char* a3 = a2 + kstep; const char* b3 = b2 + kstep;
            if (last && has_next) S.a_ready(nxt);
            if constexpr (SP2) {
            PG8_LDB(B0, 0, 0); PG8_LDB(B1, 0, 1); PG8_SCHED; PG8_LDA(At, 0, 0); PG8_STAGE(PG8_SA(1, 1), a1 + hstep, voffA);
            PG8_WAIT_V(8); PG8_WAIT_L(0); PG8_BAR; PG8_MMA(0, 0, At, B0); PG8_MMA(0, 1, At, B1); PG8_BAR; PG8_SCHED;
            PG8_LDA(At, 0, 1); PG8_STAGE(PG8_SB(0, 0), b2, voffB); PG8_STAGE(PG8_SB(0, 1), b2 + hstep, voffB); PG8_STAGE(PG8_SA(0, 0), a2, voffA);
            PG8_WAIT_V(8); PG8_WAIT_L(0); PG8_BAR; PG8_MMA(1, 0, At, B0); PG8_MMA(1, 1, At, B1); PG8_BAR; PG8_SCHED;
            PG8_LDB(B0, 1, 0); PG8_LDB(B1, 1, 1); PG8_SCHED; PG8_LDA(At, 1, 0); PG8_STAGE(PG8_SA(0, 1), a2 + hstep, voffA);
            PG8_WAIT_V(8); PG8_WAIT_L(0); PG8_BAR; PG8_MMA(0, 0, At, B0); PG8_MMA(0, 1, At, B1); PG8_BAR; PG8_SCHED;
            PG8_LDA(At, 1, 1); PG8_STAGE(PG8_SB(1, 0), b3, voffB); PG8_STAGE(PG8_SB(1, 1), b3 + hstep, voffB); PG8_STAGE(PG8_SA(1, 0), a3, voffA);
            PG8_WAIT_V(8); PG8_WAIT_L(0); PG8_BAR; PG8_MMA(1, 0, At, B0); PG8_MMA(1, 1, At, B1); PG8_BAR; PG8_SCHED;
            } else {
            PG8_LDB(B0, 0, 0); PG8_SCHED; PG8_LDA(At, 0, 0); PG8_STAGE(PG8_SA(1, 1), a1 + hstep, voffA);
            PG8_WAIT_L(8); PG8_BAR; PG8_WAIT_L(0); PG8_MMA(0, 0, At, B0); PG8_BAR; PG8_SCHED;
            PG8_LDB(B1, 0, 1); PG8_STAGE(PG8_SB(0, 0), b2, voffB);
            PG8_BAR; PG8_WAIT_L(0); PG8_MMA(0, 1, At, B1); PG8_BAR;
            PG8_LDA(At, 0, 1); PG8_STAGE(PG8_SA(0, 0), a2, voffA);
            PG8_BAR; PG8_WAIT_L(0); PG8_MMA(1, 0, At, B0); PG8_BAR; PG8_SCHED;
            PG8_STAGE(PG8_SB(0, 1), b2 + hstep, voffB);
            PG8_WAIT_V(6); PG8_BAR; PG8_MMA(1, 1, At, B1); PG8_BAR;
            PG8_LDB(B0, 1, 0); PG8_SCHED; PG8_LDA(At, 1, 0); PG8_STAGE(PG8_SA(0, 1), a2 + hstep, voffA);
            PG8_WAIT_L(8); PG8_BAR; PG8_WAIT_L(0); PG8_MMA(0, 0, At, B0); PG8_BAR; PG8_SCHED;
            PG8_LDB(B1, 1, 1); PG8_STAGE(PG8_SB(1, 0), b3, voffB);
            PG8_BAR; PG8_WAIT_L(0); PG8_MMA(0, 1, At, B1); PG8_BAR;
            PG8_LDA(At, 1, 1); PG8_STAGE(PG8_SA(1, 0), a3, voffA);
            PG8_BAR; PG8_WAIT_L(0); PG8_MMA(1, 0, At, B0); PG8_BAR; PG8_SCHED;
            PG8_STAGE(PG8_SB(1, 1), b3 + hstep, voffB);
            PG8_WAIT_V(6); PG8_BAR; PG8_MMA(1, 1, At, B1); PG8_BAR;
            }
        }
        if constexpr (ALIGN_EPI) { if (wr == 0) PG8_BAR; }
#ifdef PROBE_G
        const long long te0_ = __builtin_amdgcn_s_memrealtime();
#endif
        if constexpr (!Epi::AFTER_DRAIN) { E(acc, cur, wr, wc, fr, fq); S.done(cur); }
#ifdef PROBE_G
        if (Epi::PROBE_ID == PROBE_G) { const long long now_ = __builtin_amdgcn_s_memrealtime(), tgt_ = now_ + PROBE_GK * (now_ - te0_);
            while ((long long)__builtin_amdgcn_s_memrealtime() < tgt_) __builtin_amdgcn_s_sleep(4); }
#endif
        if (!has_next) break;
#pragma unroll
        for (int a = 0; a < 2; ++a)
#pragma unroll
            for (int b = 0; b < 2; ++b)
#pragma unroll
                for (int m = 0; m < 4; ++m)
#pragma unroll
                    for (int n = 0; n < 2; ++n) acc[a][b][m][n] = (f32x4){0.f, 0.f, 0.f, 0.f};
        cur = nxt; cA = nA; cB = nB; ++ui;
        if constexpr (ALIGN_EPI) { if (wr == 1) PG8_BAR; }
    }
    PG8_WAIT_V(0);
    if constexpr (!ALIGN_EPI) { if (wr == 0) PG8_BAR; }
    PG8_BAR;
    if constexpr (Epi::AFTER_DRAIN) { E.fused(acc, cur, wr, wc, fr, fq, lds, wid, lane); S.done(cur); }
#ifdef PROBE_G
#endif
#undef PG8_SA
#undef PG8_SB
#undef PG8_STAGE
#undef PG8_LDA
#undef PG8_LDB
#undef PG8_MMA
#undef PG8_WAIT_V
#undef PG8_WAIT_L
#undef PG8_BAR
#undef PG8_SCHED
}
}

namespace pg8 {
typedef unsigned u32x2 __attribute__((ext_vector_type(2)));
__device__ __forceinline__ u32x4 pack8(const f32x4& v0, const f32x4& v1) {
    u32x4 w; w.x = cvt_pk_bf16(v0[0], v0[1]); w.y = cvt_pk_bf16(v0[2], v0[3]); w.z = cvt_pk_bf16(v1[0], v1[1]); w.w = cvt_pk_bf16(v1[2], v1[3]); return w;
}
struct EpiIn {
    static constexpr int PROBE_ID = 1;
    static constexpr bool PERM = true, AFTER_DRAIN = false, KSCALE = false;
    bf16_t* Z; bf16_t* XBC; float* DT; const float* rstd;
    __device__ __forceinline__ void operator()(const f32x4 (&acc)[2][2][4][2], const Unit& u, int wr, int wc, int fr, int fq) const {
        const int row0 = u.pm * BM + wr * 64 + fr, c8 = wc * 32 + 8 * fq;
        float rsv[2][4];
#pragma unroll
        for (int ai = 0; ai < 2; ++ai)
#pragma unroll
            for (int m = 0; m < 4; ++m) rsv[ai][m] = rstd[row0 + ai * HALF + m * 16];
        asm volatile("" : "+v"(rsv[0][0]), "+v"(rsv[0][1]), "+v"(rsv[0][2]), "+v"(rsv[0][3]), "+v"(rsv[1][0]), "+v"(rsv[1][1]), "+v"(rsv[1][2]), "+v"(rsv[1][3]));
#pragma unroll
        for (int ai = 0; ai < 2; ++ai)
#pragma unroll
            for (int m = 0; m < 4; ++m) {
                const int row = row0 + ai * HALF + m * 16; const float rs = 1.f / sqrtf(rsv[ai][m] * (1.f / 1024.f) + 1e-6f);
#pragma unroll
                for (int bj = 0; bj < 2; ++bj) {
                    const f32x4 v0 = acc[ai][bj][m][0] * rs, v1 = acc[ai][bj][m][1] * rs;
                    if (u.pn < 8) *(u32x4*)(Z + (size_t)row * 2048 + u.pn * 256 + bj * HALF + c8) = pack8(v0, v1);
                    else if (u.pn < 20) *(u32x4*)(XBC + (size_t)row * 3072 + (u.pn - 8) * 256 + bj * HALF + c8) = pack8(v0, v1);
                    else if (bj == 0 && wc == 0) { float* d = DT + (size_t)row * 32 + 8 * fq; *(f32x4*)d = v0; *(f32x4*)(d + 4) = v1; }
                }
            }
    }
};
struct EpiRes {
    static constexpr int PROBE_ID = 2;
    static constexpr bool PERM = true, AFTER_DRAIN = false, KSCALE = true;
    const bf16_t* baseb; float* outf; bf16_t* xb; float* ss; const float* probe; const float* gss; PG8_LAS float* gtab;
    __device__ __forceinline__ void kbegin(const Unit& u, int tid) const {
        if (!gss) return;
        tid = opaque_tid();
        const int row = tid & 255, gh = tid >> 8;
        const f32x4* gp = (const f32x4*)(gss + (size_t)(u.pm * BM + row) * 16 + gh * 8);
        const f32x4 p0 = gp[0], p1 = gp[1];
        const float v0 = ((p0[0] + p0[1]) + (p0[2] + p0[3])) * (1.f / 512.f) + 1e-6f, v1 = ((p1[0] + p1[1]) + (p1[2] + p1[3])) * (1.f / 512.f) + 1e-6f;
        PG8_LAS float* tp = gtab + (((u.ui & 1) * 4 + 2 * gh) * 256 + row) * 2;
        tp[0] = __builtin_amdgcn_sqrtf(v0); tp[1] = __builtin_amdgcn_rsqf(v0); tp[512] = __builtin_amdgcn_sqrtf(v1); tp[513] = __builtin_amdgcn_rsqf(v1);
    }
    __device__ __forceinline__ void krescale(f32x4 (&acc)[2][2][4][2], const Unit& u, int g, int wr, int fr) const {
        if (!gss) return;
        const PG8_LAS float* tp = gtab + (((u.ui & 1) * 4 + g) * 256 + wr * 64 + fr) * 2;
#pragma unroll
        for (int ai = 0; ai < 2; ++ai)
#pragma unroll
            for (int m = 0; m < 4; ++m) { const float ratio = tp[(ai * HALF + m * 16) * 2] * tp[(ai * HALF + m * 16) * 2 - 511];
#pragma unroll
                for (int bj = 0; bj < 2; ++bj)
#pragma unroll
                    for (int n = 0; n < 2; ++n) acc[ai][bj][m][n] *= ratio; }
    }
    __device__ __forceinline__ void operator()(const f32x4 (&acc)[2][2][4][2], const Unit& u, int wr, int wc, int fr, int fq) const {
        const int row0 = u.pm * BM + wr * 64 + fr, col0 = u.pn * BM + wc * 32 + 8 * fq;
        u32x4 raw[8][2];
#pragma unroll
        for (int gi = 0; gi < 8; ++gi)
#pragma unroll
            for (int bj = 0; bj < 2; ++bj) raw[gi][bj] = *(const u32x4*)(baseb + (size_t)(row0 + (gi >> 2) * HALF + (gi & 3) * 16) * 1024 + col0 + bj * HALF);
#pragma unroll
        for (int gi = 0; gi < 8; ++gi) {
            const int ai = gi >> 2, m = gi & 3;
            const size_t off = (size_t)(row0 + ai * HALF + m * 16) * 1024 + col0;
            float s = 0.f;
            const float r3 = gss ? gtab[(((u.ui & 1) * 4 + 3) * 256 + wr * 64 + fr + ai * HALF + m * 16) * 2 + 1] : 1.f;
#pragma unroll
            for (int bj = 0; bj < 2; ++bj) {
                const u32x4 w_ = raw[gi][bj];
                const f32x4 lo = {__builtin_bit_cast(float, w_.x << 16), __builtin_bit_cast(float, w_.x & 0xffff0000u), __builtin_bit_cast(float, w_.y << 16), __builtin_bit_cast(float, w_.y & 0xffff0000u)};
                const f32x4 hi = {__builtin_bit_cast(float, w_.z << 16), __builtin_bit_cast(float, w_.z & 0xffff0000u), __builtin_bit_cast(float, w_.w << 16), __builtin_bit_cast(float, w_.w & 0xffff0000u)};
                f32x4 o0 = lo + acc[ai][bj][m][0] * r3, o1 = hi + acc[ai][bj][m][1] * r3;
#ifdef PROBE_T
                if (probe && gi == 0 && bj == 0 && row0 == 0 && col0 == 0) o0[0] += 0.08f + 0.2f * probe[0];
#endif
                if (outf) { *(f32x4*)(outf + off + bj * HALF) = o0; *(f32x4*)(outf + off + bj * HALF + 4) = o1; }
                if (xb) { u32x4 w; w.x = cvt_pk_bf16(o0[0], o0[1]); w.y = cvt_pk_bf16(o0[2], o0[3]); w.z = cvt_pk_bf16(o1[0], o1[1]); w.w = cvt_pk_bf16(o1[2], o1[3]); *(u32x4*)(xb + off + bj * HALF) = w; }
                s += ((o0[0] * o0[0] + o0[1] * o0[1]) + (o0[2] * o0[2] + o0[3] * o0[3])) + ((o1[0] * o1[0] + o1[1] * o1[1]) + (o1[2] * o1[2] + o1[3] * o1[3])); }
            if (ss) { s += shfl_xor_f(s, 16); s += shfl_xor_f(s, 32); if (fq == 0) atomicAdd(ss + row0 + ai * HALF + m * 16, s);
#ifdef PROBE_ATOM
                if (fq == 0) atomicAdd((float*)((char*)ss + (480u << 20)) + row0 + ai * HALF + m * 16, s);
#endif
            }
        }
    }
};
struct EpiScale {
    static constexpr int PROBE_ID = 3;
    static constexpr bool PERM = true, AFTER_DRAIN = false, KSCALE = false;
    bf16_t* O; int ldc; const float* rstd;
    __device__ __forceinline__ void operator()(const f32x4 (&acc)[2][2][4][2], const Unit& u, int wr, int wc, int fr, int fq) const {
        const int row0 = u.pm * BM + wr * 64 + fr, c8 = u.pn * BM + wc * 32 + 8 * fq;
#pragma unroll
        for (int ai = 0; ai < 2; ++ai)
#pragma unroll
            for (int m = 0; m < 4; ++m) {
                const int row = row0 + ai * HALF + m * 16; const float rs = 1.f / sqrtf(rstd[row] * (1.f / 1024.f) + 1e-6f);
#pragma unroll
                for (int bj = 0; bj < 2; ++bj) *(u32x4*)(O + (size_t)row * ldc + bj * HALF + c8) = pack8(acc[ai][bj][m][0] * rs, acc[ai][bj][m][1] * rs);
            }
    }
};
struct EpiKVQ {
    static constexpr int PROBE_ID = 4;
    static constexpr bool PERM = true, AFTER_DRAIN = false, KSCALE = false;
    bf16_t* Kb; size_t tstride; const float* rstd; const float* kg; const float* qg; float qscale;
    __device__ __forceinline__ void operator()(const f32x4 (&acc)[2][2][4][2], const Unit& u, int wr, int wc, int fr, int fq) const {
        const int row0 = u.pm * BM + wr * 64 + fr, t = u.pn >> 2;
        bf16_t* base = Kb + (size_t)t * tstride + (u.pn & 3) * BM + 64 * wc + 8 * fq;
        f32x4 g[2][2];
        const float* gp = (t == 2) ? qg : kg; const float sc = (t == 2) ? qscale : 1.f;
#pragma unroll
        for (int bj = 0; bj < 2; ++bj)
#pragma unroll
            for (int n = 0; n < 2; ++n) g[bj][n] = (t == 1) ? (f32x4){1.f, 1.f, 1.f, 1.f} : *(const f32x4*)(gp + 32 * bj + 8 * fq + 4 * n) * sc;
        float rsv[2][4];
#pragma unroll
        for (int ai = 0; ai < 2; ++ai)
#pragma unroll
            for (int m = 0; m < 4; ++m) rsv[ai][m] = rstd[row0 + ai * HALF + m * 16];
        asm volatile("" : "+v"(rsv[0][0]), "+v"(rsv[0][1]), "+v"(rsv[0][2]), "+v"(rsv[0][3]), "+v"(rsv[1][0]), "+v"(rsv[1][1]), "+v"(rsv[1][2]), "+v"(rsv[1][3]));
#pragma unroll
        for (int ai = 0; ai < 2; ++ai)
#pragma unroll
            for (int m = 0; m < 4; ++m) {
                const int row = row0 + ai * HALF + m * 16; const float rs = 1.f / sqrtf(rsv[ai][m] * (1.f / 1024.f) + 1e-6f);
                f32x4 v[2][2]; float s = 0.f;
#pragma unroll
                for (int bj = 0; bj < 2; ++bj)
#pragma unroll
                    for (int n = 0; n < 2; ++n) { v[bj][n] = acc[ai][bj][m][n] * rs; s += (v[bj][n][0] * v[bj][n][0] + v[bj][n][1] * v[bj][n][1]) + (v[bj][n][2] * v[bj][n][2] + v[bj][n][3] * v[bj][n][3]); }
                s += shfl_xor_f(s, 16); s += shfl_xor_f(s, 32);
                const float rq = (t == 1) ? 1.f : 1.f / sqrtf(s * (1.f / 64.f) + 1e-6f);
#pragma unroll
                for (int bj = 0; bj < 2; ++bj) *(u32x4*)(base + (size_t)row * 1024 + 32 * bj) = pack8(v[bj][0] * rq * g[bj][0], v[bj][1] * rq * g[bj][1]);
            }
    }
};

struct EpiConvFFN {
    static constexpr int PROBE_ID = 5;
    static constexpr bool PERM = true, AFTER_DRAIN = false, KSCALE = false;
    bf16_t* H; bf16_t* raw; const float* ss; const float* cw; const float* cb; PG8_LAS unsigned char* xl;
    static constexpr int RP = 144, SLAB = 18 * RP, HALO_OFF = 8 * SLAB;
    __device__ __forceinline__ void operator()(const f32x4 (&acc)[2][2][4][2], const Unit& u, int wr, int wc, int fr, int fq) const {
        const int lane = opaque_tid() & 63  , c = lane & 31, hf = lane >> 5, c2 = lane & 15, hq = lane >> 4, wid = wr * 4 + wc;
        PG8_LAS unsigned char* slab = xl + wid * SLAB;
        PG8_LAS unsigned char* halo = xl + HALO_OFF;
        const int chg = 128 * u.pn + 32 * wc + 2 * c2;
        typedef float f32x2v __attribute__((ext_vector_type(2)));
        const f32x2v wg0 = *(const f32x2v*)(cw + chg), wg1 = *(const f32x2v*)(cw + 5632 + chg), wg2 = *(const f32x2v*)(cw + 2 * 5632 + chg), bg = *(const f32x2v*)(cb + chg);
        const f32x2v wu0 = *(const f32x2v*)(cw + 2816 + chg), wu1 = *(const f32x2v*)(cw + 5632 + 2816 + chg), wu2 = *(const f32x2v*)(cw + 2 * 5632 + 2816 + chg), bu = *(const f32x2v*)(cb + 2816 + chg);
        const int row0 = u.pm * BM + wr * 64 + fr;
        float rsv[2][4];
#pragma unroll
        for (int ai = 0; ai < 2; ++ai)
#pragma unroll
            for (int m = 0; m < 4; ++m) rsv[ai][m] = ss[row0 + ai * HALF + m * 16];
#pragma unroll
        for (int ai = 0; ai < 2; ++ai)
#pragma unroll
            for (int m = 0; m < 4; ++m) rsv[ai][m] = 1.f / sqrtf(rsv[ai][m] * (1.f / 1024.f) + 1e-6f);
        bf16_t* rawp = raw + ((size_t)u.pm * 4 * 22 + u.pn) * 256 + wc * 64 + 8 * fq;
#pragma unroll
        for (int ai = 0; ai < 2; ++ai) {
            if (fr >= 14) {
                const float rs = rsv[ai][3];
                const int bi = 2 * ai + wr;
#pragma unroll
                for (int bj = 0; bj < 2; ++bj) { u32x4 w; { const f32x4 v0 = acc[ai][bj][3][0] * rs, v1 = acc[ai][bj][3][1] * rs; w.x = cvt_pk_bf16(v0[0], v0[1]); w.y = cvt_pk_bf16(v0[2], v0[3]); w.z = cvt_pk_bf16(v1[0], v1[1]); w.w = cvt_pk_bf16(v1[2], v1[3]); }
                        if (bi < 3) *(PG8_LAS u32x4*)(halo + ((bi * 2 + (fr - 14)) * 256 + wc * 64 + bj * 32 + 8 * fq) * 2) = w;
                        else *(u32x4*)(rawp + (size_t)(2 + fr - 14) * 22 * 256 + bj * 32) = w; }
            }
        }
        if (wr == 0 && fr < 2) {
            const float rs = rsv[0][0];
#pragma unroll
            for (int bj = 0; bj < 2; ++bj) { u32x4 w; { const f32x4 v0 = acc[0][bj][0][0] * rs, v1 = acc[0][bj][0][1] * rs; w.x = cvt_pk_bf16(v0[0], v0[1]); w.y = cvt_pk_bf16(v0[2], v0[3]); w.z = cvt_pk_bf16(v1[0], v1[1]); w.w = cvt_pk_bf16(v1[2], v1[3]); }
                    *(u32x4*)(rawp + (size_t)fr * 22 * 256 + bj * 32) = w; }
        }
        asm volatile("s_waitcnt lgkmcnt(0)" ::: "memory"); __builtin_amdgcn_s_barrier(); asm volatile("" ::: "memory");
#pragma unroll
        for (int ai = 0; ai < 2; ++ai) {
            const int bi = 2 * ai + wr;
            { unsigned hv = 0u; if (bi > 0) hv = *(const PG8_LAS unsigned*)(halo + (((bi - 1) * 2 + hf) * 256 + wc * 64 + 2 * c) * 2);
              *(PG8_LAS unsigned*)(slab + hf * RP + 4 * c) = hv; }
#pragma unroll
            for (int m = 0; m < 4; ++m) {
                const float rs = rsv[ai][m];
#pragma unroll
                for (int bj = 0; bj < 2; ++bj) { u32x4 w; { const f32x4 v0 = acc[ai][bj][m][0] * rs, v1 = acc[ai][bj][m][1] * rs; w.x = cvt_pk_bf16(v0[0], v0[1]); w.y = cvt_pk_bf16(v0[2], v0[3]); w.z = cvt_pk_bf16(v1[0], v1[1]); w.w = cvt_pk_bf16(v1[2], v1[3]); }
                        *(PG8_LAS u32x4*)(slab + (2 + fr) * RP + (bj * 32 + 8 * fq) * 2) = w; }
                asm volatile("" ::: "memory");
                unsigned gw[6], uw[6];
#pragma unroll
                for (int i = 0; i < 6; ++i) { const PG8_LAS unsigned char* rp = slab + (4 * hq + i) * RP + 4 * c2; gw[i] = *(const PG8_LAS unsigned*)rp; uw[i] = *(const PG8_LAS unsigned*)(rp + 64); }
                asm volatile("" ::: "memory");
                if (hq == 3) {
#pragma unroll
                    for (int i = 0; i < 2; ++i) { *(PG8_LAS unsigned*)(slab + i * RP + 4 * c2) = gw[4 + i]; *(PG8_LAS unsigned*)(slab + i * RP + 64 + 4 * c2) = uw[4 + i]; }
                }
                float nl2_ = -1.4426950408889634f; asm volatile("" : "+v"(nl2_)); const f32x2v NL2 = {nl2_, nl2_};
#define CF_PAIR(w_) ((f32x2v){__builtin_bit_cast(float, (w_) << 16), __builtin_bit_cast(float, (w_) & 0xffff0000u)})
                f32x2v xg[6], xu[6];
#pragma unroll
                for (int i = 0; i < 6; ++i) { xg[i] = CF_PAIR(gw[i]); xu[i] = CF_PAIR(uw[i]); }
#pragma unroll
                for (int i = 0; i < 4; ++i) {
                    const f32x2v cg = bg + wg0 * xg[i] + wg1 * xg[i + 1] + wg2 * xg[i + 2];
                    const f32x2v cu = bu + wu0 * xu[i] + wu1 * xu[i + 1] + wu2 * xu[i + 2];
                    const f32x2v ea = cg * NL2;
                    const f32x2v den = (f32x2v){__builtin_amdgcn_exp2f(ea.x), __builtin_amdgcn_exp2f(ea.y)} + (f32x2v){1.f, 1.f};
                    const f32x2v hv = cg * (f32x2v){__builtin_amdgcn_rcpf(den.x), __builtin_amdgcn_rcpf(den.y)} * cu;
                    *(PG8_LAS unsigned*)(slab + (2 + 4 * hq + i) * RP + 4 * c2) = cvt_pk_bf16(hv.x, hv.y);
                }
#undef CF_PAIR
                asm volatile("" ::: "memory");
                { const int row = lane >> 2, c8 = (lane & 3) * 8;
                  const u32x4 w = *(const PG8_LAS u32x4*)(slab + (2 + row) * RP + c8 * 2);
                  *(u32x4*)(H + (size_t)(u.pm * BM + 64 * bi + 16 * m + row) * 2816 + 128 * u.pn + 32 * wc + c8) = w; }
                asm volatile("" ::: "memory");
            }
        }
    }
};

struct EpiInConv {
    static constexpr int PROBE_ID = 1;
    static constexpr bool PERM = true, AFTER_DRAIN = false, KSCALE = false;
    bf16_t* Z; bf16_t* XBC; float* DT; const float* ss; bf16_t* raw; const float* cw; const float* cb; PG8_LAS unsigned char* xl;
    static constexpr int RP = 144, SLAB = 19 * RP, HALO_OFF = 8 * SLAB;
    __device__ __forceinline__ void operator()(const f32x4 (&acc)[2][2][4][2], const Unit& u, int wr, int wc, int fr, int fq) const {
        const int row0 = u.pm * BM + wr * 64 + fr;
        float rsv[2][4];
#pragma unroll
        for (int ai = 0; ai < 2; ++ai)
#pragma unroll
            for (int m = 0; m < 4; ++m) rsv[ai][m] = ss[row0 + ai * HALF + m * 16];
        asm volatile("" : "+v"(rsv[0][0]), "+v"(rsv[0][1]), "+v"(rsv[0][2]), "+v"(rsv[0][3]), "+v"(rsv[1][0]), "+v"(rsv[1][1]), "+v"(rsv[1][2]), "+v"(rsv[1][3]));
#pragma unroll
        for (int ai = 0; ai < 2; ++ai)
#pragma unroll
            for (int m = 0; m < 4; ++m) rsv[ai][m] = 1.f / sqrtf(rsv[ai][m] * (1.f / 1024.f) + 1e-6f);
        if (u.pn < 8) {
#pragma unroll
            for (int ai = 0; ai < 2; ++ai)
#pragma unroll
                for (int m = 0; m < 4; ++m) { bf16_t* zp = Z + (size_t)(row0 + ai * HALF + m * 16) * 2048 + u.pn * 256 + wc * 32 + 8 * fq; const float rs = rsv[ai][m];
#pragma unroll
                    for (int bj = 0; bj < 2; ++bj) { u32x4 w; { const f32x4 v0 = acc[ai][bj][m][0] * rs, v1 = acc[ai][bj][m][1] * rs; w.x = cvt_pk_bf16(v0[0], v0[1]); w.y = cvt_pk_bf16(v0[2], v0[3]); w.z = cvt_pk_bf16(v1[0], v1[1]); w.w = cvt_pk_bf16(v1[2], v1[3]); } *(u32x4*)(zp + bj * HALF) = w; } }
            return;
        }
        if (u.pn == 20) {
            if (wc == 0) {
#pragma unroll
                for (int ai = 0; ai < 2; ++ai)
#pragma unroll
                    for (int m = 0; m < 4; ++m)
#pragma unroll
                        for (int n = 0; n < 2; ++n) *(f32x4*)(DT + (size_t)(row0 + ai * HALF + m * 16) * 32 + 8 * fq + 4 * n) = acc[ai][0][m][n] * rsv[ai][m];
            }
            return;
        }
        const int up = u.pn - 8, lane = opaque_tid() & 63  , c = lane & 31, c2 = lane & 15, hq = lane >> 4, wid = wr * 4 + wc;
        PG8_LAS unsigned char* slab = xl + wid * SLAB;
        PG8_LAS unsigned char* halo = xl + HALO_OFF;
        typedef float f32x2v __attribute__((ext_vector_type(2)));
        const int colA = up * 256 + 32 * wc + 2 * c2, colB = colA + 128;
        f32x2v wA[4], wB[4];
#pragma unroll
        for (int k = 0; k < 4; ++k) { wA[k] = *(const f32x2v*)(cw + k * 3072 + colA); wB[k] = *(const f32x2v*)(cw + k * 3072 + colB); }
        const f32x2v bA = *(const f32x2v*)(cb + colA), bB = *(const f32x2v*)(cb + colB);
        bf16_t* rawp = raw + ((size_t)u.pm * 6 * 12 + up) * 256 + wc * 64 + 8 * fq;
#pragma unroll
        for (int ai = 0; ai < 2; ++ai) {
            if (fr >= 13) {
                const float rs = rsv[ai][3]; const int bi = 2 * ai + wr;
#pragma unroll
                for (int bj = 0; bj < 2; ++bj) { u32x4 w; { const f32x4 v0 = acc[ai][bj][3][0] * rs, v1 = acc[ai][bj][3][1] * rs; w.x = cvt_pk_bf16(v0[0], v0[1]); w.y = cvt_pk_bf16(v0[2], v0[3]); w.z = cvt_pk_bf16(v1[0], v1[1]); w.w = cvt_pk_bf16(v1[2], v1[3]); }
                        if (bi < 3) *(PG8_LAS u32x4*)(halo + ((bi * 3 + (fr - 13)) * 256 + wc * 64 + bj * 32 + 8 * fq) * 2) = w;
                        else *(u32x4*)(rawp + (size_t)(3 + fr - 13) * 12 * 256 + bj * 32) = w; }
            }
        }
        if (wr == 0 && fr < 3) {
            const float rs = rsv[0][0];
#pragma unroll
            for (int bj = 0; bj < 2; ++bj) { u32x4 w; { const f32x4 v0 = acc[0][bj][0][0] * rs, v1 = acc[0][bj][0][1] * rs; w.x = cvt_pk_bf16(v0[0], v0[1]); w.y = cvt_pk_bf16(v0[2], v0[3]); w.z = cvt_pk_bf16(v1[0], v1[1]); w.w = cvt_pk_bf16(v1[2], v1[3]); }
                    *(u32x4*)(rawp + (size_t)fr * 12 * 256 + bj * 32) = w; }
        }
        asm volatile("s_waitcnt lgkmcnt(0)" ::: "memory"); __builtin_amdgcn_s_barrier(); asm volatile("" ::: "memory");
#define CF_LO(w_) __builtin_bit_cast(float, (w_) << 16)
#define CF_HI(w_) __builtin_bit_cast(float, (w_) & 0xffff0000u)
#pragma unroll
        for (int ai = 0; ai < 2; ++ai) {
            const int bi = 2 * ai + wr;
            { unsigned h0 = 0u, h1 = 0u;
              if (bi > 0) { h0 = *(const PG8_LAS unsigned*)(halo + (((bi - 1) * 3 + (lane >> 5)) * 256 + wc * 64 + 2 * c) * 2); if (lane < 32) h1 = *(const PG8_LAS unsigned*)(halo + (((bi - 1) * 3 + 2) * 256 + wc * 64 + 2 * c) * 2); }
              *(PG8_LAS unsigned*)(slab + (lane >> 5) * RP + 4 * c) = h0; if (lane < 32) *(PG8_LAS unsigned*)(slab + 2 * RP + 4 * c) = h1; }
#pragma unroll
            for (int m = 0; m < 4; ++m) {
                const float rs = rsv[ai][m];
#pragma unroll
                for (int bj = 0; bj < 2; ++bj) { u32x4 w; { const f32x4 v0 = acc[ai][bj][m][0] * rs, v1 = acc[ai][bj][m][1] * rs; w.x = cvt_pk_bf16(v0[0], v0[1]); w.y = cvt_pk_bf16(v0[2], v0[3]); w.z = cvt_pk_bf16(v1[0], v1[1]); w.w = cvt_pk_bf16(v1[2], v1[3]); }
                        *(PG8_LAS u32x4*)(slab + (3 + fr) * RP + (bj * 32 + 8 * fq) * 2) = w; }
                asm volatile("" ::: "memory");
                unsigned aw[7], bw[7];
#pragma unroll
                for (int i = 0; i < 7; ++i) { const PG8_LAS unsigned char* rp = slab + (4 * hq + i) * RP + 4 * c2; aw[i] = *(const PG8_LAS unsigned*)rp; bw[i] = *(const PG8_LAS unsigned*)(rp + 64); }
                asm volatile("" ::: "memory");
                if (hq == 3) {
#pragma unroll
                    for (int i = 0; i < 3; ++i) { *(PG8_LAS unsigned*)(slab + i * RP + 4 * c2) = aw[4 + i]; *(PG8_LAS unsigned*)(slab + i * RP + 64 + 4 * c2) = bw[4 + i]; }
                }
                float nl2_ = -1.4426950408889634f; asm volatile("" : "+v"(nl2_)); const f32x2v NL2 = {nl2_, nl2_};
#define CF_PAIR(w_) ((f32x2v){__builtin_bit_cast(float, (w_) << 16), __builtin_bit_cast(float, (w_) & 0xffff0000u)})
                f32x2v xa[7], xb2[7];
#pragma unroll
                for (int i = 0; i < 7; ++i) { xa[i] = CF_PAIR(aw[i]); xb2[i] = CF_PAIR(bw[i]); }
#pragma unroll
                for (int i = 0; i < 4; ++i) {
                    const f32x2v av = bA + wA[0] * xa[i] + wA[1] * xa[i + 1] + wA[2] * xa[i + 2] + wA[3] * xa[i + 3];
                    const f32x2v bv = bB + wB[0] * xb2[i] + wB[1] * xb2[i + 1] + wB[2] * xb2[i + 2] + wB[3] * xb2[i + 3];
                    const f32x2v ea = av * NL2, eb = bv * NL2;
                    const f32x2v da = (f32x2v){__builtin_amdgcn_exp2f(ea.x), __builtin_amdgcn_exp2f(ea.y)} + (f32x2v){1.f, 1.f}, db = (f32x2v){__builtin_amdgcn_exp2f(eb.x), __builtin_amdgcn_exp2f(eb.y)} + (f32x2v){1.f, 1.f};
                    const f32x2v sa = av * (f32x2v){__builtin_amdgcn_rcpf(da.x), __builtin_amdgcn_rcpf(da.y)}, sb = bv * (f32x2v){__builtin_amdgcn_rcpf(db.x), __builtin_amdgcn_rcpf(db.y)};
                    *(PG8_LAS unsigned*)(slab + (3 + 4 * hq + i) * RP + 4 * c2) = cvt_pk_bf16(sa.x, sa.y);
                    *(PG8_LAS unsigned*)(slab + (3 + 4 * hq + i) * RP + 64 + 4 * c2) = cvt_pk_bf16(sb.x, sb.y);
                }
#undef CF_PAIR
                asm volatile("" ::: "memory");
                { const int row = lane >> 2, q = lane & 3;
                  const u32x4 w0 = *(const PG8_LAS u32x4*)(slab + (3 + row) * RP + 32 * q), w1 = *(const PG8_LAS u32x4*)(slab + (3 + row) * RP + 32 * q + 16);
                  bf16_t* op = XBC + (size_t)(u.pm * BM + 64 * bi + 16 * m + row) * 3072 + up * 256 + (q >> 1) * 128 + 32 * wc + 16 * (q & 1);
                  *(u32x4*)op = w0; *(u32x4*)(op + 8) = w1; }
                asm volatile("" ::: "memory");
            }
        }
#undef CF_LO
#undef CF_HI
    }
};
}

constexpr int NWAVES = 8;
constexpr int NBATCH = 16, SEQ = 2048, M_TOK = NBATCH * SEQ, DM = 1024;
constexpr int DIN = 2048, NXBC = 3072, NIN = 5152, NINP = 5376, SSM_H = 32;
constexpr int FF = 2816, FF2 = 5632, MH = M_TOK / 2;
constexpr float EPS = 1e-6f, LOG2E = 1.4426950408889634f;
constexpr float LAM_INIT = 0.35550906759096926f;
constexpr float QSCALE = 0.125f * 1.4426950408889634f;

constexpr size_t MiB = 1u << 20;
constexpr size_t WS_CTL = 0, CTL_ZERO_BYTES = 1 * MiB;
constexpr size_t WS_WIN = 1 * MiB, WS_WOUT = 12 * MiB, WS_WUP0 = 16 * MiB, WS_WUP1 = 27 * MiB, WS_WDN0 = 38 * MiB, WS_WDN1 = 44 * MiB,
                 WS_WKVQ = 50 * MiB, WS_WAO = 56 * MiB, WS_RSTD = 58 * MiB, WS_DT = 59 * MiB;
constexpr size_t WS_XB = 64 * MiB;
constexpr size_t WS_R = 128 * MiB;
constexpr size_t WS_Z = WS_R, WS_XBC = WS_R + 128 * MiB, WS_XRAW = WS_R + 320 * MiB;
constexpr size_t WS_U = WS_R, WS_H = WS_R, WS_FRAW = WS_R + 176 * MiB;
constexpr size_t WS_K = WS_R, WS_V = WS_R + 64 * MiB, WS_Q = WS_R + 128 * MiB, WS_O = WS_R + 192 * MiB;
constexpr size_t WS_GSS = WS_R + 340 * MiB;
constexpr size_t WS_END = 512 * MiB;
constexpr int CW_BAR = 4096;
constexpr size_t WS_SS1 = 256 * 1024, WS_SS2 = 384 * 1024, WS_SS3 = 512 * 1024;

constexpr int RING_BYTES = 131072;
constexpr int LDS_BYTES = 163840;
constexpr int LDSCTL_OFF = LDS_BYTES - 1024, MISC_OFF = LDSCTL_OFF + 320;

#define GAS __attribute__((address_space(1)))
#define LAS __attribute__((address_space(3)))
typedef unsigned short bf16;
typedef unsigned v4u __attribute__((ext_vector_type(4)));
typedef float f32x4 __attribute__((ext_vector_type(4)));
typedef short bf16x8 __attribute__((ext_vector_type(8)));
typedef GAS unsigned gu32;
typedef GAS unsigned long long gu64;
#define RLX_AGENT __ATOMIC_RELAXED, __HIP_MEMORY_SCOPE_AGENT
#define LDS_WAIT() asm volatile("s_waitcnt lgkmcnt(0)" ::: "memory")
#define VM_WAIT() asm volatile("s_waitcnt vmcnt(0)" ::: "memory")
__device__ __forceinline__ unsigned long long rt() { return __builtin_amdgcn_s_memrealtime(); }
typedef float f32x2_cv __attribute__((ext_vector_type(2))); typedef __bf16 bf16x2_cv __attribute__((ext_vector_type(2)));
__device__ __forceinline__ unsigned pk2(float lo, float hi) { f32x2_cv v = {lo, hi}; bf16x2_cv b = __builtin_convertvector(v, bf16x2_cv); return __builtin_bit_cast(unsigned, b); }
__device__ __forceinline__ unsigned f2bf(float f) { return pk2(f, f) & 0xffffu; }
#define XB_TMO      128
#define XB_XCNT(j)  (256  + 64 * (j))
#define XB_XSUB(j)  (1280 + 64 * (j))
#define XB_XGEN(j)  (2304 + 64 * (j))
#define XB_TOP      3328
#define XB_TOPGEN   3392
#define XCD_BAR_WORDS 3456
#define XB_SPIN_CAP (1u << 18)

__device__ __forceinline__ unsigned xb_ld(unsigned* p)              { return __hip_atomic_load(p, __ATOMIC_RELAXED, __HIP_MEMORY_SCOPE_AGENT); }
__device__ __forceinline__ unsigned xb_add(unsigned* p, unsigned v) { return __hip_atomic_fetch_add(p, v, __ATOMIC_RELAXED, __HIP_MEMORY_SCOPE_AGENT); }
__device__ __forceinline__ unsigned xb_xcc_id() { return (unsigned)__builtin_amdgcn_s_getreg((3 << 11) | 20) & 0xFu; }
#define XB_SPIN(cond, bar) do { unsigned _sp = 0; while (cond) { __builtin_amdgcn_s_sleep(1); \
    if ((++_sp & 255u) == 0u) { if (xb_ld(&(bar)[XB_TMO])) break; if (_sp > XB_SPIN_CAP) { atomicAdd(&(bar)[XB_TMO], 1u); break; } } } } while (0)

struct XcdBarrier {
    unsigned* bar; unsigned x;
    volatile LAS unsigned* st;
};

__device__ __forceinline__ XcdBarrier xcd_barrier_post(unsigned* bar, volatile LAS unsigned* st) {
    XcdBarrier b; b.bar = bar; b.x = xb_xcc_id(); b.st = st;
    if (threadIdx.x == 0) (void)xb_add(&bar[XB_XCNT(b.x)], 1u);
    return b;
}
__device__ __forceinline__ void xcd_barrier_complete(unsigned* bar, unsigned x, unsigned& nloc, unsigned& nx) {
    const unsigned G = gridDim.x * gridDim.y * gridDim.z;
    unsigned sum, cnt, mine, sp = 0u;
    for (;;) {
        sum = 0u; cnt = 0u; mine = 0u;
#pragma unroll
        for (unsigned j = 0; j < 16; ++j) { const unsigned c = xb_ld(&bar[XB_XCNT(j)]); sum += c; cnt += (c > 0u) ? 1u : 0u; mine = (j == x) ? c : mine; }
        if (sum == G) break;
        __builtin_amdgcn_s_sleep(1);
        if ((++sp & 255u) == 0u) { if (xb_ld(&bar[XB_TMO])) break; if (sp > XB_SPIN_CAP) { atomicAdd(&bar[XB_TMO], 1u); break; } }
    }
    nloc = mine > 0u ? mine : 1u; nx = cnt > 0u ? cnt : 1u;
}

__device__ __forceinline__ void xcd_barrier(const XcdBarrier& b) {
    asm volatile("s_waitcnt vmcnt(0)" ::: "memory");
    __syncthreads();
    if (threadIdx.x == 0) {
        unsigned* bar = b.bar;
        __builtin_amdgcn_s_waitcnt(0);
        unsigned nloc = b.st[0], nx = b.st[1];
        if (nloc == 0u) { xcd_barrier_complete(bar, b.x, nloc, nx); b.st[0] = nloc; b.st[1] = nx; }
        const unsigned old = xb_add(&bar[XB_XSUB(b.x)], 1u);
        const unsigned gen = old / nloc;
        if (old + 1u == (gen + 1u) * nloc) {
            __builtin_amdgcn_fence(__ATOMIC_RELEASE, "agent");
            asm volatile("s_waitcnt vmcnt(0)" ::: "memory");
            const unsigned og = xb_add(&bar[XB_TOP], 1u);
            const unsigned tg = og / nx;
            if (og + 1u == (tg + 1u) * nx) xb_add(&bar[XB_TOPGEN], 1u);
            else XB_SPIN(xb_ld(&bar[XB_TOPGEN]) == tg, bar);
            __builtin_amdgcn_fence(__ATOMIC_ACQUIRE, "agent");
            xb_add(&bar[XB_XGEN(b.x)], 1u);
            asm volatile("s_waitcnt vmcnt(0)" ::: "memory");
        } else {
            XB_SPIN(xb_ld(&bar[XB_XGEN(b.x)]) == gen, bar);
            __builtin_amdgcn_fence(__ATOMIC_ACQUIRE, "agent");
            asm volatile("s_waitcnt vmcnt(0)" ::: "memory");
        }
    }
    __syncthreads();
}

struct Args { const float* in[25]; float* out; unsigned char* ws; int ph_lo, ph_hi; unsigned char prog[64]; };
template <int K> __device__ __forceinline__ const float* arg_in_() { const float* p_;
    asm volatile("s_load_dwordx2 %0, %1, %2\n\ts_waitcnt lgkmcnt(0)" : "=s"(p_) : "s"(__builtin_amdgcn_kernarg_segment_ptr()), "n"(K * 8)); return p_; }
#define ARG_IN(a_, k_) arg_in_<(k_)>()
__device__ __forceinline__ unsigned char* opaque_ws(const Args& a) { unsigned char* w = a.ws; asm volatile("" : "+s"(w)); return w; }

typedef unsigned u32x4v __attribute__((ext_vector_type(4)));
__device__ __forceinline__ float bf2f(bf16 v) { return __builtin_bit_cast(float, (unsigned)v << 16); }
__device__ __forceinline__ float wave_sum(float v) {
#pragma unroll
    for (int o = 1; o < 64; o <<= 1) v += shfl_xor_f(v, o);
    return v;
}
__device__ __forceinline__ float silu_f(float v) { return v * __builtin_amdgcn_rcpf(1.f + __builtin_amdgcn_exp2f(v * -1.4426950408889634f)); }

__device__ __forceinline__ void wprep_item(const float* W, int K, int Nsrc, int scol0, const float* gain, int gmask, float gscale,
                                           bf16* WT, int drow0, int k0, LAS float* scr, int lane) {
    float wv[32];
    asm volatile("" : "+s"(gscale));
#pragma unroll
    for (int i = 0; i < 32; ++i) { const int kk = 2 * i + (lane >> 5); wv[i] = W ? W[(size_t)(k0 + kk) * Nsrc + scol0 + (lane & 31)] : 0.f; }
#pragma unroll
    for (int i = 0; i < 32; ++i) { const int kk = 2 * i + (lane >> 5);
        const float gn = gain ? gain[(k0 + kk) & gmask] * gscale : gscale;
        scr[kk * 33 + (lane & 31)] = wv[i] * gn; }
    LDS_WAIT(); asm volatile("" ::: "memory");
    const int c = lane & 7;
#pragma unroll
    for (int j = 0; j < 4; ++j) { const int n = (lane >> 3) + 8 * j; const LAS float* s = scr + (8 * c) * 33 + n;
        v4u o; o.x = pk2(s[0 * 33], s[1 * 33]); o.y = pk2(s[2 * 33], s[3 * 33]); o.z = pk2(s[4 * 33], s[5 * 33]); o.w = pk2(s[6 * 33], s[7 * 33]);
        *(GAS v4u*)(WT + (size_t)(drow0 + n) * K + k0 + 8 * c) = o; }
    LDS_WAIT(); asm volatile("" ::: "memory");
}
__device__ __forceinline__ void rowstat_phase(const float* x, bf16* xb, float* rstd, int vcu, int NGW) {
    const int tid_ = opaque_tid(), lane = tid_ & 63, gw = vcu * NWAVES + __builtin_amdgcn_readfirstlane(tid_ >> 6);
    for (int m0 = gw * 2; m0 < M_TOK; m0 += NGW * 2) {
        f32x4 v[2][4]; float s[2];
#pragma unroll
        for (int r = 0; r < 2; ++r) { const GAS f32x4* xr = (const GAS f32x4*)(x + (size_t)(m0 + r) * DM) + lane;
#pragma unroll
            for (int j = 0; j < 4; ++j) v[r][j] = xr[64 * j]; }
#pragma unroll
        for (int r = 0; r < 2; ++r) { float t = 0.f;
#pragma unroll
            for (int j = 0; j < 4; ++j) t += (v[r][j].x * v[r][j].x + v[r][j].y * v[r][j].y) + (v[r][j].z * v[r][j].z + v[r][j].w * v[r][j].w);
            s[r] = wave_sum(t);
            GAS unsigned long long* o8 = (GAS unsigned long long*)(xb + (size_t)(m0 + r) * DM) + lane;
#pragma unroll
            for (int j = 0; j < 4; ++j) o8[64 * j] = (unsigned long long)pk2(v[r][j].x, v[r][j].y) | ((unsigned long long)pk2(v[r][j].z, v[r][j].w) << 32); }
        if (lane < 2) rstd[m0 + lane] = lane ? s[1] : s[0];
    }
}
__device__ __forceinline__ void prep_phase(const Args& a, LAS unsigned char* lds, int vcu, int NGW) {
    const int tid_ = opaque_tid(), lane = tid_ & 63, wave = __builtin_amdgcn_readfirstlane(tid_ >> 6), gw = vcu * NWAVES + wave;
    LAS float* scr = (LAS float*)(lds + wave * 16384);
    unsigned char* ws = opaque_ws(a);
    constexpr int I_IN = 16 * 168, I_OUT = 32 * 32, I_UP = 16 * 176, I_DN = 44 * 32, I_KV = 16 * 64, I_Q = 16 * 32, I_AO = 16 * 32;
    constexpr int NITEMS = I_IN + I_OUT + 2 * I_UP + 2 * I_DN + I_KV + I_Q + I_AO;
    for (int it = gw; it < NITEMS; it += NGW) {
        int r = it;
        if (r < I_IN) { const int kb = r / 168, db = r % 168;
            wprep_item(db < 161 ? ARG_IN(a, 2) : nullptr, 1024, NIN, 32 * db, ARG_IN(a, 1), 1023, 1.f, (bf16*)(ws + WS_WIN), 32 * db, 64 * kb, scr, lane); continue; } r -= I_IN;
        if (r < I_OUT) { const int kb = r / 32, db = r % 32;
            wprep_item(ARG_IN(a, 9), 2048, 1024, 32 * db, ARG_IN(a, 8), 2047, 1.f, (bf16*)(ws + WS_WOUT), 32 * db, 64 * kb, scr, lane); continue; } r -= I_OUT;
        if (r < 2 * I_UP) { const int l = r / I_UP; r -= l * I_UP; const int kb = r / 176, db = r % 176, j = db >> 3, q = db & 7;
            const int scol = (q < 4) ? (128 * j + 32 * q) : (FF + 128 * j + 32 * (q - 4));
            wprep_item(ARG_IN(a, 21) + (size_t)l * 1024 * FF2, 1024, FF2, scol, ARG_IN(a, 20) + l * 1024, 1023, 1.f, (bf16*)(ws + (l ? WS_WUP1 : WS_WUP0)), 32 * db, 64 * kb, scr, lane); continue; } r -= 2 * I_UP;
        if (r < 2 * I_DN) { const int l = r / I_DN; r -= l * I_DN; const int kb = r / 32, db = r % 32;
            wprep_item(ARG_IN(a, 24) + (size_t)l * FF * 1024, FF, 1024, 32 * db, nullptr, 0, 1.f, (bf16*)(ws + (l ? WS_WDN1 : WS_WDN0)), 32 * db, 64 * kb, scr, lane); continue; } r -= 2 * I_DN;
        if (r < I_KV) { const int kb = r / 64, db = r % 64, q = db & 7;
            wprep_item(ARG_IN(a, 11), 1024, 2048, 256 * (db >> 3) + 64 * (q & 3) + 32 * (q >> 2), ARG_IN(a, 10), 1023, 1.f, (bf16*)(ws + WS_WKVQ), 32 * db, 64 * kb, scr, lane); continue; } r -= I_KV;
        if (r < I_Q) { const int kb = r / 32, db = r % 32, q = db & 7;
            wprep_item(ARG_IN(a, 15), 1024, 1024, 256 * (db >> 3) + 64 * (q & 3) + 32 * (q >> 2), ARG_IN(a, 14), 1023, 1.f, (bf16*)(ws + WS_WKVQ), 2048 + 32 * db, 64 * kb, scr, lane); continue; } r -= I_Q;
        { const int kb = r / 32, db = r % 32;
            wprep_item(ARG_IN(a, 19), 1024, 1024, 32 * db, ARG_IN(a, 18), 127, 1.f - LAM_INIT, (bf16*)(ws + WS_WAO), 32 * db, 64 * kb, scr, lane); }
    }
    rowstat_phase(ARG_IN(a, 0), (bf16*)(ws + WS_XB), (float*)(ws + WS_RSTD), vcu, NGW);
}

__device__ __forceinline__ void ssd_naive_phase(const Args& a, LAS unsigned char* lds) {
    const int tid = opaque_tid();
    LAS float* cx = (LAS float*)lds;
    LAS float* cB = cx + 64 * 64;
    LAS float* cC = cB + 64 * 128;
    LAS float* cdA = cC + 64 * 128;
    LAS float* cdt = cdA + 64;
    const bf16* XBC = (const bf16*)(opaque_ws(a) + WS_XBC); bf16* Z = (bf16*)(opaque_ws(a) + WS_Z); const float* DT = (const float*)(opaque_ws(a) + WS_DT);
    const float* conv_w = ARG_IN(a, 3); const float* conv_b = ARG_IN(a, 4);
    const int p = tid >> 3, ns = (tid & 7) * 16;
    for (int item = blockIdx.x; item < NBATCH * SSM_H; item += gridDim.x) {
        const int b = item >> 5, h = item & 31, g = h >> 3;
        const float Aneg = -__expf(ARG_IN(a, 6)[h]), dtb = ARG_IN(a, 5)[h], Dh = ARG_IN(a, 7)[h];
        float hst[16];
#pragma unroll
        for (int i = 0; i < 16; ++i) hst[i] = 0.f;
        for (int t0 = 0; t0 < SEQ; t0 += 64) {
            for (int e = tid; e < 64 * 320; e += 512) {
                const int tt = e / 320, j = e - tt * 320;
                const int col = j < 64 ? 64 * h + j : (j < 192 ? 2048 + 128 * g + (j - 64) : 2560 + 128 * g + (j - 192));
                const int t = t0 + tt;
                float v = conv_b[col];
#pragma unroll
                for (int k = 0; k < 4; ++k) { const int ts = t - 3 + k; if (ts >= 0) v += conv_w[k * NXBC + col] * bf2f(XBC[(size_t)(b * SEQ + ts) * NXBC + col]); }
                v = silu_f(v);
                if (j < 64) cx[tt * 64 + j] = v; else if (j < 192) cB[tt * 128 + (j - 64)] = v; else cC[tt * 128 + (j - 192)] = v;
            }
            if (tid < 64) { const float raw = DT[(size_t)(b * SEQ + t0 + tid) * 32 + h] + dtb; const float dtv = raw > 20.f ? raw : log1pf(__expf(raw)); cdt[tid] = dtv; cdA[tid] = __expf(dtv * Aneg); }
            __syncthreads();
            for (int tt = 0; tt < 64; ++tt) {
                const float xv = cx[tt * 64 + p], dA = cdA[tt], xdt = xv * cdt[tt];
                float acc = 0.f;
#pragma unroll
                for (int i = 0; i < 16; ++i) { hst[i] = dA * hst[i] + xdt * cB[tt * 128 + ns + i]; acc += cC[tt * 128 + ns + i] * hst[i]; }
                acc += shfl_xor_f(acc, 1); acc += shfl_xor_f(acc, 2); acc += shfl_xor_f(acc, 4);
                if ((tid & 7) == 0) { const size_t idx = (size_t)(b * SEQ + t0 + tt) * DIN + 64 * h + p; const float z = bf2f(Z[idx]); Z[idx] = (bf16)f2bf((acc + xv * Dh) * silu_f(z)); }
            }
            __syncthreads();
        }
    }
}
__device__ __forceinline__ void unpack8(const v4u w, float (&f)[8]) {
    f[0] = __builtin_bit_cast(float, w.x << 16); f[1] = __builtin_bit_cast(float, w.x & 0xffff0000u); f[2] = __builtin_bit_cast(float, w.y << 16); f[3] = __builtin_bit_cast(float, w.y & 0xffff0000u);
    f[4] = __builtin_bit_cast(float, w.z << 16); f[5] = __builtin_bit_cast(float, w.z & 0xffff0000u); f[6] = __builtin_bit_cast(float, w.w << 16); f[7] = __builtin_bit_cast(float, w.w & 0xffff0000u);
}
__device__ __forceinline__ void groupnorm_phase(const Args& a, int vcu, int NGW) {
    const int tid_ = opaque_tid(), lane = tid_ & 63, gw = vcu * NWAVES + __builtin_amdgcn_readfirstlane(tid_ >> 6);
    bf16* Z = (bf16*)(opaque_ws(a) + WS_Z);
    for (int i = gw; i < M_TOK * 4; i += NGW) {
        GAS v4u* p = (GAS v4u*)(Z + (size_t)i * 512) + lane;
        float f[8]; unpack8(*p, f);
        float s = 0.f;
#pragma unroll
        for (int j = 0; j < 8; ++j) s += f[j] * f[j];
        s = wave_sum(s);
        const float r = 1.f / sqrtf(s * (1.f / 512.f) + EPS);
        v4u o; o.x = pk2(f[0] * r, f[1] * r); o.y = pk2(f[2] * r, f[3] * r); o.z = pk2(f[4] * r, f[5] * r); o.w = pk2(f[6] * r, f[7] * r);
        *p = o;
    }
}
__device__ __forceinline__ void convact_phase(const Args& a, int layer, int r0) {
    const bf16* U = (const bf16*)(opaque_ws(a) + WS_U); bf16* H = (bf16*)(opaque_ws(a) + WS_H);
    const float* cw = ARG_IN(a, 22) + (size_t)layer * 3 * FF2; const float* cb = ARG_IN(a, 23) + (size_t)layer * FF2;
    constexpr int NG = FF / 8, NITEMS = (MH / 32) * NG;
    const int nthr = gridDim.x * 512;
    for (int item = blockIdx.x * 512 + opaque_tid(); item < NITEMS; item += nthr) {
        const int seg = item / NG, c = (item - seg * NG) * 8, gcol = 256 * (c >> 7) + (c & 127);
        const int t1 = seg * 32, tseq = (r0 + t1) & (SEQ - 1);
        float wg[3][8], wu[3][8], bg[8], bu[8];
#pragma unroll
        for (int q = 0; q < 2; ++q) {
            const f32x4 x = *(const GAS f32x4*)(cb + c + 4 * q), y = *(const GAS f32x4*)(cb + FF + c + 4 * q);
#pragma unroll
            for (int e = 0; e < 4; ++e) { bg[4 * q + e] = x[e]; bu[4 * q + e] = y[e]; }
#pragma unroll
            for (int k = 0; k < 3; ++k) { const f32x4 xg = *(const GAS f32x4*)(cw + k * FF2 + c + 4 * q), xu = *(const GAS f32x4*)(cw + k * FF2 + FF + c + 4 * q);
#pragma unroll
                for (int e = 0; e < 4; ++e) { wg[k][4 * q + e] = xg[e]; wu[k][4 * q + e] = xu[e]; } }
        }
        const bf16* up = U + (size_t)t1 * FF2 + gcol;
        v4u g2 = {0u, 0u, 0u, 0u}, g1 = g2, u2 = g2, u1 = g2;
        if (tseq != 0) { g2 = *(const GAS v4u*)(up - 2 * (ptrdiff_t)FF2); u2 = *(const GAS v4u*)(up - 2 * (ptrdiff_t)FF2 + 128); g1 = *(const GAS v4u*)(up - (ptrdiff_t)FF2); u1 = *(const GAS v4u*)(up - (ptrdiff_t)FF2 + 128); }
        bf16* hp = H + (size_t)t1 * FF + c;
#pragma unroll 8
        for (int rr = 0; rr < 32; ++rr) {
            const v4u g0 = *(const GAS v4u*)(up + (size_t)rr * FF2), u0 = *(const GAS v4u*)(up + (size_t)rr * FF2 + 128);
            float a2[8], a1[8], a0[8], b2[8], b1[8], b0[8];
            unpack8(g2, a2); unpack8(g1, a1); unpack8(g0, a0); unpack8(u2, b2); unpack8(u1, b1); unpack8(u0, b0);
            float hv[8];
#pragma unroll
            for (int e = 0; e < 8; ++e) { const float gg = bg[e] + wg[0][e] * a2[e] + wg[1][e] * a1[e] + wg[2][e] * a0[e], uu = bu[e] + wu[0][e] * b2[e] + wu[1][e] * b1[e] + wu[2][e] * b0[e]; hv[e] = silu_f(gg) * uu; }
            *(GAS v4u*)(hp + (size_t)rr * FF) = (v4u){pk2(hv[0], hv[1]), pk2(hv[2], hv[3]), pk2(hv[4], hv[5]), pk2(hv[6], hv[7])};
            g2 = g1; g1 = g0; u2 = u1; u1 = u0;
        }
    }
}
__device__ __forceinline__ void bcconv_phase(const Args& a) {
    const bf16* XBC = (const bf16*)(opaque_ws(a) + WS_XBC); bf16* BCc = (bf16*)(opaque_ws(a) + WS_XB);
    const float* cw = ARG_IN(a, 3); const float* cb = ARG_IN(a, 4);
    constexpr int NG = 1024 / 8, NITEMS = (M_TOK / 32) * NG;
    const int nthr = gridDim.x * 512;
    for (int item = blockIdx.x * 512 + opaque_tid(); item < NITEMS; item += nthr) {
        const int seg = item / NG, c = (item - seg * NG) * 8, t1 = seg * 32, tseq = t1 & (SEQ - 1);
        float w[4][8], bb[8];
#pragma unroll
        for (int q = 0; q < 2; ++q) { const f32x4 x = *(const GAS f32x4*)(cb + 2048 + c + 4 * q);
#pragma unroll
            for (int e = 0; e < 4; ++e) bb[4 * q + e] = x[e];
#pragma unroll
            for (int k = 0; k < 4; ++k) { const f32x4 y = *(const GAS f32x4*)(cw + k * NXBC + 2048 + c + 4 * q);
#pragma unroll
                for (int e = 0; e < 4; ++e) w[k][4 * q + e] = y[e]; } }
        const bf16* sp = XBC + (size_t)t1 * NXBC + 2048 + c;
        v4u r3 = {0u, 0u, 0u, 0u}, r2 = r3, r1 = r3;
        if (tseq != 0) { r3 = *(const GAS v4u*)(sp - 3 * (ptrdiff_t)NXBC); r2 = *(const GAS v4u*)(sp - 2 * (ptrdiff_t)NXBC); r1 = *(const GAS v4u*)(sp - (ptrdiff_t)NXBC); }
        bf16* dp = BCc + (size_t)t1 * 1024 + c;
#pragma unroll 8
        for (int rr = 0; rr < 32; ++rr) {
            const v4u r0 = *(const GAS v4u*)(sp + (size_t)rr * NXBC);
            float a3[8], a2[8], a1[8], a0[8]; unpack8(r3, a3); unpack8(r2, a2); unpack8(r1, a1); unpack8(r0, a0);
            float o[8];
#pragma unroll
            for (int e = 0; e < 8; ++e) o[e] = silu_f(bb[e] + w[0][e] * a3[e] + w[1][e] * a2[e] + w[2][e] * a1[e] + w[3][e] * a0[e]);
            *(GAS v4u*)(dp + (size_t)rr * 1024) = (v4u){pk2(o[0], o[1]), pk2(o[2], o[3]), pk2(o[4], o[5]), pk2(o[6], o[7])};
            r3 = r2; r2 = r1; r1 = r0;
        }
    }
}
__device__ __forceinline__ void ssmconv_fixup_phase(const Args& a) {
    const bf16* raw = (const bf16*)(opaque_ws(a) + WS_XRAW); bf16* XBC = (bf16*)(opaque_ws(a) + WS_XBC);
    const float* cw = ARG_IN(a, 3); const float* cb = ARG_IN(a, 4);
    static_assert((M_TOK / 256) * NXBC == 3 * 256 * 512, "ssmconv_fixup_phase: three trips");
    const int e0 = blockIdx.x * 512 + opaque_tid();
    float x[3][6], w[3][5];
#pragma unroll
    for (int it = 0; it < 3; ++it) {
        const int e = e0 + it * 256 * 512, pm = e / NXBC, col = e - pm * NXBC;
        const int rc = (col >> 8) * 256 + ((col >> 5) & 3) * 64 + ((col >> 7) & 1) * 32 + (col & 31);
#pragma unroll
        for (int k = 0; k < 3; ++k) {
            x[it][k] = ((pm & 7) != 0) ? bf2f(raw[((size_t)(pm - 1) * 6 + 3 + k) * NXBC + rc]) : 0.f;
            x[it][3 + k] = bf2f(raw[((size_t)pm * 6 + k) * NXBC + rc]);
        }
#pragma unroll
        for (int k = 0; k < 4; ++k) w[it][k] = cw[k * NXBC + col];
        w[it][4] = cb[col];
    }
#pragma unroll
    for (int it = 0; it < 3; ++it) {
        const int e = e0 + it * 256 * 512, pm = e / NXBC, col = e - pm * NXBC;
#pragma unroll
        for (int r = 0; r < 3; ++r) {
            const float v = w[it][4] + w[it][0] * x[it][r] + w[it][1] * x[it][r + 1] + w[it][2] * x[it][r + 2] + w[it][3] * x[it][r + 3];
            XBC[(size_t)(pm * 256 + r) * NXBC + col] = (bf16)f2bf(silu_f(v));
        }
    }
}
__device__ __forceinline__ void convffn_fixup_phase(const Args& a, int layer) {
    const bf16* raw = (const bf16*)(opaque_ws(a) + WS_FRAW); bf16* H = (bf16*)(opaque_ws(a) + WS_H);
    const float* cw = ARG_IN(a, 22) + (size_t)layer * 3 * FF2; const float* cb = ARG_IN(a, 23) + (size_t)layer * FF2;
    const int e0 = blockIdx.x * 512 + opaque_tid();
    float g[3][4], u[3][4], wg[3][4], wu[3][4];
#pragma unroll
    for (int it = 0; it < 3; ++it) {
        const int e = e0 + it * 256 * 512; const bool ok = e < (M_TOK / 256) * FF; const int ee = ok ? e : 0, pm = ee / FF, ch = ee - pm * FF;
        const int col = (ch >> 7) * 256 + ((ch >> 5) & 3) * 64 + (ch & 31);
#pragma unroll
        for (int k = 0; k < 2; ++k) {
            if ((pm & 7) != 0) { const bf16* p = raw + ((size_t)(pm - 1) * 4 + 2 + k) * 22 * 256 + col; g[it][k] = bf2f(p[0]); u[it][k] = bf2f(p[32]); } else { g[it][k] = 0.f; u[it][k] = 0.f; }
            const bf16* q = raw + ((size_t)pm * 4 + k) * 22 * 256 + col; g[it][2 + k] = bf2f(q[0]); u[it][2 + k] = bf2f(q[32]);
        }
#pragma unroll
        for (int k = 0; k < 3; ++k) { wg[it][k] = cw[k * FF2 + ch]; wu[it][k] = cw[k * FF2 + FF + ch]; }
        wg[it][3] = cb[ch]; wu[it][3] = cb[FF + ch];
    }
#pragma unroll
    for (int it = 0; it < 3; ++it) {
        const int e = e0 + it * 256 * 512; const bool ok = e < (M_TOK / 256) * FF; const int ee = ok ? e : 0, pm = ee / FF, ch = ee - pm * FF;
#pragma unroll
        for (int r = 0; r < 2; ++r) {
            const float cg = wg[it][3] + wg[it][0] * g[it][r] + wg[it][1] * g[it][r + 1] + wg[it][2] * g[it][r + 2];
            const float cu = wu[it][3] + wu[it][0] * u[it][r] + wu[it][1] * u[it][r + 1] + wu[it][2] * u[it][r + 2];
            if (ok) H[(size_t)(pm * 256 + r) * FF + ch] = (bf16)f2bf(silu_f(cg) * cu);
        }
    }
}
__device__ __forceinline__ void qknorm_phase(const Args& a, int vcu, int NGW) {
    const int tid_ = opaque_tid(), lane = tid_ & 63, gw = vcu * NWAVES + __builtin_amdgcn_readfirstlane(tid_ >> 6);
    for (int i = gw; i < M_TOK * 2; i += NGW) {
        const int tok = i >> 1, isq = i & 1;
        bf16* base = (bf16*)(opaque_ws(a) + (isq ? WS_Q : WS_K)) + (size_t)tok * 1024 + lane * 16;
        const float* g = (isq ? ARG_IN(a, 16) : ARG_IN(a, 12)) + (lane & 3) * 16; const float sc = isq ? QSCALE : 1.f;
        const v4u w0 = *(const GAS v4u*)base, w1 = *(const GAS v4u*)(base + 8);
        const unsigned ww[8] = {w0.x, w0.y, w0.z, w0.w, w1.x, w1.y, w1.z, w1.w};
        float f[16]; float s = 0.f;
#pragma unroll
        for (int q = 0; q < 8; ++q) { f[2 * q] = __builtin_bit_cast(float, ww[q] << 16); f[2 * q + 1] = __builtin_bit_cast(float, ww[q] & 0xffff0000u); s += f[2 * q] * f[2 * q] + f[2 * q + 1] * f[2 * q + 1]; }
        s += shfl_xor_f(s, 1); s += shfl_xor_f(s, 2);
        const float r = sc / sqrtf(s * (1.f / 64.f) + EPS);
        unsigned o[8];
#pragma unroll
        for (int q = 0; q < 8; ++q) o[q] = pk2(f[2 * q] * r * g[2 * q], f[2 * q + 1] * r * g[2 * q + 1]);
        *(GAS v4u*)base = (v4u){o[0], o[1], o[2], o[3]}; *(GAS v4u*)(base + 8) = (v4u){o[4], o[5], o[6], o[7]};
    }
}
__device__ __forceinline__ int t5_bucket(int n) {
    if (n < 16) return n;
    int l = 16 + (int)(__logf((float)n / 16.f) / 2.0794415416798357f * 16.f);
    return l < 31 ? l : 31;
}
__device__ __forceinline__ void attn_naive_phase(const Args& a, LAS unsigned char* lds) {
    const int tid = opaque_tid(), lane = tid & 63;
    LAS float* Qs = (LAS float*)lds;
    LAS float* Ks = Qs + 64 * 129;
    LAS float* Vs = Ks + 64 * 129;
    LAS float* Ws = Vs + 64 * 128;
    LAS float* btab = Ws + 64 * 65;
    const bf16* Kb = (const bf16*)(opaque_ws(a) + WS_K); const bf16* Vb = (const bf16*)(opaque_ws(a) + WS_V); bf16* Qb = (bf16*)(opaque_ws(a) + WS_Q);
    const float* rel_bias = ARG_IN(a, 13); const float* lv = ARG_IN(a, 17);
    const int r = tid >> 3, ks = tid & 7;
    for (int item = blockIdx.x; item < 4096; item += gridDim.x) {
        const int qb = 31 - (item >> 7), bh = item & 127, b = bh >> 3, h = bh & 7;
        const size_t row0 = (size_t)b * SEQ + qb * 64;
        __syncthreads();
        for (int e = tid; e < 64 * 128; e += 512) { const int rr = e >> 7, c = e & 127; Qs[rr * 129 + c] = bf2f(Qb[(row0 + rr) * 1024 + h * 128 + c]); }
        if (tid < 129) { const int bk = t5_bucket(tid); btab[tid] = rel_bias[bk * 8 + h] * LOG2E; }
        if (tid < 64) { float s0 = lv[tid] * lv[64 + tid], s1 = lv[128 + tid] * lv[192 + tid]; s0 = wave_sum(s0); s1 = wave_sum(s1); if (tid == 0) btab[129] = __expf(s0) - __expf(s1) + LAM_INIT; }
        const int qpos = qb * 64 + r;
        float m0 = -1e30f, l0 = 0.f, m1 = -1e30f, l1 = 0.f;
        for (int kt = 0; kt <= qb; ++kt) {
            __syncthreads();
            for (int e = tid; e < 64 * 128; e += 512) { const int kk = e >> 7, c = e & 127; Ks[kk * 129 + c] = bf2f(Kb[((size_t)b * SEQ + kt * 64 + kk) * 1024 + h * 128 + c]); }
            __syncthreads();
            float s0[8], s1[8];
#pragma unroll
            for (int i = 0; i < 8; ++i) { s0[i] = 0.f; s1[i] = 0.f; }
            for (int d = 0; d < 64; ++d) { const float q0 = Qs[r * 129 + d], q1 = Qs[r * 129 + 64 + d];
#pragma unroll
                for (int i = 0; i < 8; ++i) { s0[i] += q0 * Ks[(ks * 8 + i) * 129 + d]; s1[i] += q1 * Ks[(ks * 8 + i) * 129 + 64 + d]; } }
#pragma unroll
            for (int i = 0; i < 8; ++i) { const int kpos = kt * 64 + ks * 8 + i;
                if (kpos <= qpos) { const int dist = qpos - kpos; const float bb = btab[dist < 128 ? dist : 128];
                    const float a0 = s0[i] + bb, a1 = s1[i] + bb;
                    float mn = fmaxf(m0, a0); l0 = l0 * exp2f(m0 - mn) + exp2f(a0 - mn); m0 = mn;
                    mn = fmaxf(m1, a1); l1 = l1 * exp2f(m1 - mn) + exp2f(a1 - mn); m1 = mn; } }
        }
#pragma unroll
        for (int off = 1; off < 8; off <<= 1) {
            float mo = shfl_xor_f(m0, off), lo = shfl_xor_f(l0, off); float mn = fmaxf(m0, mo); l0 = l0 * exp2f(m0 - mn) + lo * exp2f(mo - mn); m0 = mn;
            mo = shfl_xor_f(m1, off); lo = shfl_xor_f(l1, off); mn = fmaxf(m1, mo); l1 = l1 * exp2f(m1 - mn) + lo * exp2f(mo - mn); m1 = mn;
        }
        const float inv0 = 1.f / l0, inv1 = 1.f / l1, lam = btab[129];
        float o[16];
#pragma unroll
        for (int d = 0; d < 16; ++d) o[d] = 0.f;
        for (int kt = 0; kt <= qb; ++kt) {
            __syncthreads();
            for (int e = tid; e < 64 * 128; e += 512) { const int kk = e >> 7, c = e & 127; const size_t gi = ((size_t)b * SEQ + kt * 64 + kk) * 1024 + h * 128 + c;
                Ks[kk * 129 + c] = bf2f(Kb[gi]); Vs[kk * 128 + c] = bf2f(Vb[gi]); }
            __syncthreads();
            float s0[8], s1[8];
#pragma unroll
            for (int i = 0; i < 8; ++i) { s0[i] = 0.f; s1[i] = 0.f; }
            for (int d = 0; d < 64; ++d) { const float q0 = Qs[r * 129 + d], q1 = Qs[r * 129 + 64 + d];
#pragma unroll
                for (int i = 0; i < 8; ++i) { s0[i] += q0 * Ks[(ks * 8 + i) * 129 + d]; s1[i] += q1 * Ks[(ks * 8 + i) * 129 + 64 + d]; } }
#pragma unroll
            for (int i = 0; i < 8; ++i) { const int kpos = kt * 64 + ks * 8 + i; float w = 0.f;
                if (kpos <= qpos) { const int dist = qpos - kpos; const float bb = btab[dist < 128 ? dist : 128];
                    w = exp2f(s0[i] + bb - m0) * inv0 - lam * exp2f(s1[i] + bb - m1) * inv1; }
                Ws[r * 65 + ks * 8 + i] = w; }
            __syncthreads();
            for (int kk = 0; kk < 64; ++kk) { const float w = Ws[r * 65 + kk];
#pragma unroll
                for (int d = 0; d < 16; ++d) o[d] += w * Vs[kk * 128 + ks * 16 + d]; }
        }
        float ss = 0.f;
#pragma unroll
        for (int d = 0; d < 16; ++d) ss += o[d] * o[d];
        ss += shfl_xor_f(ss, 1); ss += shfl_xor_f(ss, 2); ss += shfl_xor_f(ss, 4);
        const float rs = 1.f / sqrtf(ss * (1.f / 128.f) + EPS);
        bf16* op = Qb + (row0 + r) * 1024 + h * 128 + ks * 16;
        *(GAS v4u*)op = (v4u){pk2(o[0] * rs, o[1] * rs), pk2(o[2] * rs, o[3] * rs), pk2(o[4] * rs, o[5] * rs), pk2(o[6] * rs, o[7] * rs)};
        *(GAS v4u*)(op + 8) = (v4u){pk2(o[8] * rs, o[9] * rs), pk2(o[10] * rs, o[11] * rs), pk2(o[12] * rs, o[13] * rs), pk2(o[14] * rs, o[15] * rs)};
        (void)lane;
    }
}

typedef float f32x16 __attribute__((ext_vector_type(16)));
typedef short s16x4 __attribute__((ext_vector_type(4)));
typedef short v4i16_t __attribute__((ext_vector_type(4)));
__device__ __forceinline__ int crow(int r, int hi) { return (r & 3) + 8 * (r >> 2) + 4 * hi; }
__device__ __forceinline__ s16x4 vtr(const LAS unsigned char* p) { return __builtin_bit_cast(s16x4, __builtin_amdgcn_ds_read_tr16_b64_v4i16((LAS v4i16_t*)p)); }
template <int CTRL> __device__ __forceinline__ float dpp_add(float v) { return v + __builtin_bit_cast(float, __builtin_amdgcn_update_dpp(0, __builtin_bit_cast(int, v), CTRL, 0xf, 0xf, true)); }
__device__ __forceinline__ float red32(float v) {
    v = dpp_add<0xB1>(v); v = dpp_add<0x4E>(v); v = dpp_add<0x141>(v); v = dpp_add<0x140>(v);
    return v + __builtin_bit_cast(float, __builtin_amdgcn_ds_swizzle(__builtin_bit_cast(int, v), 0x401F));
}
__device__ __forceinline__ float wave_max(float v) {
#pragma unroll
    for (int o = 1; o < 64; o <<= 1) v = fmaxf(v, shfl_xor_f(v, o));
    return v;
}
__device__ __forceinline__ void glds16(const void* sbase, unsigned voff, unsigned lds_dst) { unsigned keep;
    asm volatile("s_nop 4\n\ts_mov_b32 %0, m0\n\ts_mov_b32 m0, %3\n\ts_nop 0\n\tglobal_load_lds_dwordx4 %1, %2\n\ts_mov_b32 m0, %0" : "=&s"(keep) : "v"(voff), "s"(sbase), "s"(lds_dst) : "memory"); }
__device__ __forceinline__ void attn_fast_phase(const Args& a, LAS unsigned char* lds, int vcu) {
    const int tid = opaque_tid(), lane = tid & 63, wid = __builtin_amdgcn_readfirstlane(tid >> 6), r32 = lane & 31, hi = lane >> 5;
    const int comp = wid >> 2, wq = wid & 3;
    const bf16* Kb = (const bf16*)(opaque_ws(a) + WS_K); const bf16* Vb = (const bf16*)(opaque_ws(a) + WS_V); const bf16* Qb = (const bf16*)(opaque_ws(a) + WS_Q); bf16* Ob = (bf16*)(opaque_ws(a) + WS_O);
    const float* rel_bias = ARG_IN(a, 13); const float* lv = ARG_IN(a, 17);
    LAS float* misc = (LAS float*)(lds + 131072);
    LAS float* wsf = misc + 256 + wid * 32;
    LAS float* X = (LAS float*)lds;
    const unsigned lds0 = (unsigned)(uintptr_t)lds;
    LAS float* tabs = misc + 512;
    { const int k = tid >> 7, d = tid & 127, hk = (4 * (vcu >> 3) + k) & 7;
      tabs[k * 132 + d] = rel_bias[t5_bucket(d) * 8 + hk] * LOG2E;
      if (d == 0) tabs[k * 132 + 128] = rel_bias[31 * 8 + hk] * LOG2E; }
    if (wid < 4) {
        const int hk = (4 * (vcu >> 3) + wid) & 7;
        float s0 = lv[lane] * lv[64 + lane], s1 = lv[128 + lane] * lv[192 + lane]; s0 = wave_sum(s0); s1 = wave_sum(s1);
        const float gq = wave_max(fabsf(ARG_IN(a, 16)[lane])), gk = wave_max(fabsf(ARG_IN(a, 12)[lane]));
        const float bm = wave_max(lane < 32 ? rel_bias[lane * 8 + hk] * LOG2E : -1e30f);
        if (lane == 0) { tabs[wid * 132 + 129] = __expf(s0) - __expf(s1) + LAM_INIT; tabs[wid * 132 + 131] = QSCALE * 64.f * gq * gk + bm; }
    }
    __syncthreads();
    for (int j = 0; j < 8; ++j) {
        const int bh = 4 * (vcu >> 3) + (j >> 1), s8 = vcu & 7, qb = (j & 1) ? 15 - s8 : s8;
        const int b = bh >> 3, h = bh & 7;
        const size_t tok0 = (size_t)b * SEQ;
        const int q0 = qb * 128;
        const LAS float* mt = tabs + (j >> 1) * 132;
        const bf16* qp = Qb + (tok0 + q0 + 32 * wq + r32) * 1024 + h * 128 + comp * 64 + 8 * hi;
        bf16x8 qr[4];
#pragma unroll
        for (int ks = 0; ks < 4; ++ks) qr[ks] = *(const GAS bf16x8*)(qp + 16 * ks);
        f32x16 o[4];
#pragma unroll
        for (int d = 0; d < 4; ++d)
#pragma unroll
            for (int r = 0; r < 16; ++r) o[d][r] = 0.f;
        float lsum = 0.f;
        const int NT = 2 * (qb + 1);
        const bf16* ksrc0 = Kb + tok0 * 1024 + h * 128;
        const unsigned kvoff = ((lane >> 2) * 1024 + 8 * ((lane & 3) ^ ((lane >> 4) & 3))) * 2, vvoff = ((lane >> 2) * 1024 + 8 * (lane & 3)) * 2;
        const bf16* vsrc0 = Vb + tok0 * 1024 + h * 128;
#define ATT_DMA_TILE(t, slot) do { _Pragma("unroll") for (int i_ = 0; i_ < 2; ++i_) { const int pk_ = wid + 8 * i_, d32_ = pk_ >> 2, k16_ = pk_ & 3; \
            glds16(ksrc0 + (size_t)(64 * (t) + 16 * k16_) * 1024 + 32 * d32_, kvoff, (unsigned)__builtin_amdgcn_readfirstlane((int)(lds0 + (slot) * 32768 + pk_ * 1024))); } \
        _Pragma("unroll") for (int i_ = 0; i_ < 2; ++i_) { const int pv_ = wid + 8 * i_, dvb_ = pv_ >> 2, k16_ = pv_ & 3; \
            glds16(vsrc0 + (size_t)(64 * (t) + 16 * k16_) * 1024 + 32 * dvb_, vvoff, (unsigned)__builtin_amdgcn_readfirstlane((int)(lds0 + (slot) * 32768 + 16384 + pv_ * 1024))); } } while (0)
        ATT_DMA_TILE(0, 0); ATT_DMA_TILE(1, 1);
        if (NT > 2) ATT_DMA_TILE(2, 2);
        asm volatile("" : "+v"(qr[0]), "+v"(qr[1]), "+v"(qr[2]), "+v"(qr[3]));
        if (NT > 2) asm volatile("s_waitcnt vmcnt(8) lgkmcnt(0)" ::: "memory"); else asm volatile("s_waitcnt vmcnt(4) lgkmcnt(0)" ::: "memory");
        __builtin_amdgcn_s_barrier(); asm volatile("" ::: "memory");
        const float cfar = mt[128] - mt[131], cnear = -mt[131];
        const int qpos = q0 + 32 * wq + r32;
        f32x16 cfarv;
#pragma unroll
        for (int r = 0; r < 16; ++r) cfarv[r] = cfar;
        asm volatile("" : "+v"(cfarv));
#define ATT_QK(P0, P1, tt, slot_) do { const LAS unsigned char* kb_ = lds + (slot_) * 32768 + (r32 >> 4) * 1024 + (r32 & 15) * 64; \
            bf16x8 kf_[8]; \
            _Pragma("unroll") for (int ks = 0; ks < 4; ++ks) { const int po_ = (comp * 2 + (ks >> 1)) * 4096 + ((((ks & 1) * 2 + hi) ^ ((r32 >> 2) & 3)) * 16); \
                kf_[2 * ks] = *(const LAS bf16x8*)(kb_ + po_); kf_[2 * ks + 1] = *(const LAS bf16x8*)(kb_ + po_ + 2048); } \
              \
            if ((tt) >= NT - 4) { f32x16 cn_; _Pragma("unroll") for (int r = 0; r < 16; ++r) cn_[r] = cnear; \
                P0 = __builtin_amdgcn_mfma_f32_32x32x16_bf16(kf_[0], qr[0], cn_, 0, 0, 0); P1 = __builtin_amdgcn_mfma_f32_32x32x16_bf16(kf_[1], qr[0], cn_, 0, 0, 0); } \
            else { P0 = __builtin_amdgcn_mfma_f32_32x32x16_bf16(kf_[0], qr[0], cfarv, 0, 0, 0); P1 = __builtin_amdgcn_mfma_f32_32x32x16_bf16(kf_[1], qr[0], cfarv, 0, 0, 0); } \
            _Pragma("unroll") for (int ks = 1; ks < 4; ++ks) { \
                P0 = __builtin_amdgcn_mfma_f32_32x32x16_bf16(kf_[2 * ks], qr[ks], P0, 0, 0, 0); \
                P1 = __builtin_amdgcn_mfma_f32_32x32x16_bf16(kf_[2 * ks + 1], qr[ks], P1, 0, 0, 0); } } while (0)
#define ATT_PV(slot_) do { const LAS unsigned char* vbase_ = lds + (slot_) * 32768 + 16384 + ((lane >> 4) & 1) * 32 + (lane & 3) * 8 + (4 * hi + ((lane & 15) >> 2)) * 64; \
            _Pragma("unroll") for (int dvb = 0; dvb < 4; ++dvb) _Pragma("unroll") for (int ks = 0; ks < 4; ++ks) { \
                const s16x4 lo_ = vtr(vbase_ + dvb * 4096 + ks * 1024), hh_ = vtr(vbase_ + dvb * 4096 + ks * 1024 + 512); \
                const bf16x8 vf_ = (bf16x8){lo_[0], lo_[1], lo_[2], lo_[3], hh_[0], hh_[1], hh_[2], hh_[3]}; \
                o[dvb] = __builtin_amdgcn_mfma_f32_32x32x16_bf16(__builtin_bit_cast(bf16x8, pw[ks]), vf_, o[dvb], 0, 0, 0); \
                } } while (0)
        f32x16 p0, p1;
        u32x4v pw[4];
#pragma unroll
        for (int q = 0; q < 4; ++q) pw[q] = (u32x4v){0u, 0u, 0u, 0u};
        int slotp = 3, slot = 0, slotn = 1, slotf = 2;
        for (int t = 0; t < NT; ++t) {
            if (comp == 1 && t > 0) ATT_PV(slotp);
            ATT_QK(p0, p1, t, slot);
            const bool near = t >= NT - 4;
            if (near) {
#define ATT_NEAR(P, koff) do { float bb_[16]; \
                    _Pragma("unroll") for (int r = 0; r < 16; ++r) { const int d_ = qpos - (64 * t + (koff) + crow(r, hi)); bb_[r] = mt[d_ < 0 ? 0 : (d_ < 128 ? d_ : 128)]; } \
                    _Pragma("unroll") for (int r = 0; r < 16; ++r) asm volatile("" : "+v"(bb_[r]));        \
                    _Pragma("unroll") for (int r = 0; r < 16; ++r) { const int d_ = qpos - (64 * t + (koff) + crow(r, hi)); const float x_ = P[r] + bb_[r]; \
                        P[r] = __builtin_amdgcn_exp2f(d_ < 0 ? -INFINITY : x_); } } while (0)
                ATT_NEAR(p0, 0); ATT_NEAR(p1, 32);
#undef ATT_NEAR
            } else {
#pragma unroll
                for (int r = 0; r < 16; ++r) { p0[r] = __builtin_amdgcn_exp2f(p0[r]); p1[r] = __builtin_amdgcn_exp2f(p1[r]); }
            }
            { typedef float f32x2a __attribute__((ext_vector_type(2)));
              f32x2a sa = (f32x2a){p0[0], p0[1]} + (f32x2a){p1[0], p1[1]};
#pragma unroll
              for (int r = 2; r < 16; r += 2) sa += (f32x2a){p0[r], p0[r + 1]} + (f32x2a){p1[r], p1[r + 1]};
              lsum += sa.x + sa.y; }
#pragma unroll
            for (int q = 0; q < 4; ++q) { pw[0][q] = pk2(p0[2 * q], p0[2 * q + 1]); pw[1][q] = pk2(p0[8 + 2 * q], p0[9 + 2 * q]);
                pw[2][q] = pk2(p1[2 * q], p1[2 * q + 1]); pw[3][q] = pk2(p1[8 + 2 * q], p1[9 + 2 * q]); }
            if (comp == 0) ATT_PV(slot);
            if (t + 2 < NT) asm volatile("s_waitcnt vmcnt(4) lgkmcnt(0)" ::: "memory"); else asm volatile("s_waitcnt vmcnt(0) lgkmcnt(0)" ::: "memory");
            __builtin_amdgcn_s_barrier(); asm volatile("" ::: "memory");
            if (t + 3 < NT) ATT_DMA_TILE(t + 3, slotp);
            { const int s_ = slotp; slotp = slot; slot = slotn; slotn = slotf; slotf = s_; }
        }
        if (comp == 1) ATT_PV(slotp);
        asm volatile("s_waitcnt lgkmcnt(0)" ::: "memory"); __builtin_amdgcn_s_barrier(); asm volatile("" ::: "memory");
#undef ATT_PV
#undef ATT_QK
#undef ATT_DMA_TILE
        const float lt = lsum + shfl_xor_f(lsum, 32);
        if (hi == 0) wsf[r32] = lt;
        LDS_WAIT(); asm volatile("" ::: "memory");
        float rli[16];
#pragma unroll
        for (int r = 0; r < 16; ++r) rli[r] = __builtin_amdgcn_rcpf(wsf[crow(r, hi)]);
        if (comp == 1) {
            const float lam = mt[129];
#pragma unroll
            for (int dvb = 0; dvb < 4; ++dvb)
#pragma unroll
                for (int q = 0; q < 4; ++q) {
                    f32x4 w;
#pragma unroll
                    for (int i = 0; i < 4; ++i) w[i] = o[dvb][4 * q + i] * rli[4 * q + i] * lam;
                    *(LAS f32x4*)(X + ((wq * 128 + 32 * dvb + r32) * 36 + 8 * q + 4 * hi)) = w; }
        }
        __syncthreads();
        if (comp == 0) {
            float ss[16];
#pragma unroll
            for (int r = 0; r < 16; ++r) ss[r] = 0.f;
#pragma unroll
            for (int dvb = 0; dvb < 4; ++dvb)
#pragma unroll
                for (int q = 0; q < 4; ++q) { const f32x4 xv = *(const LAS f32x4*)(X + ((wq * 128 + 32 * dvb + r32) * 36 + 8 * q + 4 * hi));
#pragma unroll
                    for (int i = 0; i < 4; ++i) { const int r = 4 * q + i; const float v = o[dvb][r] * rli[r] - xv[i]; o[dvb][r] = v; ss[r] += v * v; } }
#pragma unroll
            for (int r = 0; r < 16; ++r) { float s = ss[r]; s = red32(s); ss[r] = 1.f / sqrtf(s * (1.f / 128.f) + EPS); }
            LDS_WAIT(); asm volatile("" ::: "memory");
            LAS bf16* stg = (LAS bf16*)((LAS unsigned char*)X + 73728 + wq * 8192);
#pragma unroll
            for (int dvb = 0; dvb < 4; ++dvb)
#pragma unroll
                for (int r = 0; r < 16; ++r) stg[crow(r, hi) * 128 + 32 * dvb + r32] = (bf16)f2bf(o[dvb][r] * ss[r]);
            LDS_WAIT(); asm volatile("" ::: "memory");
            const int lane_e = opaque_tid() & 63;
#pragma unroll
            for (int i = 0; i < 8; ++i) { const int row = 4 * i + (lane_e >> 4), ch = lane_e & 15;
                const v4u w = *(const LAS v4u*)(stg + row * 128 + ch * 8);
                *(GAS v4u*)(Ob + (tok0 + q0 + 32 * wq + row) * 1024 + h * 128 + ch * 8) = w; }
        }
        __syncthreads();
    }
}

constexpr int SSD_LD = 272;
constexpr int SSD_BS = 0, SSD_CS = 128 * SSD_LD, SSD_XS = 2 * 128 * SSD_LD, SSD_ST = 3 * 128 * SSD_LD, SSD_VEC = 4 * 128 * SSD_LD,
              SSD_HALO = SSD_VEC + 2048, SSD_STG = SSD_HALO + 2048, SSD_GSL = SSD_STG + 8 * 2048;
static_assert(SSD_GSL + 1024 <= LDSCTL_OFF, "SSD LDS map");
__device__ __forceinline__ bf16x8 frag_tr(const LAS unsigned char* p) {
    const s16x4 lo = vtr(p), hh = vtr(p + 8 * SSD_LD);
    return (bf16x8){lo[0], lo[1], lo[2], lo[3], hh[0], hh[1], hh[2], hh[3]};
}
__device__ __forceinline__ void ssd_fast_phase(const Args& a, LAS unsigned char* lds, int vcu) {
    const int tid = opaque_tid(), lane = tid & 63, wid = __builtin_amdgcn_readfirstlane(tid >> 6), r32 = lane & 31, hi = lane >> 5;
    const unsigned zz_ = (unsigned)tid >> 31; const v4u vzero = {zz_, zz_, zz_, zz_};
    const int hh = wid >> 2, wl = hh ? 3 - (wid & 3) : (wid & 3), wn = wid & 3;
    const int b = vcu >> 4, g = (vcu >> 2) & 3, h0 = 8 * g + 2 * (vcu & 3), hd = h0 + hh;
    float* gss = (float*)(opaque_ws(a) + WS_GSS);
    const bf16* XBC = (const bf16*)(opaque_ws(a) + WS_XBC); const float* DT = (const float*)(opaque_ws(a) + WS_DT);
    const size_t tok0 = (size_t)b * SEQ;
    LAS float* dtv = (LAS float*)(lds + SSD_VEC);
    LAS float* acs = dtv + 256;
#define SSD_ROLES() const int tidr_ = opaque_tid(); const int cg = tidr_ % 48, ls = tidr_ / 48; \
    const int ccol = cg < 16 ? 64 * h0 + 8 * cg : (cg < 32 ? 2048 + 128 * g + 8 * (cg - 16) : 2560 + 128 * g + 8 * (cg - 32)); \
    const int cdst = (cg < 16 ? SSD_XS + 16 * cg : (cg < 32 ? SSD_BS + 16 * (cg - 16) : SSD_CS + 16 * (cg - 32))); (void)cdst; (void)ccol; (void)ls
    const float Aneg = -__expf(ARG_IN(a, 6)[hd]), Dh = ARG_IN(a, 7)[hd];
    f32x16 stq[2];
#pragma unroll
    for (int pb = 0; pb < 2; ++pb)
#pragma unroll
        for (int r = 0; r < 16; ++r) stq[pb][r] = 0.f;
    for (int e = tid; e < 128 * SSD_LD / 16; e += 512) *(LAS v4u*)(lds + SSD_ST + e * 16) = vzero;
    const int g16 = (lane >> 4) & 1, tq = (lane & 15) >> 2, tp = lane & 3;
    v4u pre[16];
#define SSD_PREFETCH(ch_) do { if (tid < 384) { SSD_ROLES(); const bf16* src_ = XBC + (tok0 + (ch_) * 128 + 16 * ls) * NXBC + ccol; \
        _Pragma("unroll") for (int i = 0; i < 16; ++i) pre[i] = *(const GAS v4u*)(src_ + (size_t)i * NXBC); } } while (0)
    float dtp[2] = {0.f, 0.f};
#define SSD_DTPREFETCH(ch_) do { if (wid >= 6) { const int hq_ = h0 + (wid - 6); const int lane_ = opaque_tid() & 63; \
        dtp[0] = DT[(tok0 + (ch_) * 128 + lane_) * 32 + hq_]; dtp[1] = DT[(tok0 + (ch_) * 128 + 64 + lane_) * 32 + hq_]; } } while (0)
    SSD_PREFETCH(0); SSD_DTPREFETCH(0);
    for (int ch = 0; ch < SEQ / 128; ++ch) {
        const int t0 = ch * 128;
        if (tid < 384) {
            SSD_ROLES();
#pragma unroll
            for (int i = 0; i < 16; ++i) *(LAS v4u*)(lds + cdst + (16 * ls + i) * SSD_LD) = pre[i];
        } else {
            const int q = wid - 6, hq = h0 + q; const float An = -__expf(ARG_IN(a, 6)[hq]), dtb = ARG_IN(a, 5)[hq];
            const float r0 = dtp[0] + dtb, r1 = dtp[1] + dtb;
            const float d0 = r0 > 20.f ? r0 : __logf(1.f + __expf(r0)), d1 = r1 > 20.f ? r1 : __logf(1.f + __expf(r1));
            float s0 = d0 * An, s1 = d1 * An;
#define SSD_DPP(v_, ctrl_, rmask_, bc_) __builtin_bit_cast(float, __builtin_amdgcn_update_dpp(0, __builtin_bit_cast(int, v_), ctrl_, rmask_, 0xf, bc_))
#define SSD_SCAN(v_) do { v_ += SSD_DPP(v_, 0x111, 0xf, true); v_ += SSD_DPP(v_, 0x112, 0xf, true); v_ += SSD_DPP(v_, 0x114, 0xf, true); v_ += SSD_DPP(v_, 0x118, 0xf, true); \
                v_ += SSD_DPP(v_, 0x142, 0xa, false); v_ += SSD_DPP(v_, 0x143, 0xc, false); } while (0)
            SSD_SCAN(s0); SSD_SCAN(s1);
#undef SSD_SCAN
#undef SSD_DPP
            s1 += __builtin_bit_cast(float, __builtin_amdgcn_readlane(__builtin_bit_cast(int, s0), 63));
            dtv[q * 128 + lane] = d0; dtv[q * 128 + 64 + lane] = d1; acs[q * 128 + lane] = s0; acs[q * 128 + 64 + lane] = s1;
        }
        __syncthreads();
        {
            const int lane = opaque_tid() & 63, r32 = lane & 31, hi = lane >> 5, g16 = (lane >> 4) & 1, tq = (lane & 15) >> 2, tp = lane & 3;
            bf16* Zb = (bf16*)(opaque_ws(a) + WS_Z);
            v4u zv[2][2];
#pragma unroll
            for (int pb = 0; pb < 2; ++pb)
#pragma unroll
                for (int i = 0; i < 2; ++i) zv[pb][i] = *(const GAS v4u*)(Zb + (tok0 + t0 + 32 * wl + 16 * i + (lane >> 2)) * DIN + 64 * hd + 32 * pb + (lane & 3) * 8);
            bf16x8 cf[8];
            const LAS unsigned char* cp = lds + SSD_CS + (32 * wl + r32) * SSD_LD + 16 * hi;
#pragma unroll
            for (int ks = 0; ks < 8; ++ks) cf[ks] = *(const LAS bf16x8*)(cp + 32 * ks);
            f32x16 acc[2];
#pragma unroll
            for (int pb = 0; pb < 2; ++pb) {
#pragma unroll
                for (int r = 0; r < 16; ++r) acc[pb][r] = 0.f;
                const LAS unsigned char* sp = lds + SSD_ST + (hh * 64 + 32 * pb + r32) * SSD_LD + 16 * hi;
#pragma unroll
                for (int ks = 0; ks < 8; ++ks) acc[pb] = __builtin_amdgcn_mfma_f32_32x32x16_bf16(cf[ks], *(const LAS bf16x8*)(sp + 32 * ks), acc[pb], 0, 0, 0);
            }
            const LAS float* acsh = acs + hh * 128; const LAS float* dth = dtv + hh * 128;
#pragma unroll
            for (int q = 0; q < 4; ++q) { const f32x4 av = *(const LAS f32x4*)(acsh + 32 * wl + 8 * q + 4 * hi);
#pragma unroll
                for (int i = 0; i < 4; ++i) { const float e = __expf(av[i]); acc[0][4 * q + i] *= e; acc[1][4 * q + i] *= e; } }
            const int lrow = 32 * wl + r32; const float acs_l = acsh[lrow];
            for (int sb = 0; sb <= wl; ++sb) {
                f32x16 gt;
#pragma unroll
                for (int r = 0; r < 16; ++r) gt[r] = 0.f;
                const LAS unsigned char* bp = lds + SSD_BS + (32 * sb + r32) * SSD_LD + 16 * hi;
#pragma unroll
                for (int ks = 0; ks < 8; ++ks) gt = __builtin_amdgcn_mfma_f32_32x32x16_bf16(*(const LAS bf16x8*)(bp + 32 * ks), cf[ks], gt, 0, 0, 0);
#pragma unroll
                for (int q = 0; q < 4; ++q) { const f32x4 av = *(const LAS f32x4*)(acsh + 32 * sb + 8 * q + 4 * hi), dv = *(const LAS f32x4*)(dth + 32 * sb + 8 * q + 4 * hi);
#pragma unroll
                    for (int i = 0; i < 4; ++i) { const int r = 4 * q + i, s = 32 * sb + 8 * q + 4 * hi + i;
                        float m = gt[r] * __expf(acs_l - av[i]) * dv[i];
                        if (s == lrow) m += Dh;
                        gt[r] = (s <= lrow) ? m : 0.f; } }
                u32x4v pw0, pw1;
#pragma unroll
                for (int q = 0; q < 4; ++q) { pw0[q] = pg8::cvt_pk_bf16(gt[2 * q], gt[2 * q + 1]); pw1[q] = pg8::cvt_pk_bf16(gt[8 + 2 * q], gt[9 + 2 * q]); }
#pragma unroll
                for (int pb = 0; pb < 2; ++pb) {
                    const LAS unsigned char* xp = lds + SSD_XS + (32 * sb + 4 * hi + tq) * SSD_LD + (64 * hh + 32 * pb + 16 * g16 + 4 * tp) * 2;
                    acc[pb] = __builtin_amdgcn_mfma_f32_32x32x16_bf16(__builtin_bit_cast(bf16x8, pw0), frag_tr(xp), acc[pb], 0, 0, 0);
                    acc[pb] = __builtin_amdgcn_mfma_f32_32x32x16_bf16(__builtin_bit_cast(bf16x8, pw1), frag_tr(xp + 16 * SSD_LD), acc[pb], 0, 0, 0);
                }
            }
            LAS bf16* stg = (LAS bf16*)(lds + SSD_STG + wid * 2048);
            float sqa[2] = {0.f, 0.f};
#pragma unroll
            for (int pb = 0; pb < 2; ++pb) {
#pragma unroll
                for (int r = 0; r < 16; ++r) stg[crow(r, hi) * 32 + r32] = (bf16)f2bf(acc[pb][r]);
                LDS_WAIT(); asm volatile("" ::: "memory");
#pragma unroll
                for (int i = 0; i < 2; ++i) { const int row = 16 * i + (lane >> 2), c8 = (lane & 3) * 8;
                    float y[8], z[8]; unpack8(*(const LAS v4u*)(stg + row * 32 + c8), y); unpack8(zv[pb][i], z);
                    float sq = 0.f;
#pragma unroll
                    for (int e = 0; e < 8; ++e) { y[e] *= silu_f(z[e]); sq += y[e] * y[e]; }
                    *(GAS v4u*)(Zb + (tok0 + t0 + 32 * wl + row) * DIN + 64 * hd + 32 * pb + c8) = (v4u){pk2(y[0], y[1]), pk2(y[2], y[3]), pk2(y[4], y[5]), pk2(y[6], y[7])};
                    sqa[i] += sq; }
                LDS_WAIT(); asm volatile("" ::: "memory");
            }
#pragma unroll
            for (int i = 0; i < 2; ++i) { float sq = sqa[i];
                sq += __builtin_bit_cast(float, __builtin_amdgcn_update_dpp(0, __builtin_bit_cast(int, sq), 0xB1, 0xf, 0xf, true));
                sq += __builtin_bit_cast(float, __builtin_amdgcn_update_dpp(0, __builtin_bit_cast(int, sq), 0x4E, 0xf, 0xf, true));
                if ((lane & 3) == 0) ((LAS float*)(lds + SSD_GSL))[hh * 128 + 32 * wl + 16 * i + (lane >> 2)] = sq; }
        }
        __syncthreads();
        if (ch + 1 < SEQ / 128) { SSD_PREFETCH(ch + 1); SSD_DTPREFETCH(ch + 1); }
        {
            const int tidc = opaque_tid();
            if (tidc < 128) gss[(tok0 + t0 + tidc) * 16 + g * 4 + (vcu & 3)] = ((LAS float*)(lds + SSD_GSL))[tidc] + ((LAS float*)(lds + SSD_GSL))[128 + tidc];
 const int l = tidc >> 2, c0 = (tidc & 3) * 32, hq = c0 >> 6;
            const float f = __expf(acs[hq * 128 + 127] - acs[hq * 128 + l]) * dtv[hq * 128 + l];
            LAS unsigned char* xp = lds + SSD_XS + l * SSD_LD + c0 * 2;
#pragma unroll
            for (int q = 0; q < 4; ++q) { v4u w = *(LAS v4u*)(xp + 16 * q); unsigned ww[4] = {w.x, w.y, w.z, w.w};
#pragma unroll
                for (int i = 0; i < 4; ++i) ww[i] = pk2(__builtin_bit_cast(float, ww[i] << 16) * f, __builtin_bit_cast(float, ww[i] & 0xffff0000u) * f);
                *(LAS v4u*)(xp + 16 * q) = (v4u){ww[0], ww[1], ww[2], ww[3]}; }
        }
        __syncthreads();
        {
            const int lane = opaque_tid() & 63, r32 = lane & 31, hi = lane >> 5, g16 = (lane >> 4) & 1, tq = (lane & 15) >> 2, tp = lane & 3;
            const float eL = __expf(acs[hh * 128 + 127]);
#pragma unroll
            for (int pb = 0; pb < 2; ++pb)
#pragma unroll
                for (int r = 0; r < 16; ++r) stq[pb][r] *= eL;
            const LAS unsigned char* bp = lds + SSD_BS + (4 * hi + tq) * SSD_LD + (32 * wn + 16 * g16 + 4 * tp) * 2;
            const LAS unsigned char* xp = lds + SSD_XS + (4 * hi + tq) * SSD_LD + (64 * hh + 16 * g16 + 4 * tp) * 2;
#pragma unroll
            for (int ks = 0; ks < 8; ++ks) {
                const bf16x8 bt = frag_tr(bp + 16 * ks * SSD_LD);
                stq[0] = __builtin_amdgcn_mfma_f32_32x32x16_bf16(bt, frag_tr(xp + 16 * ks * SSD_LD), stq[0], 0, 0, 0);
                stq[1] = __builtin_amdgcn_mfma_f32_32x32x16_bf16(bt, frag_tr(xp + 16 * ks * SSD_LD + 64), stq[1], 0, 0, 0);
            }
#pragma unroll
            for (int pb = 0; pb < 2; ++pb)
#pragma unroll
                for (int rg = 0; rg < 4; ++rg) {
                    typedef unsigned u32x2v __attribute__((ext_vector_type(2)));
                    u32x2v w; w.x = pg8::cvt_pk_bf16(stq[pb][4 * rg], stq[pb][4 * rg + 1]); w.y = pg8::cvt_pk_bf16(stq[pb][4 * rg + 2], stq[pb][4 * rg + 3]);
                    *(LAS u32x2v*)(lds + SSD_ST + (hh * 64 + 32 * pb + r32) * SSD_LD + (32 * wn + 8 * rg + 4 * hi) * 2) = w;
                }
        }
        __syncthreads();
    }
}


#ifndef MK_ONE_LAUNCH
#define MK_ONE_LAUNCH 1
#endif
constexpr int N_PHASES = 24;
#ifndef MK_PROG
#define MK_PROG {0, 1, 25, 2, 4, 6, 7, 8, 13, 15, 16, 18, 19, 20}
#endif
#ifndef STAG_IN
#define STAG_IN 0
#endif
#ifndef STAG_RES
#define STAG_RES 0
#endif
#ifndef STAG_UP
#define STAG_UP 0
#endif
#ifndef STAG_KVQ
#define STAG_KVQ 0
#endif
__device__ __forceinline__ void stagger_spin(int ticks) {
    if (ticks > 0) { const long long t0_ = __builtin_amdgcn_s_memrealtime(); while ((long long)__builtin_amdgcn_s_memrealtime() - t0_ < ticks) __builtin_amdgcn_s_sleep(8); }
}
__global__ void __launch_bounds__(NWAVES * 64, 2) mk_fwd(Args args) {
    extern __shared__ __attribute__((aligned(16))) unsigned char lds_raw[];
    LAS unsigned char* lds = (LAS unsigned char*)lds_raw;
    const int G = gridDim.x;
#ifdef PROBE_PH
    const long long tk0_ = __builtin_amdgcn_s_memrealtime();
#endif
    const int vcu = (G % 8 == 0) ? ((int)blockIdx.x % 8) * (G / 8) + (int)blockIdx.x / 8 : (int)blockIdx.x;
    const int NGW = G * NWAVES;
    gu32* ctl = (gu32*)(args.ws + WS_CTL);
    for (int u = threadIdx.x; u < (LDS_BYTES - LDSCTL_OFF) / 4; u += NWAVES * 64) ((LAS unsigned*)(lds + LDSCTL_OFF))[u] = 0u;
    __syncthreads();
    volatile LAS unsigned* MISC = (volatile LAS unsigned*)(lds + MISC_OFF);
    XcdBarrier bar; bar.bar = (unsigned*)(ctl + CW_BAR); bar.x = 0; bar.st = nullptr;
    const int ph_lo = __builtin_amdgcn_readfirstlane(args.ph_lo), ph_hi = __builtin_amdgcn_readfirstlane(args.ph_hi);
    const bool multi = (ph_hi - ph_lo) > 1;
    if (multi) bar = xcd_barrier_post((unsigned*)(ctl + CW_BAR), MISC + 8);

#ifdef PROBE_PH
#endif
    for (int pi = ph_lo; pi < ph_hi; ++pi) {
        const int ph = args.prog[pi];
        unsigned char* const ws = opaque_ws(args);
        bf16* const XB = (bf16*)(ws + WS_XB); float* const SS0 = (float*)(ws + WS_RSTD);
        float* const SS1 = (float*)(ws + WS_SS1); float* const SS2 = (float*)(ws + WS_SS2); float* const SS3 = (float*)(ws + WS_SS3);
#ifdef PROBE_PH
        const long long tp0_ = __builtin_amdgcn_s_memrealtime();
#endif
        if (ph == 0) prep_phase(args, lds, vcu, NGW);
        else if (ph == 1) {
            pg8::Gemm g{XB, (const bf16*)(ws + WS_WIN), M_TOK, NINP, DM}; pg8::StaticOrder S; S.init(M_TOK, NINP, G, (int)blockIdx.x);
            pg8::EpiInConv E{(bf16*)(ws + WS_Z), (bf16*)(ws + WS_XBC), (float*)(ws + WS_DT), SS0, (bf16*)(ws + WS_XRAW), ARG_IN(args, 3), ARG_IN(args, 4), lds + RING_BYTES};
            stagger_spin((int)blockIdx.x >= 128 ? STAG_IN : 0);
            pg8::gemm_phase<pg8::EpiInConv, pg8::StaticOrder, true, true>(lds, g, S, E, (float*)(ws + 768 * 1024));
        }
        else if (ph == 25) ssmconv_fixup_phase(args);
        else if (ph == 2) ssd_fast_phase(args, lds, vcu);
        else if (ph == 13) {
            pg8::Gemm g{XB, (const bf16*)(ws + WS_WKVQ), M_TOK, 3072, DM}; pg8::StaticOrder S; S.init(M_TOK, 3072, G, (int)blockIdx.x);
            pg8::EpiKVQ E{(bf16*)(ws + WS_K), (size_t)(WS_V - WS_K) / 2, SS2, ARG_IN(args, 12), ARG_IN(args, 16), QSCALE};
            static_assert(WS_Q - WS_V == WS_V - WS_K, "K, V, Q equally spaced");
            stagger_spin((((int)blockIdx.x >> 3) & 3) * STAG_KVQ);
            pg8::gemm_phase<pg8::EpiKVQ, pg8::StaticOrder, true, true>(lds, g, S, E, (float*)(ws + 768 * 1024));
        }
        else if (ph == 15) attn_fast_phase(args, lds, vcu);
        else {
            const int ffn_l = (ph >= 18) ? 1 : 0;
            if (ph == 6 || ph == 18) {
                pg8::Gemm g{XB, (const bf16*)(ws + (ffn_l ? WS_WUP1 : WS_WUP0)), M_TOK, FF2, DM}; pg8::StaticOrder S; S.init(M_TOK, FF2, G, (int)blockIdx.x);
                pg8::EpiConvFFN E{(bf16*)(ws + WS_H), (bf16*)(ws + WS_FRAW), ffn_l ? SS3 : SS1, ARG_IN(args, 22) + (size_t)ffn_l * 3 * FF2, ARG_IN(args, 23) + (size_t)ffn_l * FF2, lds + RING_BYTES};
                stagger_spin((((int)blockIdx.x >> 3) & 3) * STAG_UP);
                pg8::gemm_phase<pg8::EpiConvFFN, pg8::StaticOrder, true, true>(lds, g, S, E, (float*)(ws + 768 * 1024));
            } else if (ph == 7 || ph == 19) convffn_fixup_phase(args, ffn_l);
            else {
                const bf16* A; const bf16* Bt; int Kg; const bf16* baseb = XB; float* outf = nullptr; bf16* xbp = XB; float* ssp;
                if (ph == 4) { A = (const bf16*)(ws + WS_Z); Bt = (const bf16*)(ws + WS_WOUT); Kg = DIN; ssp = SS1; }
                else if (ph == 16) { A = (const bf16*)(ws + WS_O); Bt = (const bf16*)(ws + WS_WAO); Kg = DM; ssp = SS3; }
                else { A = (const bf16*)(ws + WS_H); Bt = (const bf16*)(ws + (ffn_l ? WS_WDN1 : WS_WDN0)); Kg = FF; ssp = ffn_l ? nullptr : SS2; if (ffn_l) { outf = args.out; xbp = nullptr; } }
                pg8::Gemm g{A, Bt, M_TOK, DM, Kg}; pg8::StaticOrder S; S.init(M_TOK, DM, G, (int)blockIdx.x);
                pg8::EpiRes E{baseb, outf, xbp, ssp, (ph == 20) ? (const float*)(ws + 768 * 1024) : nullptr, (ph == 4) ? (const float*)(ws + WS_GSS) : nullptr, (PG8_LAS float*)(lds + RING_BYTES)};
                stagger_spin((((int)blockIdx.x >> 3) & 1) * STAG_RES);
                pg8::gemm_phase<pg8::EpiRes, pg8::StaticOrder, true, true>(lds, g, S, E, (float*)(ws + 768 * 1024));
            }
        }
        if (pi + 1 < ph_hi) xcd_barrier(bar);
#ifdef PROBE_PH
        if (ph == PROBE_PH) { const long long now_ = __builtin_amdgcn_s_memrealtime(), tgt_ = now_ + PROBE_K * (now_ - tp0_) + PROBE_FIX * 100;
            while ((long long)__builtin_amdgcn_s_memrealtime() < tgt_) __builtin_amdgcn_s_sleep(20); }
#endif
    }
#ifdef PROBE_PH
    if (PROBE_PH == 99) { const long long now_ = __builtin_amdgcn_s_memrealtime(), tgt_ = now_ + (now_ - tk0_); while ((long long)__builtin_amdgcn_s_memrealtime() < tgt_) __builtin_amdgcn_s_sleep(20); }
#endif
}

extern "C" void kernel_launch(void* const* d_in, const int* in_sizes, int n_in, void* d_out, int out_size, void* d_ws, size_t ws_size, hipStream_t stream) {
    static int grid = 0;
    if (grid == 0) {
        if (n_in != 25 || in_sizes[0] != M_TOK * DM || out_size != M_TOK * DM || ws_size < WS_END) {
            fprintf(stderr, "kernel_launch: unexpected problem (n_in %d, in0 %d, out %d, ws %zu)\n", n_in, n_in > 0 ? in_sizes[0] : -1, out_size, ws_size); grid = -1; return; }
        int dev = 0, cus = 0, per_cu = 0;
        if (hipGetDevice(&dev) != hipSuccess || hipDeviceGetAttribute(&cus, hipDeviceAttributeMultiprocessorCount, dev) != hipSuccess) { grid = -1; return; }
        if (hipFuncSetAttribute((const void*)mk_fwd, hipFuncAttributeMaxDynamicSharedMemorySize, LDS_BYTES) != hipSuccess) { fprintf(stderr, "kernel_launch: hipFuncSetAttribute failed\n"); grid = -1; return; }
        if (hipOccupancyMaxActiveBlocksPerMultiprocessor(&per_cu, (const void*)mk_fwd, NWAVES * 64, LDS_BYTES) != hipSuccess || per_cu < 1)
            fprintf(stderr, "kernel_launch: occupancy query reports %d blocks per CU\n", per_cu);
        (void)hipGetLastError();
        grid = cus;
        if (grid != 256) { fprintf(stderr, "kernel_launch: built for a 256-CU device, found %d CUs\n", cus); grid = -1; return; }
    }
    if (grid < 0) return;
    if (hipMemsetAsync((char*)d_ws + WS_CTL, 0, CTL_ZERO_BYTES, stream) != hipSuccess) { fprintf(stderr, "kernel_launch: memset failed\n"); return; }
    Args a{};
    for (int i = 0; i < 25; ++i) a.in[i] = (const float*)d_in[i];
    a.out = (float*)d_out; a.ws = (unsigned char*)d_ws;
#ifndef MK_PROG
#define MK_PROG {0, 1, 2, 3, 4, 5, 6, 7, 8, 9, 10, 11, 12, 13, 14, 15, 16, 17, 18, 19, 20, 21, 22, 23}
#endif
    static const unsigned char prog_[] = MK_PROG; const int nprog = (int)sizeof(prog_);
    for (int i = 0; i < nprog && i < 64; ++i) a.prog[i] = prog_[i];
#if MK_ONE_LAUNCH
    a.ph_lo = 0; a.ph_hi = nprog;
    hipLaunchKernelGGL(mk_fwd, dim3(grid), dim3(NWAVES * 64), LDS_BYTES, stream, a);
#else
    for (int ph = 0; ph < nprog; ++ph) { a.ph_lo = ph; a.ph_hi = ph + 1; hipLaunchKernelGGL(mk_fwd, dim3(grid), dim3(NWAVES * 64), LDS_BYTES, stream, a); }
#endif
    const hipError_t le = hipPeekAtLastError();
    if (le != hipSuccess) fprintf(stderr, "kernel_launch: launch failed: %s\n", hipGetErrorName(le));
}
```

```cpp
#include <hip/hip_runtime.h>
#include <hip/hip_bf16.h>
#include <cstdio>
#include <cstdint>
#include <cmath>
__device__ __forceinline__ int opaque_tid() { int t = threadIdx.x; asm volatile("" : "+v"(t)); return t; }
__device__ __forceinline__ float shfl_xor_f(float v, int m) { int l_; asm volatile("v_mbcnt_lo_u32_b32 %0, -1, 0\n\tv_mbcnt_hi_u32_b32 %0, -1, %0" : "=v"(l_));
    return __builtin_bit_cast(float, __builtin_amdgcn_ds_bpermute((l_ ^ m) << 2, __builtin_bit_cast(int, v))); }
#ifndef ATT_REPS
#define ATT_REPS 2
#endif
#ifndef SSD_Y2XBC
#define SSD_Y2XBC 1
#endif
#ifndef SSD_SKEW_CYCLES
#define SSD_SKEW_CYCLES 25000
#endif
#define MK_ONE_LAUNCH 1

namespace pg8 {
#define PG8_LAS __attribute__((address_space(3)))
typedef unsigned short bf16_t;
typedef short bf16x8 __attribute__((ext_vector_type(8)));
typedef float f32x4 __attribute__((ext_vector_type(4)));
typedef unsigned u32x4 __attribute__((ext_vector_type(4)));
constexpr int BM = 256, BK = 64, HALF = 128, HTB = HALF * BK * 2  , STAGE_BYTES = 8 * HTB, NXCD = 8, WGM = 8;

__host__ __device__ __forceinline__ int lds_byte(int r, int c) { const int st = (r >> 4) * 2 + (c >> 5), rr = r & 15, cc = c & 31, ob = rr * 64 + cc * 2; return st * 1024 + (ob ^ (((ob >> 9) & 1) << 5)); }
__host__ __device__ __forceinline__ void stage_rc(int b, int& R, int& C) { const int st = b / 1024, sb = b % 1024, swz = sb ^ (((sb >> 9) & 1) << 5); R = (st >> 1) * 16 + swz / 64; C = (st & 1) * 32 + (swz % 64) / 2; }
__host__ __device__ __forceinline__ int perm32(int rho) { const int n = rho >> 4, i = rho & 15; return 8 * (i >> 2) + 4 * n + (i & 3); }

struct Unit { int pm, pn, ui; };
struct Gemm { const bf16_t* A; const bf16_t* Bt; int M, N, K; };

struct StaticOrder {
    int nM, nN, nwg, G, c;
    __host__ __device__ void init(int M, int N, int G_, int c_) { nM = M / BM; nN = N / BM; nwg = nM * nN; G = G_; c = c_; }
    __host__ __device__ bool next(int i, Unit& u) const {
        const long L = (long)i * G + c; if (L >= nwg) return false;
        int wgid = (int)L; { const int q = nwg / NXCD, r = nwg % NXCD, xcd = wgid % NXCD, off = wgid / NXCD; wgid = (xcd < r ? xcd * (q + 1) : r * (q + 1) + (xcd - r) * q) + off; }
        const int nig = WGM * nN, gid = wgid / nig, fm = gid * WGM, gsz = (nM - fm) < WGM ? (nM - fm) : WGM;
        u.pm = fm + ((wgid % nig) % gsz); u.pn = (wgid % nig) / gsz; return true;
    }
    __device__ __forceinline__ void a_ready(const Unit&) const {}
    __device__ __forceinline__ void done(const Unit&) const {}
};
__device__ __forceinline__ unsigned cvt_pk_bf16(float lo, float hi) { unsigned r; asm volatile("v_cvt_pk_bf16_f32 %0, %1, %2" : "=v"(r) : "v"(lo), "v"(hi)); return r; }
typedef float f32x2 __attribute__((ext_vector_type(2)));
template <class Epi, class Sched, bool ALIGN_EPI = false, bool SP2 = false>
__device__ __forceinline__ void gemm_phase(PG8_LAS unsigned char* lds, const Gemm g, const Sched& S, const Epi& E, float* probe_slot_ = nullptr) {
    const int tid = opaque_tid(), wid = __builtin_amdgcn_readfirstlane(tid >> 6), lane = tid & 63, wr = wid >> 2, wc = wid & 3, fr = lane & 15, fq = lane >> 4;
    const int K = g.K, nt = K / BK;
    unsigned voffA[2], voffB[2];
#pragma unroll
    for (int i = 0; i < 2; ++i) { int R, C; stage_rc(tid * 16 + i * 8192, R, C); const int Rb = Epi::PERM ? ((R & ~31) + perm32(R & 31)) : R;
        voffA[i] = (unsigned)(R * K + C) * 2u; voffB[i] = (unsigned)(Rb * K + C) * 2u; }
    const size_t kstep = (size_t)(BK * 2);
    const size_t hstep = (size_t)HALF * K * 2;
    const size_t tstep = 2 * hstep;
    const unsigned ldsw = (unsigned)wid * 1024u;
    const unsigned lds0_ = (unsigned)__builtin_amdgcn_readfirstlane((int)((unsigned)(uintptr_t)lds + ldsw));
    const int aoff = lds_byte(wr * 64 + fr, fq * 8), boff = lds_byte(wc * 32 + fr, fq * 8);
#define PG8_SA(b, h) (((b) * 2 + (h)) * HTB)
#define PG8_SB(b, h) ((4 + (b) * 2 + (h)) * HTB)
#define PG8_STAGE(bufoff, gbase, voff) do { _Pragma("unroll") for (int _i = 0; _i < 2; ++_i) { unsigned keep_; \
        asm volatile("s_mov_b32 m0, %2\n\ts_nop 0\n\tglobal_load_lds_dwordx4 %0, %1" \
            :: "v"((voff)[_i]), "s"((const char*)(gbase)), "s"(lds0_ + (unsigned)((bufoff) + _i * 8192)) : "memory", "m0"); (void)keep_; } } while (0)
#define PG8_LDA(dst, b, h) do { _Pragma("unroll") for (int m = 0; m < 4; ++m) _Pragma("unroll") for (int k = 0; k < 2; ++k) dst[m][k] = *(const PG8_LAS bf16x8*)(lds + PG8_SA(b, h) + aoff + m * 2048 + k * 1024); } while (0)
#define PG8_LDB(dst, b, h) do { _Pragma("unroll") for (int n = 0; n < 2; ++n) _Pragma("unroll") for (int k = 0; k < 2; ++k) dst[n][k] = *(const PG8_LAS bf16x8*)(lds + PG8_SB(b, h) + boff + n * 2048 + k * 1024); } while (0)
#define PG8_MMA(ai, bj, At, Bt) do { __builtin_amdgcn_s_setprio(1); _Pragma("unroll") for (int m = 0; m < 4; ++m) _Pragma("unroll") for (int n = 0; n < 2; ++n) _Pragma("unroll") for (int k = 0; k < 2; ++k) \
        acc[ai][bj][m][n] = __builtin_amdgcn_mfma_f32_16x16x32_bf16(Bt[n][k], At[m][k], acc[ai][bj][m][n], 0, 0, 0); __builtin_amdgcn_s_setprio(0); } while (0)
#define PG8_WAIT_V(n) asm volatile("s_waitcnt vmcnt(" #n ")" ::: "memory")
#define PG8_WAIT_L(n) asm volatile("s_waitcnt lgkmcnt(" #n ")" ::: "memory")
#define PG8_BAR __builtin_amdgcn_s_barrier()
#define PG8_SCHED __builtin_amdgcn_sched_barrier(0)
#ifdef PROBE_G
#endif
    Unit cur, nxt; int ui = 0;
    if (!S.next(0, cur)) return;
    cur.ui = 0;
    f32x4 acc[2][2][4][2];
#pragma unroll
    for (int a = 0; a < 2; ++a)
#pragma unroll
        for (int b = 0; b < 2; ++b)
#pragma unroll
            for (int m = 0; m < 4; ++m)
#pragma unroll
                for (int n = 0; n < 2; ++n) acc[a][b][m][n] = (f32x4){0.f, 0.f, 0.f, 0.f};
    bf16x8 At[4][2], B0[2][2], B1[2][2];
    const char* cA = (const char*)g.A + (size_t)cur.pm * tstep; const char* cB = (const char*)g.Bt + (size_t)cur.pn * tstep;
    S.a_ready(cur);
    if constexpr (SP2) {
        PG8_STAGE(PG8_SB(0, 0), cB, voffB); PG8_STAGE(PG8_SB(0, 1), cB + hstep, voffB); PG8_STAGE(PG8_SA(0, 0), cA, voffA); PG8_STAGE(PG8_SA(0, 1), cA + hstep, voffA);
        if (wr == 1) PG8_BAR;
        PG8_WAIT_V(2); PG8_BAR;
        PG8_STAGE(PG8_SB(1, 0), cB + kstep, voffB); PG8_STAGE(PG8_SA(1, 0), cA + kstep, voffA); PG8_STAGE(PG8_SB(1, 1), cB + hstep + kstep, voffB);
        PG8_WAIT_V(6); PG8_BAR;
    } else {
        PG8_STAGE(PG8_SB(0, 0), cB, voffB); PG8_STAGE(PG8_SA(0, 0), cA, voffA); PG8_STAGE(PG8_SB(0, 1), cB + hstep, voffB); PG8_STAGE(PG8_SA(0, 1), cA + hstep, voffA);
        if (wr == 1) PG8_BAR;
        PG8_WAIT_V(4); PG8_BAR;
        PG8_STAGE(PG8_SB(1, 0), cB + kstep, voffB); PG8_STAGE(PG8_SA(1, 0), cA + kstep, voffA); PG8_STAGE(PG8_SB(1, 1), cB + hstep + kstep, voffB);
        PG8_WAIT_V(6); PG8_BAR;
    }
    for (;;) {
        const bool has_next = S.next(ui + 1, nxt); nxt.ui = ui + 1;
        const char* nA = has_next ? (const char*)g.A + (size_t)nxt.pm * tstep : cA; const char* nB = has_next ? (const char*)g.Bt + (size_t)nxt.pn * tstep : cB;
        for (int t = 0; t < nt; t += 2) {
            if constexpr (Epi::KSCALE) { if (t == 0) E.kbegin(cur, tid); else if ((t & 7) == 0) E.krescale(acc, cur, t >> 3, wr, fr); }
            const bool last = (t == nt - 2);
            const char* a1 = cA + (size_t)(t + 1) * kstep;
            const char* a2 = last ? nA : cA + (size_t)(t + 2) * kstep; const char* b2 = last ? nB : cB + (size_t)(t + 2) * kstep;
            const char* a3 = a2 + kstep; const char* b3 = b2 + kstep;
            if (last && has_next) S.a_ready(nxt);
            if constexpr (SP2) {
            PG8_LDB(B0, 0, 0); PG8_LDB(B1, 0, 1); PG8_SCHED; PG8_LDA(At, 0, 0); PG8_STAGE(PG8_SA(1, 1), a1 + hstep, voffA);
            PG8_WAIT_V(8); PG8_WAIT_L(0); PG8_BAR; PG8_MMA(0, 0, At, B0); PG8_MMA(0, 1, At, B1); PG8_BAR; PG8_SCHED;
            PG8_LDA(At, 0, 1); PG8_STAGE(PG8_SB(0, 0), b2, voffB); PG8_STAGE(PG8_SB(0, 1), b2 + hstep, voffB); PG8_STAGE(PG8_SA(0, 0), a2, voffA);
            PG8_WAIT_V(8); PG8_WAIT_L(0); PG8_BAR; PG8_MMA(1, 0, At, B0); PG8_MMA(1, 1, At, B1); PG8_BAR; PG8_SCHED;
            PG8_LDB(B0, 1, 0); PG8_LDB(B1, 1, 1); PG8_SCHED; PG8_LDA(At, 1, 0); PG8_STAGE(PG8_SA(0, 1), a2 + hstep, voffA);
            PG8_WAIT_V(8); PG8_WAIT_L(0); PG8_BAR; PG8_MMA(0, 0, At, B0); PG8_MMA(0, 1, At, B1); PG8_BAR; PG8_SCHED;
            PG8_LDA(At, 1, 1); PG8_STAGE(PG8_SB(1, 0), b3, voffB); PG8_STAGE(PG8_SB(1, 1), b3 + hstep, voffB); PG8_STAGE(PG8_SA(1, 0), a3, voffA);
            PG8_WAIT_V(8); PG8_WAIT_L(0); PG8_BAR; PG8_MMA(1, 0, At, B0); PG8_MMA(1, 1, At, B1); PG8_BAR; PG8_SCHED;
            } else {
            PG8_LDB(B0, 0, 0); PG8_SCHED; PG8_LDA(At, 0, 0); PG8_STAGE(PG8_SA(1, 1), a1 + hstep, voffA);
            PG8_WAIT_L(8); PG8_BAR; PG8_WAIT_L(0); PG8_MMA(0, 0, At, B0); PG8_BAR; PG8_SCHED;
            PG8_LDB(B1, 0, 1); PG8_STAGE(PG8_SB(0, 0), b2, voffB);
            PG8_BAR; PG8_WAIT_L(0); PG8_MMA(0, 1, At, B1); PG8_BAR;
            PG8_LDA(At, 0, 1); PG8_STAGE(PG8_SA(0, 0), a2, voffA);
            PG8_BAR; PG8_WAIT_L(0); PG8_MMA(1, 0, At, B0); PG8_BAR; PG8_SCHED;
            PG8_STAGE(PG8_SB(0, 1), b2 + hstep, voffB);
            PG8_WAIT_V(6); PG8_BAR; PG8_MMA(1, 1, At, B1); PG8_BAR;
            PG8_LDB(B0, 1, 0); PG8_SCHED; PG8_LDA(At, 1, 0); PG8_STAGE(PG8_SA(0, 1), a2 + hstep, voffA);
            PG8_WAIT_L(8); PG8_BAR; PG8_WAIT_L(0); PG8_MMA(0, 0, At, B0); PG8_BAR; PG8_SCHED;
            PG8_LDB(B1, 1, 1); PG8_STAGE(PG8_SB(1, 0), b3, voffB);
            PG8_BAR; PG8_WAIT_L(0); PG8_MMA(0, 1, At, B1); PG8_BAR;
            PG8_LDA(At, 1, 1); PG8_STAGE(PG8_SA(1, 0), a3, voffA);
            PG8_BAR; PG8_WAIT_L(0); PG8_MMA(1, 0, At, B0); PG8_BAR; PG8_SCHED;
            PG8_STAGE(PG8_SB(1, 1), b3 + hstep, voffB);
            PG8_WAIT_V(6); PG8_BAR; PG8_MMA(1, 1, At, B1); PG8_BAR;
            }
        }
        if constexpr (ALIGN_EPI) { if (wr == 0) PG8_BAR; }
#ifdef PROBE_G
        const long long te0_ = __builtin_amdgcn_s_memrealtime();
#endif
        if constexpr (!Epi::AFTER_DRAIN) { E(acc, cur, wr, wc, fr, fq); S.done(cur); }
#ifdef PROBE_G
        if (Epi::PROBE_ID == PROBE_G) { const long long now_ = __builtin_amdgcn_s_memrealtime(), tgt_ = now_ + PROBE_GK * (now_ - te0_);
            while ((long long)__builtin_amdgcn_s_memrealtime() < tgt_) __builtin_amdgcn_s_sleep(4); }
#endif
        if (!has_next) break;
#pragma unroll
        for (int a = 0; a < 2; ++a)
#pragma unroll
            for (int b = 0; b < 2; ++b)
#pragma unroll
                for (int m = 0; m < 4; ++m)
#pragma unroll
                    for (int n = 0; n < 2; ++n) acc[a][b][m][n] = (f32x4){0.f, 0.f, 0.f, 0.f};
        cur = nxt; cA = nA; cB = nB; ++ui;
        if constexpr (ALIGN_EPI) { if (wr == 1) PG8_BAR; }
    }
    PG8_WAIT_V(0);
    if constexpr (!ALIGN_EPI) { if (wr == 0) PG8_BAR; }
    PG8_BAR;
    if constexpr (Epi::AFTER_DRAIN) { E.fused(acc, cur, wr, wc, fr, fq, lds, wid, lane); S.done(cur); }
#ifdef PROBE_G
#endif
#undef PG8_SA
#undef PG8_SB
#undef PG8_STAGE
#undef PG8_LDA
#undef PG8_LDB
#undef PG8_MMA
#undef PG8_WAIT_V
#undef PG8_WAIT_L
#undef PG8_BAR
#undef PG8_SCHED
}
}

namespace pg8 {
typedef unsigned u32x2 __attribute__((ext_vector_type(2)));
#define NT_ST(v_, p_) (*(p_) = (v_))
__device__ __forceinline__ u32x4 pack8(const f32x4& v0, const f32x4& v1) {
    u32x4 w; w.x = cvt_pk_bf16(v0[0], v0[1]); w.y = cvt_pk_bf16(v0[2], v0[3]); w.z = cvt_pk_bf16(v1[0], v1[1]); w.w = cvt_pk_bf16(v1[2], v1[3]); return w;
}
struct EpiIn {
    static constexpr int PROBE_ID = 1;
    static constexpr bool PERM = true, AFTER_DRAIN = false, KSCALE = false;
    bf16_t* Z; bf16_t* XBC; float* DT; const float* rstd;
    __device__ __forceinline__ void operator()(const f32x4 (&acc)[2][2][4][2], const Unit& u, int wr, int wc, int fr, int fq) const {
        const int row0 = u.pm * BM + wr * 64 + fr, c8 = wc * 32 + 8 * fq;
        float rsv[2][4];
#pragma unroll
        for (int ai = 0; ai < 2; ++ai)
#pragma unroll
            for (int m = 0; m < 4; ++m) rsv[ai][m] = rstd[row0 + ai * HALF + m * 16];
        asm volatile("" : "+v"(rsv[0][0]), "+v"(rsv[0][1]), "+v"(rsv[0][2]), "+v"(rsv[0][3]), "+v"(rsv[1][0]), "+v"(rsv[1][1]), "+v"(rsv[1][2]), "+v"(rsv[1][3]));
#pragma unroll
        for (int ai = 0; ai < 2; ++ai)
#pragma unroll
            for (int m = 0; m < 4; ++m) {
                const int row = row0 + ai * HALF + m * 16; const float rs = __builtin_amdgcn_rsqf(rsv[ai][m] * (1.f / 1024.f) + 1e-6f);
#pragma unroll
                for (int bj = 0; bj < 2; ++bj) {
                    const f32x4 v0 = acc[ai][bj][m][0] * rs, v1 = acc[ai][bj][m][1] * rs;
                    if (u.pn < 8) *(u32x4*)(Z + (size_t)row * 2048 + u.pn * 256 + bj * HALF + c8) = pack8(v0, v1);
                    else if (u.pn < 20) *(u32x4*)(XBC + (size_t)row * 3072 + (u.pn - 8) * 256 + bj * HALF + c8) = pack8(v0, v1);
                    else if (bj == 0 && wc == 0) { float* d = DT + (size_t)row * 32 + 8 * fq; *(f32x4*)d = v0; *(f32x4*)(d + 4) = v1; }
                }
            }
    }
};
struct EpiRes {
    static constexpr int PROBE_ID = 2;
    static constexpr bool PERM = true, AFTER_DRAIN = false, KSCALE = true;
    const bf16_t* baseb; float* outf; bf16_t* xb; float* ss; const float* probe; const float* gss; PG8_LAS float* gtab;
    __device__ __forceinline__ void kbegin(const Unit& u, int tid) const {
        if (!gss) return;
        tid = opaque_tid();
        const int row = tid & 255, gh = tid >> 8;
        const f32x4* gp = (const f32x4*)(gss + (size_t)(u.pm * BM + row) * 16 + gh * 8);
        const f32x4 p0 = gp[0], p1 = gp[1];
        const float v0 = ((p0[0] + p0[1]) + (p0[2] + p0[3])) * (1.f / 512.f) + 1e-6f, v1 = ((p1[0] + p1[1]) + (p1[2] + p1[3])) * (1.f / 512.f) + 1e-6f;
        PG8_LAS float* tp = gtab + (((u.ui & 1) * 4 + 2 * gh) * 256 + row) * 2;
        tp[0] = __builtin_amdgcn_sqrtf(v0); tp[1] = __builtin_amdgcn_rsqf(v0); tp[512] = __builtin_amdgcn_sqrtf(v1); tp[513] = __builtin_amdgcn_rsqf(v1);
    }
    __device__ __forceinline__ void krescale(f32x4 (&acc)[2][2][4][2], const Unit& u, int g, int wr, int fr) const {
        if (!gss) return;
        const PG8_LAS float* tp = gtab + (((u.ui & 1) * 4 + g) * 256 + wr * 64 + fr) * 2;
#pragma unroll
        for (int ai = 0; ai < 2; ++ai)
#pragma unroll
            for (int m = 0; m < 4; ++m) { const float ratio = tp[(ai * HALF + m * 16) * 2] * tp[(ai * HALF + m * 16) * 2 - 511];
#pragma unroll
                for (int bj = 0; bj < 2; ++bj)
#pragma unroll
                    for (int n = 0; n < 2; ++n) acc[ai][bj][m][n] *= ratio; }
    }
    __device__ __forceinline__ void operator()(const f32x4 (&acc)[2][2][4][2], const Unit& u, int wr, int wc, int fr, int fq) const {
        const int row0 = u.pm * BM + wr * 64 + fr, col0 = u.pn * BM + wc * 32 + 8 * fq;
        u32x4 raw[8][2];
#pragma unroll
        for (int gi = 0; gi < 8; ++gi)
#pragma unroll
            for (int bj = 0; bj < 2; ++bj) raw[gi][bj] = *(const u32x4*)(baseb + (size_t)(row0 + (gi >> 2) * HALF + (gi & 3) * 16) * 1024 + col0 + bj * HALF);
#pragma unroll
        for (int gi = 0; gi < 8; ++gi) {
            const int ai = gi >> 2, m = gi & 3;
            const size_t off = (size_t)(row0 + ai * HALF + m * 16) * 1024 + col0;
            float s = 0.f;
            const float r3 = gss ? gtab[(((u.ui & 1) * 4 + 3) * 256 + wr * 64 + fr + ai * HALF + m * 16) * 2 + 1] : 1.f;
#pragma unroll
            for (int bj = 0; bj < 2; ++bj) {
                const u32x4 w_ = raw[gi][bj];
                const f32x4 lo = {__builtin_bit_cast(float, w_.x << 16), __builtin_bit_cast(float, w_.x & 0xffff0000u), __builtin_bit_cast(float, w_.y << 16), __builtin_bit_cast(float, w_.y & 0xffff0000u)};
                const f32x4 hi = {__builtin_bit_cast(float, w_.z << 16), __builtin_bit_cast(float, w_.z & 0xffff0000u), __builtin_bit_cast(float, w_.w << 16), __builtin_bit_cast(float, w_.w & 0xffff0000u)};
                f32x4 o0 = lo + acc[ai][bj][m][0] * r3, o1 = hi + acc[ai][bj][m][1] * r3;
#ifdef PROBE_T
                if (probe && gi == 0 && bj == 0 && row0 == 0 && col0 == 0) o0[0] += 0.08f + 0.2f * probe[0];
#endif
                if (outf) { NT_ST(o0, (f32x4*)(outf + off + bj * HALF)); NT_ST(o1, (f32x4*)(outf + off + bj * HALF + 4)); }
                if (xb) { u32x4 w; w.x = cvt_pk_bf16(o0[0], o0[1]); w.y = cvt_pk_bf16(o0[2], o0[3]); w.z = cvt_pk_bf16(o1[0], o1[1]); w.w = cvt_pk_bf16(o1[2], o1[3]); NT_ST(w, (u32x4*)(xb + off + bj * HALF)); }
                s += ((o0[0] * o0[0] + o0[1] * o0[1]) + (o0[2] * o0[2] + o0[3] * o0[3])) + ((o1[0] * o1[0] + o1[1] * o1[1]) + (o1[2] * o1[2] + o1[3] * o1[3])); }
            if (ss) { s += shfl_xor_f(s, 16); s += shfl_xor_f(s, 32); if (fq == 0) atomicAdd(ss + row0 + ai * HALF + m * 16, s);
#ifdef PROBE_ATOM
                if (fq == 0) atomicAdd((float*)((char*)ss + (480u << 20)) + row0 + ai * HALF + m * 16, s);
#endif
            }
        }
    }
};
struct EpiScale {
    static constexpr int PROBE_ID = 3;
    static constexpr bool PERM = true, AFTER_DRAIN = false, KSCALE = false;
    bf16_t* O; int ldc; const float* rstd;
    __device__ __forceinline__ void operator()(const f32x4 (&acc)[2][2][4][2], const Unit& u, int wr, int wc, int fr, int fq) const {
        const int row0 = u.pm * BM + wr * 64 + fr, c8 = u.pn * BM + wc * 32 + 8 * fq;
#pragma unroll
        for (int ai = 0; ai < 2; ++ai)
#pragma unroll
            for (int m = 0; m < 4; ++m) {
                const int row = row0 + ai * HALF + m * 16; const float rs = __builtin_amdgcn_rsqf(rstd[row] * (1.f / 1024.f) + 1e-6f);
#pragma unroll
                for (int bj = 0; bj < 2; ++bj) *(u32x4*)(O + (size_t)row * ldc + bj * HALF + c8) = pack8(acc[ai][bj][m][0] * rs, acc[ai][bj][m][1] * rs);
            }
    }
};
struct EpiKVQ {
    static constexpr int PROBE_ID = 4;
    static constexpr bool PERM = true, AFTER_DRAIN = false, KSCALE = false;
    bf16_t* Kb; size_t tstride; const float* rstd; const float* kg; const float* qg; float qscale;
    __device__ __forceinline__ void operator()(const f32x4 (&acc)[2][2][4][2], const Unit& u, int wr, int wc, int fr, int fq) const {
        const int row0 = u.pm * BM + wr * 64 + fr, t = u.pn >> 2;
        bf16_t* base = Kb + (size_t)t * tstride + (u.pn & 3) * BM + 64 * wc + 8 * fq;
        f32x4 g[2][2];
        const float* gp = (t == 2) ? qg : kg; const float sc = (t == 2) ? qscale : 1.f;
#pragma unroll
        for (int bj = 0; bj < 2; ++bj)
#pragma unroll
            for (int n = 0; n < 2; ++n) g[bj][n] = (t == 1) ? (f32x4){1.f, 1.f, 1.f, 1.f} : *(const f32x4*)(gp + 32 * bj + 8 * fq + 4 * n) * sc;
        float rsv[2][4];
#pragma unroll
        for (int ai = 0; ai < 2; ++ai)
#pragma unroll
            for (int m = 0; m < 4; ++m) rsv[ai][m] = rstd[row0 + ai * HALF + m * 16];
        asm volatile("" : "+v"(rsv[0][0]), "+v"(rsv[0][1]), "+v"(rsv[0][2]), "+v"(rsv[0][3]), "+v"(rsv[1][0]), "+v"(rsv[1][1]), "+v"(rsv[1][2]), "+v"(rsv[1][3]));
#pragma unroll
        for (int ai = 0; ai < 2; ++ai)
#pragma unroll
            for (int m = 0; m < 4; ++m) {
                const int row = row0 + ai * HALF + m * 16; const float rs = __builtin_amdgcn_rsqf(rsv[ai][m] * (1.f / 1024.f) + 1e-6f);
                f32x4 v[2][2]; float s = 0.f;
#pragma unroll
                for (int bj = 0; bj < 2; ++bj)
#pragma unroll
                    for (int n = 0; n < 2; ++n) { v[bj][n] = acc[ai][bj][m][n] * rs; s += (v[bj][n][0] * v[bj][n][0] + v[bj][n][1] * v[bj][n][1]) + (v[bj][n][2] * v[bj][n][2] + v[bj][n][3] * v[bj][n][3]); }
                s += shfl_xor_f(s, 16); s += shfl_xor_f(s, 32);
                const float rq = (t == 1) ? 1.f : __builtin_amdgcn_rsqf(s * (1.f / 64.f) + 1e-6f);
#pragma unroll
                for (int bj = 0; bj < 2; ++bj) NT_ST(pack8(v[bj][0] * rq * g[bj][0], v[bj][1] * rq * g[bj][1]), (u32x4*)(base + (size_t)row * 1024 + 32 * bj));
            }
    }
};

struct EpiConvFFN {
    static constexpr int PROBE_ID = 5;
    static constexpr bool PERM = true, AFTER_DRAIN = false, KSCALE = false;
    bf16_t* H; bf16_t* raw; const float* ss; const float* cw; const float* cb; PG8_LAS unsigned char* xl;
    static constexpr int RP = 144, SLAB = 18 * RP, HALO_OFF = 8 * SLAB;
    __device__ __forceinline__ void operator()(const f32x4 (&acc)[2][2][4][2], const Unit& u, int wr, int wc, int fr, int fq) const {
        const int lane = opaque_tid() & 63  , c = lane & 31, hf = lane >> 5, c2 = lane & 15, hq = lane >> 4, wid = wr * 4 + wc;
        PG8_LAS unsigned char* slab = xl + wid * SLAB;
        PG8_LAS unsigned char* halo = xl + HALO_OFF;
        const int chg = 128 * u.pn + 32 * wc + 2 * c2;
        typedef float f32x2v __attribute__((ext_vector_type(2)));
        const f32x2v wg0 = *(const f32x2v*)(cw + chg), wg1 = *(const f32x2v*)(cw + 5632 + chg), wg2 = *(const f32x2v*)(cw + 2 * 5632 + chg), bg = *(const f32x2v*)(cb + chg);
        const f32x2v wu0 = *(const f32x2v*)(cw + 2816 + chg), wu1 = *(const f32x2v*)(cw + 5632 + 2816 + chg), wu2 = *(const f32x2v*)(cw + 2 * 5632 + 2816 + chg), bu = *(const f32x2v*)(cb + 2816 + chg);
        const int row0 = u.pm * BM + wr * 64 + fr;
        float rsv[2][4];
#pragma unroll
        for (int ai = 0; ai < 2; ++ai)
#pragma unroll
            for (int m = 0; m < 4; ++m) rsv[ai][m] = ss[row0 + ai * HALF + m * 16];
#pragma unroll
        for (int ai = 0; ai < 2; ++ai)
#pragma unroll
            for (int m = 0; m < 4; ++m) rsv[ai][m] = __builtin_amdgcn_rsqf(rsv[ai][m] * (1.f / 1024.f) + 1e-6f);
        bf16_t* rawp = raw + ((size_t)u.pm * 4 * 22 + u.pn) * 256 + wc * 64 + 8 * fq;
#pragma unroll
        for (int ai = 0; ai < 2; ++ai) {
            if (fr >= 14) {
                const float rs = rsv[ai][3];
                const int bi = 2 * ai + wr;
#pragma unroll
                for (int bj = 0; bj < 2; ++bj) { u32x4 w; { const f32x4 v0 = acc[ai][bj][3][0] * rs, v1 = acc[ai][bj][3][1] * rs; w.x = cvt_pk_bf16(v0[0], v0[1]); w.y = cvt_pk_bf16(v0[2], v0[3]); w.z = cvt_pk_bf16(v1[0], v1[1]); w.w = cvt_pk_bf16(v1[2], v1[3]); }
                        if (bi < 3) *(PG8_LAS u32x4*)(halo + ((bi * 2 + (fr - 14)) * 256 + wc * 64 + bj * 32 + 8 * fq) * 2) = w;
                        else *(u32x4*)(rawp + (size_t)(2 + fr - 14) * 22 * 256 + bj * 32) = w; }
            }
        }
        if (wr == 0 && fr < 2) {
            const float rs = rsv[0][0];
#pragma unroll
            for (int bj = 0; bj < 2; ++bj) { u32x4 w; { const f32x4 v0 = acc[0][bj][0][0] * rs, v1 = acc[0][bj][0][1] * rs; w.x = cvt_pk_bf16(v0[0], v0[1]); w.y = cvt_pk_bf16(v0[2], v0[3]); w.z = cvt_pk_bf16(v1[0], v1[1]); w.w = cvt_pk_bf16(v1[2], v1[3]); }
                    *(u32x4*)(rawp + (size_t)fr * 22 * 256 + bj * 32) = w; }
        }
        asm volatile("s_waitcnt lgkmcnt(0)" ::: "memory"); __builtin_amdgcn_s_barrier(); asm volatile("" ::: "memory");
#pragma unroll
        for (int ai = 0; ai < 2; ++ai) {
            const int bi = 2 * ai + wr;
            { unsigned hv = 0u; if (bi > 0) hv = *(const PG8_LAS unsigned*)(halo + (((bi - 1) * 2 + hf) * 256 + wc * 64 + 2 * c) * 2);
              *(PG8_LAS unsigned*)(slab + hf * RP + 4 * c) = hv; }
#pragma unroll
            for (int m = 0; m < 4; ++m) {
                const float rs = rsv[ai][m];
#pragma unroll
                for (int bj = 0; bj < 2; ++bj) { u32x4 w; { const f32x4 v0 = acc[ai][bj][m][0] * rs, v1 = acc[ai][bj][m][1] * rs; w.x = cvt_pk_bf16(v0[0], v0[1]); w.y = cvt_pk_bf16(v0[2], v0[3]); w.z = cvt_pk_bf16(v1[0], v1[1]); w.w = cvt_pk_bf16(v1[2], v1[3]); }
                        *(PG8_LAS u32x4*)(slab + (2 + fr) * RP + (bj * 32 + 8 * fq) * 2) = w; }
                asm volatile("" ::: "memory");
                unsigned gw[6], uw[6];
#pragma unroll
                for (int i = 0; i < 6; ++i) { const PG8_LAS unsigned char* rp = slab + (4 * hq + i) * RP + 4 * c2; gw[i] = *(const PG8_LAS unsigned*)rp; uw[i] = *(const PG8_LAS unsigned*)(rp + 64); }
                asm volatile("" ::: "memory");
                if (hq == 3) {
#pragma unroll
                    for (int i = 0; i < 2; ++i) { *(PG8_LAS unsigned*)(slab + i * RP + 4 * c2) = gw[4 + i]; *(PG8_LAS unsigned*)(slab + i * RP + 64 + 4 * c2) = uw[4 + i]; }
                }
                float nl2_ = -1.4426950408889634f; asm volatile("" : "+v"(nl2_)); const f32x2v NL2 = {nl2_, nl2_};
#define CF_PAIR(w_) ((f32x2v){__builtin_bit_cast(float, (w_) << 16), __builtin_bit_cast(float, (w_) & 0xffff0000u)})
                f32x2v xg[6], xu[6];
#pragma unroll
                for (int i = 0; i < 6; ++i) { xg[i] = CF_PAIR(gw[i]); xu[i] = CF_PAIR(uw[i]); }
#pragma unroll
                for (int i = 0; i < 4; ++i) {
                    const f32x2v cg = bg + wg0 * xg[i] + wg1 * xg[i + 1] + wg2 * xg[i + 2];
                    const f32x2v cu = bu + wu0 * xu[i] + wu1 * xu[i + 1] + wu2 * xu[i + 2];
                    const f32x2v ea = cg * NL2;
                    const f32x2v den = (f32x2v){__builtin_amdgcn_exp2f(ea.x), __builtin_amdgcn_exp2f(ea.y)} + (f32x2v){1.f, 1.f};
                    const f32x2v hv = cg * (f32x2v){__builtin_amdgcn_rcpf(den.x), __builtin_amdgcn_rcpf(den.y)} * cu;
                    *(PG8_LAS unsigned*)(slab + (2 + 4 * hq + i) * RP + 4 * c2) = cvt_pk_bf16(hv.x, hv.y);
                }
#undef CF_PAIR
                asm volatile("" ::: "memory");
                { const int row = lane >> 2, c8 = (lane & 3) * 8;
                  const u32x4 w = *(const PG8_LAS u32x4*)(slab + (2 + row) * RP + c8 * 2);
                  NT_ST(w, (u32x4*)(H + (size_t)(u.pm * BM + 64 * bi + 16 * m + row) * 2816 + 128 * u.pn + 32 * wc + c8)); }
                asm volatile("" ::: "memory");
            }
        }
    }
};

struct EpiInConv {
    static constexpr int PROBE_ID = 1;
    static constexpr bool PERM = true, AFTER_DRAIN = false, KSCALE = false;
    bf16_t* Z; bf16_t* XBC; float* DT; const float* ss; bf16_t* raw; const float* cw; const float* cb; PG8_LAS unsigned char* xl;
    static constexpr int RP = 144, SLAB = 19 * RP, HALO_OFF = 8 * SLAB;
    __device__ __forceinline__ void operator()(const f32x4 (&acc)[2][2][4][2], const Unit& u, int wr, int wc, int fr, int fq) const {
        const int row0 = u.pm * BM + wr * 64 + fr;
        float rsv[2][4];
#pragma unroll
        for (int ai = 0; ai < 2; ++ai)
#pragma unroll
            for (int m = 0; m < 4; ++m) rsv[ai][m] = ss[row0 + ai * HALF + m * 16];
        asm volatile("" : "+v"(rsv[0][0]), "+v"(rsv[0][1]), "+v"(rsv[0][2]), "+v"(rsv[0][3]), "+v"(rsv[1][0]), "+v"(rsv[1][1]), "+v"(rsv[1][2]), "+v"(rsv[1][3]));
#pragma unroll
        for (int ai = 0; ai < 2; ++ai)
#pragma unroll
            for (int m = 0; m < 4; ++m) rsv[ai][m] = __builtin_amdgcn_rsqf(rsv[ai][m] * (1.f / 1024.f) + 1e-6f);
        if (u.pn < 8) {
#pragma unroll
            for (int ai = 0; ai < 2; ++ai)
#pragma unroll
                for (int m = 0; m < 4; ++m) { bf16_t* zp = Z + (size_t)(row0 + ai * HALF + m * 16) * 2048 + u.pn * 256 + wc * 32 + 8 * fq; const float rs = rsv[ai][m];
#pragma unroll
                    for (int bj = 0; bj < 2; ++bj) { u32x4 w; { const f32x4 v0 = acc[ai][bj][m][0] * rs, v1 = acc[ai][bj][m][1] * rs; w.x = cvt_pk_bf16(v0[0], v0[1]); w.y = cvt_pk_bf16(v0[2], v0[3]); w.z = cvt_pk_bf16(v1[0], v1[1]); w.w = cvt_pk_bf16(v1[2], v1[3]); } NT_ST(w, (u32x4*)(zp + bj * HALF)); } }
            return;
        }
        if (u.pn == 20) {
            if (wc == 0) {
#pragma unroll
                for (int ai = 0; ai < 2; ++ai)
#pragma unroll
                    for (int m = 0; m < 4; ++m)
#pragma unroll
                        for (int n = 0; n < 2; ++n) *(f32x4*)(DT + (size_t)(row0 + ai * HALF + m * 16) * 32 + 8 * fq + 4 * n) = acc[ai][0][m][n] * rsv[ai][m];
            }
            return;
        }
        const int up = u.pn - 8, lane = opaque_tid() & 63  , c = lane & 31, c2 = lane & 15, hq = lane >> 4, wid = wr * 4 + wc;
        PG8_LAS unsigned char* slab = xl + wid * SLAB;
        PG8_LAS unsigned char* halo = xl + HALO_OFF;
        typedef float f32x2v __attribute__((ext_vector_type(2)));
        const int colA = up * 256 + 32 * wc + 2 * c2, colB = colA + 128;
        f32x2v wA[4], wB[4];
#pragma unroll
        for (int k = 0; k < 4; ++k) { wA[k] = *(const f32x2v*)(cw + k * 3072 + colA); wB[k] = *(const f32x2v*)(cw + k * 3072 + colB); }
        const f32x2v bA = *(const f32x2v*)(cb + colA), bB = *(const f32x2v*)(cb + colB);
        bf16_t* rawp = raw + ((size_t)u.pm * 6 * 12 + up) * 256 + wc * 64 + 8 * fq;
#pragma unroll
        for (int ai = 0; ai < 2; ++ai) {
            if (fr >= 13) {
                const float rs = rsv[ai][3]; const int bi = 2 * ai + wr;
#pragma unroll
                for (int bj = 0; bj < 2; ++bj) { u32x4 w; { const f32x4 v0 = acc[ai][bj][3][0] * rs, v1 = acc[ai][bj][3][1] * rs; w.x = cvt_pk_bf16(v0[0], v0[1]); w.y = cvt_pk_bf16(v0[2], v0[3]); w.z = cvt_pk_bf16(v1[0], v1[1]); w.w = cvt_pk_bf16(v1[2], v1[3]); }
                        if (bi < 3) *(PG8_LAS u32x4*)(halo + ((bi * 3 + (fr - 13)) * 256 + wc * 64 + bj * 32 + 8 * fq) * 2) = w;
                        else *(u32x4*)(rawp + (size_t)(3 + fr - 13) * 12 * 256 + bj * 32) = w; }
            }
        }
        if (wr == 0 && fr < 3) {
            const float rs = rsv[0][0];
#pragma unroll
            for (int bj = 0; bj < 2; ++bj) { u32x4 w; { const f32x4 v0 = acc[0][bj][0][0] * rs, v1 = acc[0][bj][0][1] * rs; w.x = cvt_pk_bf16(v0[0], v0[1]); w.y = cvt_pk_bf16(v0[2], v0[3]); w.z = cvt_pk_bf16(v1[0], v1[1]); w.w = cvt_pk_bf16(v1[2], v1[3]); }
                    *(u32x4*)(rawp + (size_t)fr * 12 * 256 + bj * 32) = w; }
        }
        asm volatile("s_waitcnt lgkmcnt(0)" ::: "memory"); __builtin_amdgcn_s_barrier(); asm volatile("" ::: "memory");
#define CF_LO(w_) __builtin_bit_cast(float, (w_) << 16)
#define CF_HI(w_) __builtin_bit_cast(float, (w_) & 0xffff0000u)
#pragma unroll
        for (int ai = 0; ai < 2; ++ai) {
            const int bi = 2 * ai + wr;
            { unsigned h0 = 0u, h1 = 0u;
              if (bi > 0) { h0 = *(const PG8_LAS unsigned*)(halo + (((bi - 1) * 3 + (lane >> 5)) * 256 + wc * 64 + 2 * c) * 2); if (lane < 32) h1 = *(const PG8_LAS unsigned*)(halo + (((bi - 1) * 3 + 2) * 256 + wc * 64 + 2 * c) * 2); }
              *(PG8_LAS unsigned*)(slab + (lane >> 5) * RP + 4 * c) = h0; if (lane < 32) *(PG8_LAS unsigned*)(slab + 2 * RP + 4 * c) = h1; }
#pragma unroll
            for (int m = 0; m < 4; ++m) {
                const float rs = rsv[ai][m];
#pragma unroll
                for (int bj = 0; bj < 2; ++bj) { u32x4 w; { const f32x4 v0 = acc[ai][bj][m][0] * rs, v1 = acc[ai][bj][m][1] * rs; w.x = cvt_pk_bf16(v0[0], v0[1]); w.y = cvt_pk_bf16(v0[2], v0[3]); w.z = cvt_pk_bf16(v1[0], v1[1]); w.w = cvt_pk_bf16(v1[2], v1[3]); }
                        *(PG8_LAS u32x4*)(slab + (3 + fr) * RP + (bj * 32 + 8 * fq) * 2) = w; }
                asm volatile("" ::: "memory");
                unsigned aw[7], bw[7];
#pragma unroll
                for (int i = 0; i < 7; ++i) { const PG8_LAS unsigned char* rp = slab + (4 * hq + i) * RP + 4 * c2; aw[i] = *(const PG8_LAS unsigned*)rp; bw[i] = *(const PG8_LAS unsigned*)(rp + 64); }
                asm volatile("" ::: "memory");
                if (hq == 3) {
#pragma unroll
                    for (int i = 0; i < 3; ++i) { *(PG8_LAS unsigned*)(slab + i * RP + 4 * c2) = aw[4 + i]; *(PG8_LAS unsigned*)(slab + i * RP + 64 + 4 * c2) = bw[4 + i]; }
                }
                float nl2_ = -1.4426950408889634f; asm volatile("" : "+v"(nl2_)); const f32x2v NL2 = {nl2_, nl2_};
#define CF_PAIR(w_) ((f32x2v){__builtin_bit_cast(float, (w_) << 16), __builtin_bit_cast(float, (w_) & 0xffff0000u)})
                f32x2v xa[7], xb2[7];
#pragma unroll
                for (int i = 0; i < 7; ++i) { xa[i] = CF_PAIR(aw[i]); xb2[i] = CF_PAIR(bw[i]); }
#pragma unroll
                for (int i = 0; i < 4; ++i) {
                    const f32x2v av = bA + wA[0] * xa[i] + wA[1] * xa[i + 1] + wA[2] * xa[i + 2] + wA[3] * xa[i + 3];
                    const f32x2v bv = bB + wB[0] * xb2[i] + wB[1] * xb2[i + 1] + wB[2] * xb2[i + 2] + wB[3] * xb2[i + 3];
                    const f32x2v ea = av * NL2, eb = bv * NL2;
                    const f32x2v da = (f32x2v){__builtin_amdgcn_exp2f(ea.x), __builtin_amdgcn_exp2f(ea.y)} + (f32x2v){1.f, 1.f}, db = (f32x2v){__builtin_amdgcn_exp2f(eb.x), __builtin_amdgcn_exp2f(eb.y)} + (f32x2v){1.f, 1.f};
                    const f32x2v sa = av * (f32x2v){__builtin_amdgcn_rcpf(da.x), __builtin_amdgcn_rcpf(da.y)}, sb = bv * (f32x2v){__builtin_amdgcn_rcpf(db.x), __builtin_amdgcn_rcpf(db.y)};
                    *(PG8_LAS unsigned*)(slab + (3 + 4 * hq + i) * RP + 4 * c2) = cvt_pk_bf16(sa.x, sa.y);
                    *(PG8_LAS unsigned*)(slab + (3 + 4 * hq + i) * RP + 64 + 4 * c2) = cvt_pk_bf16(sb.x, sb.y);
                }
#undef CF_PAIR
                asm volatile("" ::: "memory");
                { const int row = lane >> 2, q = lane & 3;
                  const u32x4 w0 = *(const PG8_LAS u32x4*)(slab + (3 + row) * RP + 32 * q), w1 = *(const PG8_LAS u32x4*)(slab + (3 + row) * RP + 32 * q + 16);
                  bf16_t* op = XBC + (size_t)(u.pm * BM + 64 * bi + 16 * m + row) * 3072 + up * 256 + (q >> 1) * 128 + 32 * wc + 16 * (q & 1);
                  NT_ST(w0, (u32x4*)op); NT_ST(w1, (u32x4*)(op + 8)); }
                asm volatile("" ::: "memory");
            }
        }
#undef CF_LO
#undef CF_HI
    }
};
}

constexpr int NWAVES = 8;
constexpr int NBATCH = 16, SEQ = 2048, M_TOK = NBATCH * SEQ, DM = 1024;
constexpr int DIN = 2048, NXBC = 3072, NIN = 5152, NINP = 5376, SSM_H = 32;
constexpr int FF = 2816, FF2 = 5632, MH = M_TOK / 2;
constexpr float EPS = 1e-6f, LOG2E = 1.4426950408889634f;
constexpr float LAM_INIT = 0.35550906759096926f;
constexpr float QSCALE = 0.125f * 1.4426950408889634f;

constexpr size_t MiB = 1u << 20;
constexpr size_t WS_LO = 384 * MiB;
constexpr size_t WS_CTL = WS_LO, CTL_ZERO_BYTES = 1 * MiB;
constexpr size_t WS_WIN = WS_LO + 1 * MiB, WS_WOUT = WS_LO + 12 * MiB, WS_WUP0 = WS_LO + 16 * MiB, WS_WUP1 = WS_LO + 27 * MiB, WS_WDN0 = WS_LO + 38 * MiB, WS_WDN1 = WS_LO + 44 * MiB,
                 WS_WKVQ = WS_LO + 50 * MiB, WS_WAO = WS_LO + 56 * MiB, WS_RSTD = WS_LO + 58 * MiB, WS_DT = WS_LO + 59 * MiB;
constexpr size_t WS_XB = WS_LO + 64 * MiB;
constexpr size_t WS_R = 0;
constexpr size_t WS_Z = WS_R, WS_XBC = WS_R + 128 * MiB, WS_XRAW = WS_R + 320 * MiB;
constexpr size_t WS_U = WS_R, WS_H = WS_R, WS_FRAW = WS_R + 176 * MiB;
constexpr size_t WS_K = WS_R, WS_V = WS_R + 64 * MiB, WS_Q = WS_R + 128 * MiB, WS_O = WS_R + 192 * MiB;
constexpr size_t WS_GSS = WS_R + 340 * MiB;
constexpr size_t WS_END = 512 * MiB;
constexpr int CW_BAR = 4096;
constexpr size_t WS_SS1 = WS_LO + 256 * 1024, WS_SS2 = WS_LO + 384 * 1024, WS_SS3 = WS_LO + 512 * 1024;

constexpr int RING_BYTES = 131072;
constexpr int LDS_BYTES = 163840;
constexpr int LDSCTL_OFF = LDS_BYTES - 1024, MISC_OFF = LDSCTL_OFF + 320;

#define GAS __attribute__((address_space(1)))
#define LAS __attribute__((address_space(3)))
typedef unsigned short bf16;
typedef unsigned v4u __attribute__((ext_vector_type(4)));
typedef float f32x4 __attribute__((ext_vector_type(4)));
typedef short bf16x8 __attribute__((ext_vector_type(8)));
typedef GAS unsigned gu32;
typedef GAS unsigned long long gu64;
#define RLX_AGENT __ATOMIC_RELAXED, __HIP_MEMORY_SCOPE_AGENT
#define LDS_WAIT() asm volatile("s_waitcnt lgkmcnt(0)" ::: "memory")
#define VM_WAIT() asm volatile("s_waitcnt vmcnt(0)" ::: "memory")
__device__ __forceinline__ unsigned long long rt() { return __builtin_amdgcn_s_memrealtime(); }
typedef float f32x2_cv __attribute__((ext_vector_type(2))); typedef __bf16 bf16x2_cv __attribute__((ext_vector_type(2)));
__device__ __forceinline__ unsigned pk2(float lo, float hi) { f32x2_cv v = {lo, hi}; bf16x2_cv b = __builtin_convertvector(v, bf16x2_cv); return __builtin_bit_cast(unsigned, b); }
__device__ __forceinline__ unsigned f2bf(float f) { return pk2(f, f) & 0xffffu; }
#define XB_TMO      128
#define XB_XCNT(j)  (256  + 64 * (j))
#define XB_XSUB(j)  (1280 + 64 * (j))
#define XB_XGEN(j)  (2304 + 64 * (j))
#define XB_TOP      3328
#define XB_TOPGEN   3392
#define XCD_BAR_WORDS 3456
#define XB_SPIN_CAP (1u << 18)

__device__ __forceinline__ unsigned xb_ld(unsigned* p)              { return __hip_atomic_load(p, __ATOMIC_RELAXED, __HIP_MEMORY_SCOPE_AGENT); }
__device__ __forceinline__ unsigned xb_add(unsigned* p, unsigned v) { return __hip_atomic_fetch_add(p, v, __ATOMIC_RELAXED, __HIP_MEMORY_SCOPE_AGENT); }
__device__ __forceinline__ unsigned xb_xcc_id() { return (unsigned)__builtin_amdgcn_s_getreg((3 << 11) | 20) & 0xFu; }
#define XB_SPIN(cond, bar) do { unsigned _sp = 0; while (cond) { __builtin_amdgcn_s_sleep(1); \
    if ((++_sp & 255u) == 0u) { if (xb_ld(&(bar)[XB_TMO])) break; if (_sp > XB_SPIN_CAP) { atomicAdd(&(bar)[XB_TMO], 1u); break; } } } } while (0)

struct XcdBarrier {
    unsigned* bar; unsigned x;
    volatile LAS unsigned* st;
};

__device__ __forceinline__ XcdBarrier xcd_barrier_post(unsigned* bar, volatile LAS unsigned* st) {
    XcdBarrier b; b.bar = bar; b.x = xb_xcc_id(); b.st = st;
    if (threadIdx.x == 0) (void)xb_add(&bar[XB_XCNT(b.x)], 1u);
    return b;
}
__device__ __forceinline__ void xcd_barrier_complete(unsigned* bar, unsigned x, unsigned& nloc, unsigned& nx) {
    const unsigned G = gridDim.x * gridDim.y * gridDim.z;
    unsigned sum, cnt, mine, sp = 0u;
    for (;;) {
        sum = 0u; cnt = 0u; mine = 0u;
#pragma unroll
        for (unsigned j = 0; j < 16; ++j) { const unsigned c = xb_ld(&bar[XB_XCNT(j)]); sum += c; cnt += (c > 0u) ? 1u : 0u; mine = (j == x) ? c : mine; }
        if (sum == G) break;
        __builtin_amdgcn_s_sleep(1);
        if ((++sp & 255u) == 0u) { if (xb_ld(&bar[XB_TMO])) break; if (sp > XB_SPIN_CAP) { atomicAdd(&bar[XB_TMO], 1u); break; } }
    }
    nloc = mine > 0u ? mine : 1u; nx = cnt > 0u ? cnt : 1u;
}

__device__ __forceinline__ void xcd_barrier(const XcdBarrier& b) {
    asm volatile("s_waitcnt vmcnt(0)" ::: "memory");
    __syncthreads();
    if (threadIdx.x == 0) {
        unsigned* bar = b.bar;
        __builtin_amdgcn_s_waitcnt(0);
        unsigned nloc = b.st[0], nx = b.st[1];
        if (nloc == 0u) { xcd_barrier_complete(bar, b.x, nloc, nx); b.st[0] = nloc; b.st[1] = nx; }
        const unsigned old = xb_add(&bar[XB_XSUB(b.x)], 1u);
        const unsigned gen = old / nloc;
        if (old + 1u == (gen + 1u) * nloc) {
            __builtin_amdgcn_fence(__ATOMIC_RELEASE, "agent");
            asm volatile("s_waitcnt vmcnt(0)" ::: "memory");
            const unsigned og = xb_add(&bar[XB_TOP], 1u);
            const unsigned tg = og / nx;
            if (og + 1u == (tg + 1u) * nx) xb_add(&bar[XB_TOPGEN], 1u);
            else XB_SPIN(xb_ld(&bar[XB_TOPGEN]) == tg, bar);
            __builtin_amdgcn_fence(__ATOMIC_ACQUIRE, "agent");
            asm volatile("s_waitcnt vmcnt(0)" ::: "memory");
        } else {
            XB_SPIN(xb_ld(&bar[XB_TOPGEN]) == gen, bar);
            __builtin_amdgcn_fence(__ATOMIC_ACQUIRE, "agent");
            asm volatile("s_waitcnt vmcnt(0)" ::: "memory");
        }
    }
    __syncthreads();
}

struct Args { const float* in[25]; float* out; unsigned char* ws; int ph_lo, ph_hi; unsigned char prog[64]; };
template <int K> __device__ __forceinline__ const float* arg_in_() { const float* p_;
    asm volatile("s_load_dwordx2 %0, %1, %2\n\ts_waitcnt lgkmcnt(0)" : "=s"(p_) : "s"(__builtin_amdgcn_kernarg_segment_ptr()), "n"(K * 8)); return p_; }
#define ARG_IN(a_, k_) arg_in_<(k_)>()
__device__ __forceinline__ unsigned char* opaque_ws(const Args& a) { unsigned char* w = a.ws; asm volatile("" : "+s"(w)); return w; }

typedef unsigned u32x4v __attribute__((ext_vector_type(4)));
__device__ __forceinline__ float bf2f(bf16 v) { return __builtin_bit_cast(float, (unsigned)v << 16); }
__device__ __forceinline__ float wave_sum(float v) {
#pragma unroll
    for (int o = 1; o < 64; o <<= 1) v += shfl_xor_f(v, o);
    return v;
}
__device__ __forceinline__ float silu_f(float v) { return v * __builtin_amdgcn_rcpf(1.f + __builtin_amdgcn_exp2f(v * -1.4426950408889634f)); }

__device__ __forceinline__ void wprep_item(const float* W, int K, int Nsrc, int scol0, const float* gain, int gmask, float gscale,
                                           bf16* WT, int drow0, int k0, LAS float* scr, int lane) {
    float wv[32];
    asm volatile("" : "+s"(gscale));
    const float gl = gain ? gain[(k0 + lane) & gmask] * gscale : gscale;
#pragma unroll
    for (int i = 0; i < 32; ++i) { const int kk = 2 * i + (lane >> 5); wv[i] = W ? __builtin_nontemporal_load(W + (size_t)(k0 + kk) * Nsrc + scol0 + (lane & 31)) : 0.f; }
#pragma unroll
    for (int i = 0; i < 32; ++i) { const int kk = 2 * i + (lane >> 5);
        const float g0 = __builtin_bit_cast(float, __builtin_amdgcn_readlane(__builtin_bit_cast(int, gl), 2 * i)), g1 = __builtin_bit_cast(float, __builtin_amdgcn_readlane(__builtin_bit_cast(int, gl), 2 * i + 1));
        scr[kk * 33 + (lane & 31)] = wv[i] * ((lane >> 5) ? g1 : g0); }
    LDS_WAIT(); asm volatile("" ::: "memory");
    const int c = lane & 7;
#pragma unroll
    for (int j = 0; j < 4; ++j) { const int n = (lane >> 3) + 8 * j; const LAS float* s = scr + (8 * c) * 33 + n;
        v4u o; o.x = pk2(s[0 * 33], s[1 * 33]); o.y = pk2(s[2 * 33], s[3 * 33]); o.z = pk2(s[4 * 33], s[5 * 33]); o.w = pk2(s[6 * 33], s[7 * 33]);
        *(GAS v4u*)(WT + (size_t)(drow0 + n) * K + k0 + 8 * c) = o; }
    LDS_WAIT(); asm volatile("" ::: "memory");
}
__device__ __forceinline__ void rowstat_phase(const float* x, bf16* xb, float* rstd, int vcu, int NGW) {
    const int tid_ = opaque_tid(), lane = tid_ & 63, gw = vcu * NWAVES + __builtin_amdgcn_readfirstlane(tid_ >> 6);
    for (int m0 = gw * 2; m0 < M_TOK; m0 += NGW * 2) {
        f32x4 v[2][4]; float s[2];
#pragma unroll
        for (int r = 0; r < 2; ++r) { const GAS f32x4* xr = (const GAS f32x4*)(x + (size_t)(m0 + r) * DM) + lane;
#pragma unroll
            for (int j = 0; j < 4; ++j) v[r][j] = __builtin_nontemporal_load(xr + 64 * j); }
#pragma unroll
        for (int r = 0; r < 2; ++r) { float t = 0.f;
#pragma unroll
            for (int j = 0; j < 4; ++j) t += (v[r][j].x * v[r][j].x + v[r][j].y * v[r][j].y) + (v[r][j].z * v[r][j].z + v[r][j].w * v[r][j].w);
            s[r] = wave_sum(t);
            GAS unsigned long long* o8 = (GAS unsigned long long*)(xb + (size_t)(m0 + r) * DM) + lane;
#pragma unroll
            for (int j = 0; j < 4; ++j) o8[64 * j] = (unsigned long long)pk2(v[r][j].x, v[r][j].y) | ((unsigned long long)pk2(v[r][j].z, v[r][j].w) << 32); }
        if (lane < 2) rstd[m0 + lane] = lane ? s[1] : s[0];
    }
}
__device__ __forceinline__ void prep_phase(const Args& a, LAS unsigned char* lds, int vcu, int NGW, int part, int gw1 = 0, int ngw1 = 1) {
    const int tid_ = opaque_tid(), lane = tid_ & 63, wave = __builtin_amdgcn_readfirstlane(tid_ >> 6), gw = part ? gw1 * NWAVES + wave : vcu * NWAVES + wave;
    LAS float* scr = (LAS float*)(lds + wave * 16384);
    unsigned char* ws = opaque_ws(a);
    constexpr int I_IN = 16 * 168, I_OUT = 32 * 32, I_UP = 16 * 176, I_DN = 44 * 32, I_KV = 16 * 64, I_Q = 16 * 32, I_AO = 16 * 32;
    constexpr int N0 = I_IN + I_OUT + I_UP, N1 = I_UP + 2 * I_DN + I_KV + I_Q + I_AO;
    const int nit = part ? N1 : N0, step = part ? ngw1 * NWAVES : NGW;
    for (int it = gw; it < nit; it += step) {
        int r;
        if (part == 0) r = it;
        else r = I_IN + I_OUT + I_UP + it;
        if (r < I_IN) { const int kb = r / 168, db = r % 168;
            wprep_item(db < 161 ? ARG_IN(a, 2) : nullptr, 1024, NIN, 32 * db, ARG_IN(a, 1), 1023, 1.f, (bf16*)(ws + WS_WIN), 32 * db, 64 * kb, scr, lane); continue; } r -= I_IN;
        if (r < I_OUT) { const int kb = r / 32, db = r % 32;
            wprep_item(ARG_IN(a, 9), 2048, 1024, 32 * db, ARG_IN(a, 8), 2047, 1.f, (bf16*)(ws + WS_WOUT), 32 * db, 64 * kb, scr, lane); continue; } r -= I_OUT;
        if (r < 2 * I_UP) { const int l = r / I_UP; r -= l * I_UP; const int kb = r / 176, db = r % 176, j = db >> 3, q = db & 7;
            const int scol = (q < 4) ? (128 * j + 32 * q) : (FF + 128 * j + 32 * (q - 4));
            wprep_item(ARG_IN(a, 21) + (size_t)l * 1024 * FF2, 1024, FF2, scol, ARG_IN(a, 20) + l * 1024, 1023, 1.f, (bf16*)(ws + (l ? WS_WUP1 : WS_WUP0)), 32 * db, 64 * kb, scr, lane); continue; } r -= 2 * I_UP;
        if (r < 2 * I_DN) { const int l = r / I_DN; r -= l * I_DN; const int kb = r / 32, db = r % 32;
            wprep_item(ARG_IN(a, 24) + (size_t)l * FF * 1024, FF, 1024, 32 * db, nullptr, 0, 1.f, (bf16*)(ws + (l ? WS_WDN1 : WS_WDN0)), 32 * db, 64 * kb, scr, lane); continue; } r -= 2 * I_DN;
        if (r < I_KV) { const int kb = r / 64, db = r % 64, q = db & 7;
            wprep_item(ARG_IN(a, 11), 1024, 2048, 256 * (db >> 3) + 64 * (q & 3) + 32 * (q >> 2), ARG_IN(a, 10), 1023, 1.f, (bf16*)(ws + WS_WKVQ), 32 * db, 64 * kb, scr, lane); continue; } r -= I_KV;
        if (r < I_Q) { const int kb = r / 32, db = r % 32, q = db & 7;
            wprep_item(ARG_IN(a, 15), 1024, 1024, 256 * (db >> 3) + 64 * (q & 3) + 32 * (q >> 2), ARG_IN(a, 14), 1023, 1.f, (bf16*)(ws + WS_WKVQ), 2048 + 32 * db, 64 * kb, scr, lane); continue; } r -= I_Q;
        { const int kb = r / 32, db = r % 32;
            wprep_item(ARG_IN(a, 19), 1024, 1024, 32 * db, ARG_IN(a, 18), 127, 1.f - LAM_INIT, (bf16*)(ws + WS_WAO), 32 * db, 64 * kb, scr, lane); }
    }
    if (part == 0) rowstat_phase(ARG_IN(a, 0), (bf16*)(ws + WS_XB), (float*)(ws + WS_RSTD), vcu, NGW);
}

__device__ __forceinline__ void ssd_naive_phase(const Args& a, LAS unsigned char* lds) {
    const int tid = opaque_tid();
    LAS float* cx = (LAS float*)lds;
    LAS float* cB = cx + 64 * 64;
    LAS float* cC = cB + 64 * 128;
    LAS float* cdA = cC + 64 * 128;
    LAS float* cdt = cdA + 64;
    const bf16* XBC = (const bf16*)(opaque_ws(a) + WS_XBC); bf16* Z = (bf16*)(opaque_ws(a) + WS_Z); const float* DT = (const float*)(opaque_ws(a) + WS_DT);
    const float* conv_w = ARG_IN(a, 3); const float* conv_b = ARG_IN(a, 4);
    const int p = tid >> 3, ns = (tid & 7) * 16;
    for (int item = blockIdx.x; item < NBATCH * SSM_H; item += gridDim.x) {
        const int b = item >> 5, h = item & 31, g = h >> 3;
        const float Aneg = -__expf(ARG_IN(a, 6)[h]), dtb = ARG_IN(a, 5)[h], Dh = ARG_IN(a, 7)[h];
        float hst[16];
#pragma unroll
        for (int i = 0; i < 16; ++i) hst[i] = 0.f;
        for (int t0 = 0; t0 < SEQ; t0 += 64) {
            for (int e = tid; e < 64 * 320; e += 512) {
                const int tt = e / 320, j = e - tt * 320;
                const int col = j < 64 ? 64 * h + j : (j < 192 ? 2048 + 128 * g + (j - 64) : 2560 + 128 * g + (j - 192));
                const int t = t0 + tt;
                float v = conv_b[col];
#pragma unroll
                for (int k = 0; k < 4; ++k) { const int ts = t - 3 + k; if (ts >= 0) v += conv_w[k * NXBC + col] * bf2f(XBC[(size_t)(b * SEQ + ts) * NXBC + col]); }
                v = silu_f(v);
                if (j < 64) cx[tt * 64 + j] = v; else if (j < 192) cB[tt * 128 + (j - 64)] = v; else cC[tt * 128 + (j - 192)] = v;
            }
            if (tid < 64) { const float raw = DT[(size_t)(b * SEQ + t0 + tid) * 32 + h] + dtb; const float dtv = raw > 20.f ? raw : log1pf(__expf(raw)); cdt[tid] = dtv; cdA[tid] = __expf(dtv * Aneg); }
            __syncthreads();
            for (int tt = 0; tt < 64; ++tt) {
                const float xv = cx[tt * 64 + p], dA = cdA[tt], xdt = xv * cdt[tt];
                float acc = 0.f;
#pragma unroll
                for (int i = 0; i < 16; ++i) { hst[i] = dA * hst[i] + xdt * cB[tt * 128 + ns + i]; acc += cC[tt * 128 + ns + i] * hst[i]; }
                acc += shfl_xor_f(acc, 1); acc += shfl_xor_f(acc, 2); acc += shfl_xor_f(acc, 4);
                if ((tid & 7) == 0) { const size_t idx = (size_t)(b * SEQ + t0 + tt) * DIN + 64 * h + p; const float z = bf2f(Z[idx]); Z[idx] = (bf16)f2bf((acc + xv * Dh) * silu_f(z)); }
            }
            __syncthreads();
        }
    }
}
__device__ __forceinline__ void unpack8(const v4u w, float (&f)[8]) {
    f[0] = __builtin_bit_cast(float, w.x << 16); f[1] = __builtin_bit_cast(float, w.x & 0xffff0000u); f[2] = __builtin_bit_cast(float, w.y << 16); f[3] = __builtin_bit_cast(float, w.y & 0xffff0000u);
    f[4] = __builtin_bit_cast(float, w.z << 16); f[5] = __builtin_bit_cast(float, w.z & 0xffff0000u); f[6] = __builtin_bit_cast(float, w.w << 16); f[7] = __builtin_bit_cast(float, w.w & 0xffff0000u);
}
__device__ __forceinline__ void groupnorm_phase(const Args& a, int vcu, int NGW) {
    const int tid_ = opaque_tid(), lane = tid_ & 63, gw = vcu * NWAVES + __builtin_amdgcn_readfirstlane(tid_ >> 6);
    bf16* Z = (bf16*)(opaque_ws(a) + WS_Z);
    for (int i = gw; i < M_TOK * 4; i += NGW) {
        GAS v4u* p = (GAS v4u*)(Z + (size_t)i * 512) + lane;
        float f[8]; unpack8(*p, f);
        float s = 0.f;
#pragma unroll
        for (int j = 0; j < 8; ++j) s += f[j] * f[j];
        s = wave_sum(s);
        const float r = 1.f / sqrtf(s * (1.f / 512.f) + EPS);
        v4u o; o.x = pk2(f[0] * r, f[1] * r); o.y = pk2(f[2] * r, f[3] * r); o.z = pk2(f[4] * r, f[5] * r); o.w = pk2(f[6] * r, f[7] * r);
        *p = o;
    }
}
__device__ __forceinline__ void convact_phase(const Args& a, int layer, int r0) {
    const bf16* U = (const bf16*)(opaque_ws(a) + WS_U); bf16* H = (bf16*)(opaque_ws(a) + WS_H);
    const float* cw = ARG_IN(a, 22) + (size_t)layer * 3 * FF2; const float* cb = ARG_IN(a, 23) + (size_t)layer * FF2;
    constexpr int NG = FF / 8, NITEMS = (MH / 32) * NG;
    const int nthr = gridDim.x * 512;
    for (int item = blockIdx.x * 512 + opaque_tid(); item < NITEMS; item += nthr) {
        const int seg = item / NG, c = (item - seg * NG) * 8, gcol = 256 * (c >> 7) + (c & 127);
        const int t1 = seg * 32, tseq = (r0 + t1) & (SEQ - 1);
        float wg[3][8], wu[3][8], bg[8], bu[8];
#pragma unroll
        for (int q = 0; q < 2; ++q) {
            const f32x4 x = *(const GAS f32x4*)(cb + c + 4 * q), y = *(const GAS f32x4*)(cb + FF + c + 4 * q);
#pragma unroll
            for (int e = 0; e < 4; ++e) { bg[4 * q + e] = x[e]; bu[4 * q + e] = y[e]; }
#pragma unroll
            for (int k = 0; k < 3; ++k) { const f32x4 xg = *(const GAS f32x4*)(cw + k * FF2 + c + 4 * q), xu = *(const GAS f32x4*)(cw + k * FF2 + FF + c + 4 * q);
#pragma unroll
                for (int e = 0; e < 4; ++e) { wg[k][4 * q + e] = xg[e]; wu[k][4 * q + e] = xu[e]; } }
        }
        const bf16* up = U + (size_t)t1 * FF2 + gcol;
        v4u g2 = {0u, 0u, 0u, 0u}, g1 = g2, u2 = g2, u1 = g2;
        if (tseq != 0) { g2 = *(const GAS v4u*)(up - 2 * (ptrdiff_t)FF2); u2 = *(const GAS v4u*)(up - 2 * (ptrdiff_t)FF2 + 128); g1 = *(const GAS v4u*)(up - (ptrdiff_t)FF2); u1 = *(const GAS v4u*)(up - (ptrdiff_t)FF2 + 128); }
        bf16* hp = H + (size_t)t1 * FF + c;
#pragma unroll 8
        for (int rr = 0; rr < 32; ++rr) {
            const v4u g0 = *(const GAS v4u*)(up + (size_t)rr * FF2), u0 = *(const GAS v4u*)(up + (size_t)rr * FF2 + 128);
            float a2[8], a1[8], a0[8], b2[8], b1[8], b0[8];
            unpack8(g2, a2); unpack8(g1, a1); unpack8(g0, a0); unpack8(u2, b2); unpack8(u1, b1); unpack8(u0, b0);
            float hv[8];
#pragma unroll
            for (int e = 0; e < 8; ++e) { const float gg = bg[e] + wg[0][e] * a2[e] + wg[1][e] * a1[e] + wg[2][e] * a0[e], uu = bu[e] + wu[0][e] * b2[e] + wu[1][e] * b1[e] + wu[2][e] * b0[e]; hv[e] = silu_f(gg) * uu; }
            *(GAS v4u*)(hp + (size_t)rr * FF) = (v4u){pk2(hv[0], hv[1]), pk2(hv[2], hv[3]), pk2(hv[4], hv[5]), pk2(hv[6], hv[7])};
            g2 = g1; g1 = g0; u2 = u1; u1 = u0;
        }
    }
}
__device__ __forceinline__ void bcconv_phase(const Args& a) {
    const bf16* XBC = (const bf16*)(opaque_ws(a) + WS_XBC); bf16* BCc = (bf16*)(opaque_ws(a) + WS_XB);
    const float* cw = ARG_IN(a, 3); const float* cb = ARG_IN(a, 4);
    constexpr int NG = 1024 / 8, NITEMS = (M_TOK / 32) * NG;
    const int nthr = gridDim.x * 512;
    for (int item = blockIdx.x * 512 + opaque_tid(); item < NITEMS; item += nthr) {
        const int seg = item / NG, c = (item - seg * NG) * 8, t1 = seg * 32, tseq = t1 & (SEQ - 1);
        float w[4][8], bb[8];
#pragma unroll
        for (int q = 0; q < 2; ++q) { const f32x4 x = *(const GAS f32x4*)(cb + 2048 + c + 4 * q);
#pragma unroll
            for (int e = 0; e < 4; ++e) bb[4 * q + e] = x[e];
#pragma unroll
            for (int k = 0; k < 4; ++k) { const f32x4 y = *(const GAS f32x4*)(cw + k * NXBC + 2048 + c + 4 * q);
#pragma unroll
                for (int e = 0; e < 4; ++e) w[k][4 * q + e] = y[e]; } }
        const bf16* sp = XBC + (size_t)t1 * NXBC + 2048 + c;
        v4u r3 = {0u, 0u, 0u, 0u}, r2 = r3, r1 = r3;
        if (tseq != 0) { r3 = *(const GAS v4u*)(sp - 3 * (ptrdiff_t)NXBC); r2 = *(const GAS v4u*)(sp - 2 * (ptrdiff_t)NXBC); r1 = *(const GAS v4u*)(sp - (ptrdiff_t)NXBC); }
        bf16* dp = BCc + (size_t)t1 * 1024 + c;
#pragma unroll 8
        for (int rr = 0; rr < 32; ++rr) {
            const v4u r0 = *(const GAS v4u*)(sp + (size_t)rr * NXBC);
            float a3[8], a2[8], a1[8], a0[8]; unpack8(r3, a3); unpack8(r2, a2); unpack8(r1, a1); unpack8(r0, a0);
            float o[8];
#pragma unroll
            for (int e = 0; e < 8; ++e) o[e] = silu_f(bb[e] + w[0][e] * a3[e] + w[1][e] * a2[e] + w[2][e] * a1[e] + w[3][e] * a0[e]);
            *(GAS v4u*)(dp + (size_t)rr * 1024) = (v4u){pk2(o[0], o[1]), pk2(o[2], o[3]), pk2(o[4], o[5]), pk2(o[6], o[7])};
            r3 = r2; r2 = r1; r1 = r0;
        }
    }
}
__device__ __forceinline__ void ssmconv_fixup_phase(const Args& a) {
    const bf16* raw = (const bf16*)(opaque_ws(a) + WS_XRAW); bf16* XBC = (bf16*)(opaque_ws(a) + WS_XBC);
    const float* cw = ARG_IN(a, 3); const float* cb = ARG_IN(a, 4);
    static_assert((M_TOK / 256) * NXBC == 3 * 256 * 512, "ssmconv_fixup_phase: three trips");
    const int e0 = blockIdx.x * 512 + opaque_tid();
    float x[3][6], w[3][5];
#pragma unroll
    for (int it = 0; it < 3; ++it) {
        const int e = e0 + it * 256 * 512, pm = e / NXBC, col = e - pm * NXBC;
        const int rc = (col >> 8) * 256 + ((col >> 5) & 3) * 64 + ((col >> 7) & 1) * 32 + (col & 31);
#pragma unroll
        for (int k = 0; k < 3; ++k) {
            x[it][k] = ((pm & 7) != 0) ? bf2f(raw[((size_t)(pm - 1) * 6 + 3 + k) * NXBC + rc]) : 0.f;
            x[it][3 + k] = bf2f(raw[((size_t)pm * 6 + k) * NXBC + rc]);
        }
#pragma unroll
        for (int k = 0; k < 4; ++k) w[it][k] = cw[k * NXBC + col];
        w[it][4] = cb[col];
    }
#pragma unroll
    for (int it = 0; it < 3; ++it) {
        const int e = e0 + it * 256 * 512, pm = e / NXBC, col = e - pm * NXBC;
#pragma unroll
        for (int r = 0; r < 3; ++r) {
            const float v = w[it][4] + w[it][0] * x[it][r] + w[it][1] * x[it][r + 1] + w[it][2] * x[it][r + 2] + w[it][3] * x[it][r + 3];
            XBC[(size_t)(pm * 256 + r) * NXBC + col] = (bf16)f2bf(silu_f(v));
        }
    }
}
__device__ __forceinline__ void convffn_fixup_phase(const Args& a, int layer) {
    const bf16* raw = (const bf16*)(opaque_ws(a) + WS_FRAW); bf16* H = (bf16*)(opaque_ws(a) + WS_H);
    const float* cw = ARG_IN(a, 22) + (size_t)layer * 3 * FF2; const float* cb = ARG_IN(a, 23) + (size_t)layer * FF2;
    const int e0 = blockIdx.x * 512 + opaque_tid();
    float g[3][4], u[3][4], wg[3][4], wu[3][4];
#pragma unroll
    for (int it = 0; it < 3; ++it) {
        const int e = e0 + it * 256 * 512; const bool ok = e < (M_TOK / 256) * FF; const int ee = ok ? e : 0, pm = ee / FF, ch = ee - pm * FF;
        const int col = (ch >> 7) * 256 + ((ch >> 5) & 3) * 64 + (ch & 31);
#pragma unroll
        for (int k = 0; k < 2; ++k) {
            if ((pm & 7) != 0) { const bf16* p = raw + ((size_t)(pm - 1) * 4 + 2 + k) * 22 * 256 + col; g[it][k] = bf2f(p[0]); u[it][k] = bf2f(p[32]); } else { g[it][k] = 0.f; u[it][k] = 0.f; }
            const bf16* q = raw + ((size_t)pm * 4 + k) * 22 * 256 + col; g[it][2 + k] = bf2f(q[0]); u[it][2 + k] = bf2f(q[32]);
        }
#pragma unroll
        for (int k = 0; k < 3; ++k) { wg[it][k] = cw[k * FF2 + ch]; wu[it][k] = cw[k * FF2 + FF + ch]; }
        wg[it][3] = cb[ch]; wu[it][3] = cb[FF + ch];
    }
#pragma unroll
    for (int it = 0; it < 3; ++it) {
        const int e = e0 + it * 256 * 512; const bool ok = e < (M_TOK / 256) * FF; const int ee = ok ? e : 0, pm = ee / FF, ch = ee - pm * FF;
#pragma unroll
        for (int r = 0; r < 2; ++r) {
            const float cg = wg[it][3] + wg[it][0] * g[it][r] + wg[it][1] * g[it][r + 1] + wg[it][2] * g[it][r + 2];
            const float cu = wu[it][3] + wu[it][0] * u[it][r] + wu[it][1] * u[it][r + 1] + wu[it][2] * u[it][r + 2];
            if (ok) H[(size_t)(pm * 256 + r) * FF + ch] = (bf16)f2bf(silu_f(cg) * cu);
        }
    }
}
__device__ __forceinline__ void qknorm_phase(const Args& a, int vcu, int NGW) {
    const int tid_ = opaque_tid(), lane = tid_ & 63, gw = vcu * NWAVES + __builtin_amdgcn_readfirstlane(tid_ >> 6);
    for (int i = gw; i < M_TOK * 2; i += NGW) {
        const int tok = i >> 1, isq = i & 1;
        bf16* base = (bf16*)(opaque_ws(a) + (isq ? WS_Q : WS_K)) + (size_t)tok * 1024 + lane * 16;
        const float* g = (isq ? ARG_IN(a, 16) : ARG_IN(a, 12)) + (lane & 3) * 16; const float sc = isq ? QSCALE : 1.f;
        const v4u w0 = *(const GAS v4u*)base, w1 = *(const GAS v4u*)(base + 8);
        const unsigned ww[8] = {w0.x, w0.y, w0.z, w0.w, w1.x, w1.y, w1.z, w1.w};
        float f[16]; float s = 0.f;
#pragma unroll
        for (int q = 0; q < 8; ++q) { f[2 * q] = __builtin_bit_cast(float, ww[q] << 16); f[2 * q + 1] = __builtin_bit_cast(float, ww[q] & 0xffff0000u); s += f[2 * q] * f[2 * q] + f[2 * q + 1] * f[2 * q + 1]; }
        s += shfl_xor_f(s, 1); s += shfl_xor_f(s, 2);
        const float r = sc / sqrtf(s * (1.f / 64.f) + EPS);
        unsigned o[8];
#pragma unroll
        for (int q = 0; q < 8; ++q) o[q] = pk2(f[2 * q] * r * g[2 * q], f[2 * q + 1] * r * g[2 * q + 1]);
        *(GAS v4u*)base = (v4u){o[0], o[1], o[2], o[3]}; *(GAS v4u*)(base + 8) = (v4u){o[4], o[5], o[6], o[7]};
    }
}
__device__ __forceinline__ int t5_bucket(int n) {
    if (n < 16) return n;
    int l = 16 + (int)(__logf((float)n / 16.f) / 2.0794415416798357f * 16.f);
    return l < 31 ? l : 31;
}
__device__ __forceinline__ void attn_naive_phase(const Args& a, LAS unsigned char* lds) {
    const int tid = opaque_tid(), lane = tid & 63;
    LAS float* Qs = (LAS float*)lds;
    LAS float* Ks = Qs + 64 * 129;
    LAS float* Vs = Ks + 64 * 129;
    LAS float* Ws = Vs + 64 * 128;
    LAS float* btab = Ws + 64 * 65;
    const bf16* Kb = (const bf16*)(opaque_ws(a) + WS_K); const bf16* Vb = (const bf16*)(opaque_ws(a) + WS_V); bf16* Qb = (bf16*)(opaque_ws(a) + WS_Q);
    const float* rel_bias = ARG_IN(a, 13); const float* lv = ARG_IN(a, 17);
    const int r = tid >> 3, ks = tid & 7;
    for (int item = blockIdx.x; item < 4096; item += gridDim.x) {
        const int qb = 31 - (item >> 7), bh = item & 127, b = bh >> 3, h = bh & 7;
        const size_t row0 = (size_t)b * SEQ + qb * 64;
        __syncthreads();
        for (int e = tid; e < 64 * 128; e += 512) { const int rr = e >> 7, c = e & 127; Qs[rr * 129 + c] = bf2f(Qb[(row0 + rr) * 1024 + h * 128 + c]); }
        if (tid < 129) { const int bk = t5_bucket(tid); btab[tid] = rel_bias[bk * 8 + h] * LOG2E; }
        if (tid < 64) { float s0 = lv[tid] * lv[64 + tid], s1 = lv[128 + tid] * lv[192 + tid]; s0 = wave_sum(s0); s1 = wave_sum(s1); if (tid == 0) btab[129] = __expf(s0) - __expf(s1) + LAM_INIT; }
        const int qpos = qb * 64 + r;
        float m0 = -1e30f, l0 = 0.f, m1 = -1e30f, l1 = 0.f;
        for (int kt = 0; kt <= qb; ++kt) {
            __syncthreads();
            for (int e = tid; e < 64 * 128; e += 512) { const int kk = e >> 7, c = e & 127; Ks[kk * 129 + c] = bf2f(Kb[((size_t)b * SEQ + kt * 64 + kk) * 1024 + h * 128 + c]); }
            __syncthreads();
            float s0[8], s1[8];
#pragma unroll
            for (int i = 0; i < 8; ++i) { s0[i] = 0.f; s1[i] = 0.f; }
            for (int d = 0; d < 64; ++d) { const float q0 = Qs[r * 129 + d], q1 = Qs[r * 129 + 64 + d];
#pragma unroll
                for (int i = 0; i < 8; ++i) { s0[i] += q0 * Ks[(ks * 8 + i) * 129 + d]; s1[i] += q1 * Ks[(ks * 8 + i) * 129 + 64 + d]; } }
#pragma unroll
            for (int i = 0; i < 8; ++i) { const int kpos = kt * 64 + ks * 8 + i;
                if (kpos <= qpos) { const int dist = qpos - kpos; const float bb = btab[dist < 128 ? dist : 128];
                    const float a0 = s0[i] + bb, a1 = s1[i] + bb;
                    float mn = fmaxf(m0, a0); l0 = l0 * exp2f(m0 - mn) + exp2f(a0 - mn); m0 = mn;
                    mn = fmaxf(m1, a1); l1 = l1 * exp2f(m1 - mn) + exp2f(a1 - mn); m1 = mn; } }
        }
#pragma unroll
        for (int off = 1; off < 8; off <<= 1) {
            float mo = shfl_xor_f(m0, off), lo = shfl_xor_f(l0, off); float mn = fmaxf(m0, mo); l0 = l0 * exp2f(m0 - mn) + lo * exp2f(mo - mn); m0 = mn;
            mo = shfl_xor_f(m1, off); lo = shfl_xor_f(l1, off); mn = fmaxf(m1, mo); l1 = l1 * exp2f(m1 - mn) + lo * exp2f(mo - mn); m1 = mn;
        }
        const float inv0 = 1.f / l0, inv1 = 1.f / l1, lam = btab[129];
        float o[16];
#pragma unroll
        for (int d = 0; d < 16; ++d) o[d] = 0.f;
        for (int kt = 0; kt <= qb; ++kt) {
            __syncthreads();
            for (int e = tid; e < 64 * 128; e += 512) { const int kk = e >> 7, c = e & 127; const size_t gi = ((size_t)b * SEQ + kt * 64 + kk) * 1024 + h * 128 + c;
                Ks[kk * 129 + c] = bf2f(Kb[gi]); Vs[kk * 128 + c] = bf2f(Vb[gi]); }
            __syncthreads();
            float s0[8], s1[8];
#pragma unroll
            for (int i = 0; i < 8; ++i) { s0[i] = 0.f; s1[i] = 0.f; }
            for (int d = 0; d < 64; ++d) { const float q0 = Qs[r * 129 + d], q1 = Qs[r * 129 + 64 + d];
#pragma unroll
                for (int i = 0; i < 8; ++i) { s0[i] += q0 * Ks[(ks * 8 + i) * 129 + d]; s1[i] += q1 * Ks[(ks * 8 + i) * 129 + 64 + d]; } }
#pragma unroll
            for (int i = 0; i < 8; ++i) { const int kpos = kt * 64 + ks * 8 + i; float w = 0.f;
                if (kpos <= qpos) { const int dist = qpos - kpos; const float bb = btab[dist < 128 ? dist : 128];
                    w = exp2f(s0[i] + bb - m0) * inv0 - lam * exp2f(s1[i] + bb - m1) * inv1; }
                Ws[r * 65 + ks * 8 + i] = w; }
            __syncthreads();
            for (int kk = 0; kk < 64; ++kk) { const float w = Ws[r * 65 + kk];
#pragma unroll
                for (int d = 0; d < 16; ++d) o[d] += w * Vs[kk * 128 + ks * 16 + d]; }
        }
        float ss = 0.f;
#pragma unroll
        for (int d = 0; d < 16; ++d) ss += o[d] * o[d];
        ss += shfl_xor_f(ss, 1); ss += shfl_xor_f(ss, 2); ss += shfl_xor_f(ss, 4);
        const float rs = 1.f / sqrtf(ss * (1.f / 128.f) + EPS);
        bf16* op = Qb + (row0 + r) * 1024 + h * 128 + ks * 16;
        *(GAS v4u*)op = (v4u){pk2(o[0] * rs, o[1] * rs), pk2(o[2] * rs, o[3] * rs), pk2(o[4] * rs, o[5] * rs), pk2(o[6] * rs, o[7] * rs)};
        *(GAS v4u*)(op + 8) = (v4u){pk2(o[8] * rs, o[9] * rs), pk2(o[10] * rs, o[11] * rs), pk2(o[12] * rs, o[13] * rs), pk2(o[14] * rs, o[15] * rs)};
        (void)lane;
    }
}

typedef float f32x16 __attribute__((ext_vector_type(16)));
typedef short s16x4 __attribute__((ext_vector_type(4)));
typedef short v4i16_t __attribute__((ext_vector_type(4)));
__device__ __forceinline__ int crow(int r, int hi) { return (r & 3) + 8 * (r >> 2) + 4 * hi; }
__device__ __forceinline__ s16x4 vtr(const LAS unsigned char* p) { return __builtin_bit_cast(s16x4, __builtin_amdgcn_ds_read_tr16_b64_v4i16((LAS v4i16_t*)p)); }
template <int CTRL> __device__ __forceinline__ float dpp_add(float v) { return v + __builtin_bit_cast(float, __builtin_amdgcn_update_dpp(0, __builtin_bit_cast(int, v), CTRL, 0xf, 0xf, true)); }
__device__ __forceinline__ float red32(float v) {
    v = dpp_add<0xB1>(v); v = dpp_add<0x4E>(v); v = dpp_add<0x141>(v); v = dpp_add<0x140>(v);
    return v + __builtin_bit_cast(float, __builtin_amdgcn_ds_swizzle(__builtin_bit_cast(int, v), 0x401F));
}
__device__ __forceinline__ float wave_max(float v) {
#pragma unroll
    for (int o = 1; o < 64; o <<= 1) v = fmaxf(v, shfl_xor_f(v, o));
    return v;
}
__device__ __forceinline__ void glds16(const void* sbase, unsigned voff, unsigned lds_dst) { unsigned keep;
    asm volatile("s_nop 4\n\ts_mov_b32 %0, m0\n\ts_mov_b32 m0, %3\n\ts_nop 0\n\tglobal_load_lds_dwordx4 %1, %2\n\ts_mov_b32 m0, %0" : "=&s"(keep) : "v"(voff), "s"(sbase), "s"(lds_dst) : "memory"); }
#ifndef ATT_PRIO
#define ATT_PRIO 1
#endif
#ifdef ATT_PROBE_SEC
#define ATT_T0() long long tsec_ = __builtin_amdgcn_s_memrealtime()
#define ATT_T1(sec_) do { const long long now_ = __builtin_amdgcn_s_memrealtime(); if (ATT_PROBE_SEC == (sec_)) { const long long tgt_ = now_ + 2 * (now_ - tsec_); \
        while ((long long)__builtin_amdgcn_s_memrealtime() < tgt_) __builtin_amdgcn_s_sleep(4); } tsec_ = __builtin_amdgcn_s_memrealtime(); } while (0)
#else
#define ATT_T0() do {} while (0)
#define ATT_T1(sec_) do {} while (0)
#endif
__device__ __forceinline__ void attn_fast_phase(const Args& a, LAS unsigned char* lds, int vcu) {
    const int tid = opaque_tid(), lane = tid & 63, wid = __builtin_amdgcn_readfirstlane(tid >> 6), r32 = lane & 31, hi = lane >> 5;
    const int comp = wid >> 2, wq = wid & 3;
    const bf16* Kb = (const bf16*)(opaque_ws(a) + WS_K); const bf16* Vb = (const bf16*)(opaque_ws(a) + WS_V); const bf16* Qb = (const bf16*)(opaque_ws(a) + WS_Q); bf16* Ob = (bf16*)(opaque_ws(a) + WS_O);
    const float* rel_bias = ARG_IN(a, 13); const float* lv = ARG_IN(a, 17);
    LAS float* misc = (LAS float*)(lds + 131072);
    LAS float* wsf = misc + 256 + wid * 32;
    LAS float* X = (LAS float*)lds;
    const unsigned lds0 = (unsigned)(uintptr_t)lds;
    LAS float* tabs = misc + 512;
    { const int k = tid >> 7, d = tid & 127, hk = (4 * (vcu >> 3) + k) & 7;
      tabs[k * 132 + d] = rel_bias[t5_bucket(d) * 8 + hk] * LOG2E;
      if (d == 0) tabs[k * 132 + 128] = rel_bias[31 * 8 + hk] * LOG2E; }
    LAS float* t2 = misc + 1280;
    for (int e = tid; e < 4 * 384; e += NWAVES * 64) { const int k = e / 384, j = e - k * 384, d = 255 - j, hk = (4 * (vcu >> 3) + k) & 7;
        t2[e] = d < 0 ? -INFINITY : rel_bias[(d < 128 ? t5_bucket(d) : 31) * 8 + hk] * LOG2E; }
    if (wid < 4) {
        const int hk = (4 * (vcu >> 3) + wid) & 7;
        float s0 = lv[lane] * lv[64 + lane], s1 = lv[128 + lane] * lv[192 + lane]; s0 = wave_sum(s0); s1 = wave_sum(s1);
        const float gq = wave_max(fabsf(ARG_IN(a, 16)[lane])), gk = wave_max(fabsf(ARG_IN(a, 12)[lane]));
        const float bm = wave_max(lane < 32 ? rel_bias[lane * 8 + hk] * LOG2E : -1e30f);
        if (lane == 0) { tabs[wid * 132 + 129] = __expf(s0) - __expf(s1) + LAM_INIT; tabs[wid * 132 + 131] = QSCALE * 64.f * gq * gk + bm; }
    }
    __syncthreads();
    bf16x8 qn[4];
    { const int bh0 = 4 * (vcu >> 3), qb0 = vcu & 7;
      const bf16* qp0 = Qb + ((size_t)(bh0 >> 3) * SEQ + qb0 * 128 + 32 * wq + r32) * 1024 + (bh0 & 7) * 128 + comp * 64 + 8 * hi;
#pragma unroll
      for (int ks = 0; ks < 4; ++ks) qn[ks] = *(const GAS bf16x8*)(qp0 + 16 * ks); }
    for (int j = 0; j < 8; ++j) { ATT_T0();
        const int bh = 4 * (vcu >> 3) + (j >> 1), s8 = vcu & 7, qb = (j & 1) ? 15 - s8 : s8;
        const int b = bh >> 3, h = bh & 7;
        const size_t tok0 = (size_t)b * SEQ;
        const int q0 = qb * 128;
        const LAS float* mt = tabs + (j >> 1) * 132;
        bf16x8 qr[4];
#pragma unroll
        for (int ks = 0; ks < 4; ++ks) qr[ks] = qn[ks];
        f32x16 o[4];
#pragma unroll
        for (int d = 0; d < 4; ++d)
#pragma unroll
            for (int r = 0; r < 16; ++r) o[d][r] = 0.f;
        float lsum = 0.f;
        const int NT = 2 * (qb + 1);
        const bf16* ksrc0 = Kb + tok0 * 1024 + h * 128;
        const unsigned kvoff = ((lane >> 2) * 1024 + 8 * ((lane & 3) ^ ((lane >> 4) & 3))) * 2, vvoff = ((lane >> 2) * 1024 + 8 * (lane & 3)) * 2;
        const bf16* vsrc0 = Vb + tok0 * 1024 + h * 128;
#define ATT_DMA_TILE(t, slot) do { _Pragma("unroll") for (int i_ = 0; i_ < 2; ++i_) { const int pk_ = wid + 8 * i_, d32_ = pk_ >> 2, k16_ = pk_ & 3; \
            glds16(ksrc0 + (size_t)(64 * (t) + 16 * k16_) * 1024 + 32 * d32_, kvoff, (unsigned)__builtin_amdgcn_readfirstlane((int)(lds0 + (slot) * 32768 + pk_ * 1024))); } \
        _Pragma("unroll") for (int i_ = 0; i_ < 2; ++i_) { const int pv_ = wid + 8 * i_, dvb_ = pv_ >> 2, k16_ = pv_ & 3; \
            glds16(vsrc0 + (size_t)(64 * (t) + 16 * k16_) * 1024 + 32 * dvb_, vvoff, (unsigned)__builtin_amdgcn_readfirstlane((int)(lds0 + (slot) * 32768 + 16384 + pv_ * 1024))); } } while (0)
        ATT_DMA_TILE(0, 0); ATT_DMA_TILE(1, 1);
        if (NT > 2) ATT_DMA_TILE(2, 2);
        asm volatile("" : "+v"(qr[0]), "+v"(qr[1]), "+v"(qr[2]), "+v"(qr[3]));
        if (NT > 2) asm volatile("s_waitcnt vmcnt(8) lgkmcnt(0)" ::: "memory"); else asm volatile("s_waitcnt vmcnt(4) lgkmcnt(0)" ::: "memory");
        __builtin_amdgcn_s_barrier(); asm volatile("" ::: "memory"); ATT_T1(0);
        const float cfar = mt[128] - mt[131], cnear = -mt[131];
        const int qpos = q0 + 32 * wq + r32;
        f32x16 cfarv;
#pragma unroll
        for (int r = 0; r < 16; ++r) cfarv[r] = cfar;
        asm volatile("" : "+v"(cfarv));
        bf16x8 kf_[8];
#define ATT_KREAD(slot_) do { const LAS unsigned char* kb_ = lds + (slot_) * 32768 + (r32 >> 4) * 1024 + (r32 & 15) * 64; \
            _Pragma("unroll") for (int ks = 0; ks < 4; ++ks) { const int po_ = (comp * 2 + (ks >> 1)) * 4096 + ((((ks & 1) * 2 + hi) ^ ((r32 >> 2) & 3)) * 16); \
                kf_[2 * ks] = *(const LAS bf16x8*)(kb_ + po_); kf_[2 * ks + 1] = *(const LAS bf16x8*)(kb_ + po_ + 2048); } asm volatile("" ::: "memory"); } while (0)
#define ATT_QK(P0, P1, tt, slot_) do { \
              \
            __builtin_amdgcn_s_setprio(ATT_PRIO); if ((tt) >= NT - 4) { f32x16 cn_; _Pragma("unroll") for (int r = 0; r < 16; ++r) cn_[r] = cnear; \
                P0 = __builtin_amdgcn_mfma_f32_32x32x16_bf16(kf_[0], qr[0], cn_, 0, 0, 0); P1 = __builtin_amdgcn_mfma_f32_32x32x16_bf16(kf_[1], qr[0], cn_, 0, 0, 0); } \
            else { P0 = __builtin_amdgcn_mfma_f32_32x32x16_bf16(kf_[0], qr[0], cfarv, 0, 0, 0); P1 = __builtin_amdgcn_mfma_f32_32x32x16_bf16(kf_[1], qr[0], cfarv, 0, 0, 0); } \
            _Pragma("unroll") for (int ks = 1; ks < 4; ++ks) { \
                P0 = __builtin_amdgcn_mfma_f32_32x32x16_bf16(kf_[2 * ks], qr[ks], P0, 0, 0, 0); \
                P1 = __builtin_amdgcn_mfma_f32_32x32x16_bf16(kf_[2 * ks + 1], qr[ks], P1, 0, 0, 0); } __builtin_amdgcn_s_setprio(0); } while (0)
#ifndef ATT_PFD
#define ATT_PFD 3
#endif
#define ATT_VFRAG(i_) (bf16x8){vl_[(i_) % (ATT_PFD + 1)][0], vl_[(i_) % (ATT_PFD + 1)][1], vl_[(i_) % (ATT_PFD + 1)][2], vl_[(i_) % (ATT_PFD + 1)][3], vh_[(i_) % (ATT_PFD + 1)][0], vh_[(i_) % (ATT_PFD + 1)][1], vh_[(i_) % (ATT_PFD + 1)][2], vh_[(i_) % (ATT_PFD + 1)][3]}
#define ATT_VREAD(i_) do { vl_[(i_) % (ATT_PFD + 1)] = vtr(vbase_ + ((i_) >> 2) * 4096 + ((i_) & 3) * 1024); vh_[(i_) % (ATT_PFD + 1)] = vtr(vbase_ + ((i_) >> 2) * 4096 + ((i_) & 3) * 1024 + 512); } while (0)
#define ATT_PV(slot_) do { const LAS unsigned char* vbase_ = lds + (slot_) * 32768 + 16384 + ((lane >> 4) & 1) * 32 + (lane & 3) * 8 + (4 * hi + ((lane & 15) >> 2)) * 64; \
            s16x4 vl_[ATT_PFD + 1], vh_[ATT_PFD + 1]; \
            _Pragma("unroll") for (int i = 0; i < ATT_PFD; ++i) ATT_VREAD(i); \
            asm volatile("" ::: "memory"); __builtin_amdgcn_s_setprio(ATT_PRIO); \
            _Pragma("unroll") for (int i = 0; i < 16; ++i) {   \
                if (i + ATT_PFD < 16) ATT_VREAD(i + ATT_PFD); \
                asm volatile("" : "+v"(o[i >> 2]) :: "memory");     \
                o[i >> 2] = __builtin_amdgcn_mfma_f32_32x32x16_bf16(__builtin_bit_cast(bf16x8, pw[i & 3]), ATT_VFRAG(i), o[i >> 2], 0, 0, 0); \
                } __builtin_amdgcn_s_setprio(0); } while (0)
        f32x16 p0, p1;
        u32x4v pw[4];
#pragma unroll
        for (int q = 0; q < 4; ++q) pw[q] = (u32x4v){0u, 0u, 0u, 0u};
        int slotp = 3, slot = 0, slotn = 1, slotf = 2;
        for (int t = 0; t < NT; ++t) {
            ATT_KREAD(slot);
            if (comp == 1 && t > 0) ATT_PV(slotp);
            ATT_QK(p0, p1, t, slot);
            const bool near = t >= NT - 4;
            if (near) {
#define ATT_NEAR(P, koff) do { float bb_[16]; const LAS float* tp_ = t2 + (j >> 1) * 384 + (255 - qpos + 64 * t + (koff) + 4 * hi); \
                    _Pragma("unroll") for (int r = 0; r < 16; ++r) bb_[r] = tp_[(r & 3) + 8 * (r >> 2)];     \
                    _Pragma("unroll") for (int r = 0; r < 16; ++r) asm volatile("" : "+v"(bb_[r]));        \
                    _Pragma("unroll") for (int r = 0; r < 16; ++r) P[r] = __builtin_amdgcn_exp2f(P[r] + bb_[r]); } while (0)
                ATT_NEAR(p0, 0); ATT_NEAR(p1, 32);
#undef ATT_NEAR
            } else {
#pragma unroll
                for (int r = 0; r < 16; ++r) { p0[r] = __builtin_amdgcn_exp2f(p0[r]); p1[r] = __builtin_amdgcn_exp2f(p1[r]); }
            }
            { typedef float f32x2a __attribute__((ext_vector_type(2)));
              f32x2a sa = (f32x2a){p0[0], p0[1]} + (f32x2a){p1[0], p1[1]};
#pragma unroll
              for (int r = 2; r < 16; r += 2) sa += (f32x2a){p0[r], p0[r + 1]} + (f32x2a){p1[r], p1[r + 1]};
              lsum += sa.x + sa.y; }
#pragma unroll
            for (int q = 0; q < 4; ++q) { pw[0][q] = pk2(p0[2 * q], p0[2 * q + 1]); pw[1][q] = pk2(p0[8 + 2 * q], p0[9 + 2 * q]);
                pw[2][q] = pk2(p1[2 * q], p1[2 * q + 1]); pw[3][q] = pk2(p1[8 + 2 * q], p1[9 + 2 * q]); }
#ifdef ATT_XEXP
            { float d0_ = lsum, d1_ = lsum, d2_ = lsum, d3_ = lsum;
#pragma unroll
              for (int r = 0; r < 8; ++r) asm volatile("v_exp_f32 %0, %0\n\tv_exp_f32 %1, %1\n\tv_exp_f32 %2, %2\n\tv_exp_f32 %3, %3" : "+v"(d0_), "+v"(d1_), "+v"(d2_), "+v"(d3_)); }
#endif
#ifdef ATT_XMFMA
            { f32x16 dm_ = p0;
#pragma unroll
              for (int r = 0; r < 8; ++r) dm_ = __builtin_amdgcn_mfma_f32_32x32x16_bf16(qr[r & 3], qr[(r + 1) & 3], dm_, 0, 0, 0);
              asm volatile("" :: "v"(dm_)); }
#endif
            if (comp == 0) ATT_PV(slot);
            asm volatile("s_waitcnt vmcnt(0) lgkmcnt(0)" ::: "memory");
            __builtin_amdgcn_s_barrier(); asm volatile("" ::: "memory");
            if (t + 3 < NT) ATT_DMA_TILE(t + 3, slotp);
            { const int s_ = slotp; slotp = slot; slot = slotn; slotn = slotf; slotf = s_; }
        }
        if (comp == 1) ATT_PV(slotp);
        if (j + 1 < 8) {
            const int jn = j + 1, bhn = 4 * (vcu >> 3) + (jn >> 1), qbn = (jn & 1) ? 15 - (vcu & 7) : (vcu & 7);
            const int lane_q = opaque_tid() & 63;
            const bf16* qpn = Qb + ((size_t)(bhn >> 3) * SEQ + qbn * 128 + 32 * wq + (lane_q & 31)) * 1024 + (bhn & 7) * 128 + comp * 64 + 8 * (lane_q >> 5);
#pragma unroll
            for (int ks = 0; ks < 4; ++ks) qn[ks] = *(const GAS bf16x8*)(qpn + 16 * ks);
        }
        asm volatile("s_waitcnt lgkmcnt(0)" ::: "memory"); __builtin_amdgcn_s_barrier(); asm volatile("" ::: "memory");
#undef ATT_PV
#undef ATT_VREAD
#undef ATT_VFRAG
#undef ATT_QK
#undef ATT_KREAD
#undef ATT_DMA_TILE
        const float lt = lsum + shfl_xor_f(lsum, 32);
        if (hi == 0) wsf[r32] = lt;
        LDS_WAIT(); asm volatile("" ::: "memory");
        float rli[16];
#pragma unroll
        for (int r = 0; r < 16; ++r) rli[r] = __builtin_amdgcn_rcpf(wsf[crow(r, hi)]);
        if (comp == 1) {
            const float lam = mt[129];
#pragma unroll
            for (int dvb = 0; dvb < 4; ++dvb)
#pragma unroll
                for (int q = 0; q < 4; ++q) {
                    f32x4 w;
#pragma unroll
                    for (int i = 0; i < 4; ++i) w[i] = o[dvb][4 * q + i] * rli[4 * q + i] * lam;
                    *(LAS f32x4*)(X + ((wq * 128 + 32 * dvb + r32) * 36 + 8 * q + 4 * hi)) = w; }
        }
        asm volatile("s_waitcnt lgkmcnt(0)" ::: "memory"); __builtin_amdgcn_s_barrier(); asm volatile("" ::: "memory");
        if (comp == 0) {
            float ss[16];
#pragma unroll
            for (int r = 0; r < 16; ++r) ss[r] = 0.f;
#pragma unroll
            for (int dvb = 0; dvb < 4; ++dvb)
#pragma unroll
                for (int q = 0; q < 4; ++q) { const f32x4 xv = *(const LAS f32x4*)(X + ((wq * 128 + 32 * dvb + r32) * 36 + 8 * q + 4 * hi));
#pragma unroll
                    for (int i = 0; i < 4; ++i) { const int r = 4 * q + i; const float v = o[dvb][r] * rli[r] - xv[i]; o[dvb][r] = v; ss[r] += v * v; } }
#pragma unroll
            for (int r = 0; r < 16; ++r) { float s = ss[r]; s = red32(s); ss[r] = __builtin_amdgcn_rsqf(s * (1.f / 128.f) + EPS); }
            LDS_WAIT(); asm volatile("" ::: "memory");
            LAS bf16* stg = (LAS bf16*)((LAS unsigned char*)X + 73728 + wq * 8192);
#pragma unroll
            for (int dvb = 0; dvb < 4; ++dvb)
#pragma unroll
                for (int r = 0; r < 16; ++r) stg[crow(r, hi) * 128 + 32 * dvb + r32] = (bf16)f2bf(o[dvb][r] * ss[r]);
            LDS_WAIT(); asm volatile("" ::: "memory");
            const int lane_e = opaque_tid() & 63;
#pragma unroll
            for (int i = 0; i < 8; ++i) { const int row = 4 * i + (lane_e >> 4), ch = lane_e & 15;
                const v4u w = *(const LAS v4u*)(stg + row * 128 + ch * 8);
                *(GAS v4u*)(Ob + (tok0 + q0 + 32 * wq + row) * 1024 + h * 128 + ch * 8) = w; }
        }
        asm volatile("s_waitcnt lgkmcnt(0)" ::: "memory"); __builtin_amdgcn_s_barrier(); asm volatile("" ::: "memory");
    }
}

constexpr int SSD_LD = 272;
constexpr int SSD_BS = 0, SSD_CS = 128 * SSD_LD, SSD_XS = 2 * 128 * SSD_LD, SSD_ST = 3 * 128 * SSD_LD, SSD_VEC = 4 * 128 * SSD_LD,
              SSD_HALO = SSD_VEC + 2048, SSD_STG = SSD_HALO + 2048, SSD_GSL = SSD_STG + 8 * 2048;
constexpr int SSD_FCOL = SSD_GSL + 1024;
static_assert(SSD_FCOL + 1024 <= LDSCTL_OFF, "SSD LDS map");
__device__ __forceinline__ bf16x8 frag_tr(const LAS unsigned char* p) {
    const s16x4 lo = vtr(p), hh = vtr(p + 8 * SSD_LD);
    return (bf16x8){lo[0], lo[1], lo[2], lo[3], hh[0], hh[1], hh[2], hh[3]};
}
#define SSD_SYNC() do { asm volatile("s_waitcnt lgkmcnt(0)" ::: "memory"); __builtin_amdgcn_s_barrier(); asm volatile("" ::: "memory"); } while (0)
#ifdef SSD_PROBE_SEC
#define SSD_T0() long long tsec_ = __builtin_amdgcn_s_memrealtime()
#define SSD_T1(sec_) do { const long long now_ = __builtin_amdgcn_s_memrealtime(); if (SSD_PROBE_SEC == (sec_)) { const long long tgt_ = now_ + 2 * (now_ - tsec_); \
        while ((long long)__builtin_amdgcn_s_memrealtime() < tgt_) __builtin_amdgcn_s_sleep(4); } tsec_ = __builtin_amdgcn_s_memrealtime(); } while (0)
#else
#define SSD_T0() do {} while (0)
#define SSD_T1(sec_) do {} while (0)
#endif
__device__ __forceinline__ void ssd_fast_phase(const Args& a, LAS unsigned char* lds, int vcu) {
    const int tid = opaque_tid(), lane = tid & 63, wid = __builtin_amdgcn_readfirstlane(tid >> 6), r32 = lane & 31, hi = lane >> 5;
    const unsigned zz_ = (unsigned)tid >> 31; const v4u vzero = {zz_, zz_, zz_, zz_};
    const int hh = wid >> 2, wl = hh ? 3 - (wid & 3) : (wid & 3), wn = wid & 3;
    const int b = vcu >> 4, g = (vcu >> 2) & 3, h0 = 8 * g + 2 * (vcu & 3), hd = h0 + hh;
    float* gss = (float*)(opaque_ws(a) + WS_GSS);
    const bf16* XBC = (const bf16*)(opaque_ws(a) + WS_XBC); const float* DT = (const float*)(opaque_ws(a) + WS_DT);
    const size_t tok0 = (size_t)b * SEQ;
    LAS float* dtv = (LAS float*)(lds + SSD_VEC);
    LAS float* acs = dtv + 256;
#define SSD_ROLES() const int tidr_ = opaque_tid(); const int cg = tidr_ % 48, ls = tidr_ / 48; \
    const int ccol = cg < 16 ? 64 * h0 + 8 * cg : (cg < 32 ? 2048 + 128 * g + 8 * (cg - 16) : 2560 + 128 * g + 8 * (cg - 32)); \
    const int cdst = (cg < 16 ? SSD_XS + 16 * cg : (cg < 32 ? SSD_BS + 16 * (cg - 16) : SSD_CS + 16 * (cg - 32))); (void)cdst; (void)ccol; (void)ls
    const float Aneg = -__expf(ARG_IN(a, 6)[hd]), Dh = ARG_IN(a, 7)[hd];
    f32x16 stq[2];
#pragma unroll
    for (int pb = 0; pb < 2; ++pb)
#pragma unroll
        for (int r = 0; r < 16; ++r) stq[pb][r] = 0.f;
    for (int e = tid; e < 128 * SSD_LD / 16; e += 512) *(LAS v4u*)(lds + SSD_ST + e * 16) = vzero;
    const int g16 = (lane >> 4) & 1, tq = (lane & 15) >> 2, tp = lane & 3;
    v4u pre[16];
#define SSD_PREFETCH(ch_) do { if (tid < 384) { SSD_ROLES(); const bf16* src_ = XBC + (tok0 + (ch_) * 128 + 16 * ls) * NXBC + ccol; \
        _Pragma("unroll") for (int i = 0; i < 16; ++i) pre[i] = *(const GAS v4u*)(src_ + (size_t)i * NXBC); } } while (0)
    float dtp[2] = {0.f, 0.f};
#define SSD_DTPREFETCH(ch_) do { if (wid >= 6) { const int hq_ = h0 + (wid - 6); const int lane_ = opaque_tid() & 63; \
        dtp[0] = DT[(tok0 + (ch_) * 128 + lane_) * 32 + hq_]; dtp[1] = DT[(tok0 + (ch_) * 128 + 64 + lane_) * 32 + hq_]; } } while (0)
    SSD_PREFETCH(0); SSD_DTPREFETCH(0);
    for (int ch = 0; ch < SEQ / 128; ++ch) {
        const int t0 = ch * 128;
        SSD_T0();
        if (tid < 384) {
            SSD_ROLES();
#pragma unroll
            for (int i = 0; i < 16; ++i) *(LAS v4u*)(lds + cdst + (16 * ls + i) * SSD_LD) = pre[i];
        } else {
            const int q = wid - 6, hq = h0 + q; const float An = -__expf(ARG_IN(a, 6)[hq]) * LOG2E  , dtb = ARG_IN(a, 5)[hq];
            const float r0 = dtp[0] + dtb, r1 = dtp[1] + dtb;
            const float d0 = r0 > 20.f ? r0 : __logf(1.f + __expf(r0)), d1 = r1 > 20.f ? r1 : __logf(1.f + __expf(r1));
            float s0 = d0 * An, s1 = d1 * An;
#define SSD_DPP(v_, ctrl_, rmask_, bc_) __builtin_bit_cast(float, __builtin_amdgcn_update_dpp(0, __builtin_bit_cast(int, v_), ctrl_, rmask_, 0xf, bc_))
#define SSD_SCAN(v_) do { v_ += SSD_DPP(v_, 0x111, 0xf, true); v_ += SSD_DPP(v_, 0x112, 0xf, true); v_ += SSD_DPP(v_, 0x114, 0xf, true); v_ += SSD_DPP(v_, 0x118, 0xf, true); \
                v_ += SSD_DPP(v_, 0x142, 0xa, false); v_ += SSD_DPP(v_, 0x143, 0xc, false); } while (0)
            SSD_SCAN(s0); SSD_SCAN(s1);
#undef SSD_SCAN
#undef SSD_DPP
            s1 += __builtin_bit_cast(float, __builtin_amdgcn_readlane(__builtin_bit_cast(int, s0), 63));
            dtv[q * 128 + lane] = d0; dtv[q * 128 + 64 + lane] = d1; acs[q * 128 + lane] = s0; acs[q * 128 + 64 + lane] = s1;
            { const float e0 = __builtin_bit_cast(float, __builtin_amdgcn_readlane(__builtin_bit_cast(int, s0), 31)), e1 = __builtin_bit_cast(float, __builtin_amdgcn_readlane(__builtin_bit_cast(int, s0), 63));
              const float e2 = __builtin_bit_cast(float, __builtin_amdgcn_readlane(__builtin_bit_cast(int, s1), 31)), e3 = __builtin_bit_cast(float, __builtin_amdgcn_readlane(__builtin_bit_cast(int, s1), 63));
              LAS float* fc = (LAS float*)(lds + SSD_FCOL) + q * 128;
              fc[lane] = __builtin_amdgcn_exp2f((lane < 32 ? e0 : e1) - s0) * d0; fc[64 + lane] = __builtin_amdgcn_exp2f((lane < 32 ? e2 : e3) - s1) * d1; }
        }
        SSD_SYNC(); SSD_T1(0);
        {
            const int lane = opaque_tid() & 63, r32 = lane & 31, hi = lane >> 5, g16 = (lane >> 4) & 1, tq = (lane & 15) >> 2, tp = lane & 3;
            bf16* Zb = (bf16*)(opaque_ws(a) + WS_Z);
            v4u zv[2][2];
#pragma unroll
            for (int pb = 0; pb < 2; ++pb)
#pragma unroll
                for (int i = 0; i < 2; ++i) zv[pb][i] = *(const GAS v4u*)(Zb + (tok0 + t0 + 32 * wl + 16 * i + (lane >> 2)) * DIN + 64 * hd + 32 * pb + (lane & 3) * 8);
            bf16x8 cf[8];
            const LAS unsigned char* cp = lds + SSD_CS + (32 * wl + r32) * SSD_LD + 16 * hi;
#pragma unroll
            for (int ks = 0; ks < 8; ++ks) cf[ks] = *(const LAS bf16x8*)(cp + 32 * ks);
#define SSD_PIN(acc_) asm volatile("" : "+v"(acc_) :: "memory")
            f32x16 acc[2];
#pragma unroll
            for (int pb = 0; pb < 2; ++pb)
#pragma unroll
                for (int r = 0; r < 16; ++r) acc[pb][r] = 0.f;
            {
                const LAS unsigned char* sp = lds + SSD_ST + (hh * 64 + r32) * SSD_LD + 16 * hi;
#define SSD_SREAD(i_) (*(const LAS bf16x8*)(sp + ((i_) >> 3) * 32 * SSD_LD + 32 * ((i_) & 7)))
                bf16x8 sf[4];
#pragma unroll
                for (int i = 0; i < 3; ++i) sf[i] = SSD_SREAD(i);
#pragma unroll
                for (int i = 0; i < 16; ++i) {
                    if (i + 3 < 16) sf[(i + 3) & 3] = SSD_SREAD(i + 3);
                    SSD_PIN(acc[i >> 3]);
                    acc[i >> 3] = __builtin_amdgcn_mfma_f32_32x32x16_bf16(cf[i & 7], sf[i & 3], acc[i >> 3], 0, 0, 0);
                }
#undef SSD_SREAD
            }
            const LAS float* acsh = acs + hh * 128; const LAS float* dth = dtv + hh * 128;
            { LAS float* ew = (LAS float*)(lds + SSD_STG + wid * 2048);
              ew[r32] = __builtin_amdgcn_exp2f(acsh[32 * wl + r32]);
              asm volatile("" ::: "memory");
#pragma unroll
              for (int q = 0; q < 4; ++q) { const f32x4 ev = *(const LAS f32x4*)(ew + 8 * q + 4 * hi);
#pragma unroll
                for (int i = 0; i < 4; ++i) { acc[0][4 * q + i] *= ev[i]; acc[1][4 * q + i] *= ev[i]; } }
              asm volatile("" ::: "memory"); }
            const int lrow = 32 * wl + r32; const float acs_l = acsh[lrow];
            for (int sb = 0; sb <= wl; ++sb) {
                f32x16 gt;
#pragma unroll
                for (int r = 0; r < 16; ++r) gt[r] = 0.f;
                const LAS unsigned char* bp = lds + SSD_BS + (32 * sb + r32) * SSD_LD + 16 * hi;
                bf16x8 bfr[3];
#pragma unroll
                for (int ks = 0; ks < 2; ++ks) bfr[ks] = *(const LAS bf16x8*)(bp + 32 * ks);
#pragma unroll
                for (int ks = 0; ks < 8; ++ks) {
                    if (ks + 2 < 8) bfr[(ks + 2) % 3] = *(const LAS bf16x8*)(bp + 32 * (ks + 2));
                    SSD_PIN(gt);
                    gt = __builtin_amdgcn_mfma_f32_32x32x16_bf16(bfr[ks % 3], cf[ks], gt, 0, 0, 0);
                }
                const float rng_ = __builtin_bit_cast(float, __builtin_amdgcn_readfirstlane(__builtin_bit_cast(int, acsh[32 * sb] - acsh[32 * sb + 31])));
                if (sb < wl || rng_ <= 100.f) {
                    const float er = __builtin_amdgcn_exp2f(acs_l - acsh[32 * sb + 31]);
                    const LAS float* fch = (const LAS float*)(lds + SSD_FCOL) + hh * 128 + 32 * sb + 4 * hi;
#pragma unroll
                    for (int q = 0; q < 4; ++q) { const f32x4 fv = *(const LAS f32x4*)(fch + 8 * q);
#pragma unroll
                        for (int i = 0; i < 4; ++i) gt[4 * q + i] *= er * fv[i]; }
                } else {
#pragma unroll
                    for (int q = 0; q < 4; ++q) { const f32x4 av = *(const LAS f32x4*)(acsh + 32 * sb + 8 * q + 4 * hi), dv = *(const LAS f32x4*)(dth + 32 * sb + 8 * q + 4 * hi);
#pragma unroll
                        for (int i = 0; i < 4; ++i) gt[4 * q + i] *= __builtin_amdgcn_exp2f(fminf(acs_l - av[i], 0.f)) * dv[i]; }
                }
                if (sb == wl) {
#pragma unroll
                    for (int r = 0; r < 16; ++r) { const int s = 32 * sb + crow(r, hi); float m = gt[r]; if (s == lrow) m += Dh; gt[r] = (s <= lrow) ? m : 0.f; }
                }
                u32x4v pw0, pw1;
#pragma unroll
                for (int q = 0; q < 4; ++q) { pw0[q] = pg8::cvt_pk_bf16(gt[2 * q], gt[2 * q + 1]); pw1[q] = pg8::cvt_pk_bf16(gt[8 + 2 * q], gt[9 + 2 * q]); }
                bf16x8 xf[2][2];
#pragma unroll
                for (int pb = 0; pb < 2; ++pb) {
                    const LAS unsigned char* xp = lds + SSD_XS + (32 * sb + 4 * hi + tq) * SSD_LD + (64 * hh + 32 * pb + 16 * g16 + 4 * tp) * 2;
                    xf[pb][0] = frag_tr(xp); xf[pb][1] = frag_tr(xp + 16 * SSD_LD); }
                SSD_PIN(acc[0]);
#pragma unroll
                for (int pb = 0; pb < 2; ++pb) {
                    acc[pb] = __builtin_amdgcn_mfma_f32_32x32x16_bf16(__builtin_bit_cast(bf16x8, pw0), xf[pb][0], acc[pb], 0, 0, 0);
                    acc[pb] = __builtin_amdgcn_mfma_f32_32x32x16_bf16(__builtin_bit_cast(bf16x8, pw1), xf[pb][1], acc[pb], 0, 0, 0);
                }
            }
            LAS bf16* stg = (LAS bf16*)(lds + SSD_STG + wid * 2048);
            float sqa[2] = {0.f, 0.f};
#pragma unroll
            for (int pb = 0; pb < 2; ++pb) {
#pragma unroll
                for (int r = 0; r < 16; ++r) stg[crow(r, hi) * 32 + r32] = (bf16)f2bf(acc[pb][r]);
                asm volatile("" ::: "memory");
#pragma unroll
                for (int i = 0; i < 2; ++i) { const int row = 16 * i + (lane >> 2), c8 = (lane & 3) * 8;
                    typedef float f32x2s __attribute__((ext_vector_type(2)));
                    const v4u yw = *(const LAS v4u*)(stg + row * 32 + c8), zw = zv[pb][i];
                    const unsigned yu[4] = {yw.x, yw.y, yw.z, yw.w}, zu[4] = {zw.x, zw.y, zw.z, zw.w};
                    f32x2s sq2 = {0.f, 0.f}; unsigned ow[4];
#pragma unroll
                    for (int e = 0; e < 4; ++e) {
                        const f32x2s yv = {__builtin_bit_cast(float, yu[e] << 16), __builtin_bit_cast(float, yu[e] & 0xffff0000u)}, zf = {__builtin_bit_cast(float, zu[e] << 16), __builtin_bit_cast(float, zu[e] & 0xffff0000u)};
                        const f32x2s ez = zf * (f32x2s){-LOG2E, -LOG2E};
                        const f32x2s den = (f32x2s){__builtin_amdgcn_exp2f(ez.x), __builtin_amdgcn_exp2f(ez.y)} + (f32x2s){1.f, 1.f};
                        const f32x2s g = yv * zf * (f32x2s){__builtin_amdgcn_rcpf(den.x), __builtin_amdgcn_rcpf(den.y)};
                        sq2 += g * g; ow[e] = pk2(g.x, g.y); }
                    *(GAS v4u*)(Zb + (tok0 + t0 + 32 * wl + row) * DIN + 64 * hd + 32 * pb + c8) = (v4u){ow[0], ow[1], ow[2], ow[3]};
                    sqa[i] += sq2.x + sq2.y; }
                asm volatile("" ::: "memory");
            }
#pragma unroll
            for (int i = 0; i < 2; ++i) { float sq = sqa[i];
                sq += __builtin_bit_cast(float, __builtin_amdgcn_update_dpp(0, __builtin_bit_cast(int, sq), 0xB1, 0xf, 0xf, true));
                sq += __builtin_bit_cast(float, __builtin_amdgcn_update_dpp(0, __builtin_bit_cast(int, sq), 0x4E, 0xf, 0xf, true));
                if ((lane & 3) == 0) ((LAS float*)(lds + SSD_GSL))[hh * 128 + 32 * wl + 16 * i + (lane >> 2)] = sq; }
        }
        SSD_SYNC(); SSD_T1(1);
        if (ch + 1 < SEQ / 128) { SSD_PREFETCH(ch + 1); SSD_DTPREFETCH(ch + 1); }
        {
            const int tidc = opaque_tid();
            if (tidc < 128) gss[(tok0 + t0 + tidc) * 16 + g * 4 + (vcu & 3)] = ((LAS float*)(lds + SSD_GSL))[tidc] + ((LAS float*)(lds + SSD_GSL))[128 + tidc];
 const int l = tidc >> 2, c0 = (tidc & 3) * 32, hq = c0 >> 6;
            const float f = __builtin_amdgcn_exp2f(acs[hq * 128 + 127] - acs[hq * 128 + l]) * dtv[hq * 128 + l];
            LAS unsigned char* xp = lds + SSD_XS + l * SSD_LD + c0 * 2;
#pragma unroll
            for (int q = 0; q < 4; ++q) { v4u w = *(LAS v4u*)(xp + 16 * q); unsigned ww[4] = {w.x, w.y, w.z, w.w};
#pragma unroll
                for (int i = 0; i < 4; ++i) ww[i] = pk2(__builtin_bit_cast(float, ww[i] << 16) * f, __builtin_bit_cast(float, ww[i] & 0xffff0000u) * f);
                *(LAS v4u*)(xp + 16 * q) = (v4u){ww[0], ww[1], ww[2], ww[3]}; }
        }
        SSD_SYNC(); SSD_T1(2);
        {
            const int lane = opaque_tid() & 63, r32 = lane & 31, hi = lane >> 5, g16 = (lane >> 4) & 1, tq = (lane & 15) >> 2, tp = lane & 3;
            const float eL = __builtin_amdgcn_exp2f(acs[hh * 128 + 127]);
#pragma unroll
            for (int pb = 0; pb < 2; ++pb)
#pragma unroll
                for (int r = 0; r < 16; ++r) stq[pb][r] *= eL;
            const LAS unsigned char* bp = lds + SSD_BS + (4 * hi + tq) * SSD_LD + (32 * wn + 16 * g16 + 4 * tp) * 2;
            const LAS unsigned char* xp = lds + SSD_XS + (4 * hi + tq) * SSD_LD + (64 * hh + 16 * g16 + 4 * tp) * 2;
#pragma unroll
            for (int ks = 0; ks < 8; ++ks) {
                const bf16x8 bt = frag_tr(bp + 16 * ks * SSD_LD);
                stq[0] = __builtin_amdgcn_mfma_f32_32x32x16_bf16(bt, frag_tr(xp + 16 * ks * SSD_LD), stq[0], 0, 0, 0);
                stq[1] = __builtin_amdgcn_mfma_f32_32x32x16_bf16(bt, frag_tr(xp + 16 * ks * SSD_LD + 64), stq[1], 0, 0, 0);
            }
#pragma unroll
            for (int pb = 0; pb < 2; ++pb)
#pragma unroll
                for (int rg = 0; rg < 4; ++rg) {
                    typedef unsigned u32x2v __attribute__((ext_vector_type(2)));
                    u32x2v w; w.x = pg8::cvt_pk_bf16(stq[pb][4 * rg], stq[pb][4 * rg + 1]); w.y = pg8::cvt_pk_bf16(stq[pb][4 * rg + 2], stq[pb][4 * rg + 3]);
                    *(LAS u32x2v*)(lds + SSD_ST + (hh * 64 + 32 * pb + r32) * SSD_LD + (32 * wn + 8 * rg + 4 * hi) * 2) = w;
                }
        }
        SSD_SYNC(); SSD_T1(3);
    }
}


#ifndef MK_ONE_LAUNCH
#define MK_ONE_LAUNCH 1
#endif
constexpr int N_PHASES = 24;
#ifndef MK_PROG
#define MK_PROG {0, 1, 25, 2, 4, 6, 7, 8, 13, 15, 16, 18, 19, 20}
#endif
#ifndef STAG_IN
#define STAG_IN 0
#endif
#ifndef STAG_RES
#define STAG_RES 0
#endif
#ifndef STAG_UP
#define STAG_UP 0
#endif
#ifndef STAG_KVQ
#define STAG_KVQ 0
#endif
__device__ __forceinline__ void stagger_spin(int ticks) {
    if (ticks > 0) { const long long t0_ = __builtin_amdgcn_s_memrealtime(); while ((long long)__builtin_amdgcn_s_memrealtime() - t0_ < ticks) __builtin_amdgcn_s_sleep(8); }
}
__global__ void __launch_bounds__(NWAVES * 64, 2) mk_fwd(Args args) {
    extern __shared__ __attribute__((aligned(16))) unsigned char lds_raw[];
    LAS unsigned char* lds = (LAS unsigned char*)lds_raw;
    const int G = gridDim.x;
#ifdef PROBE_PH
    const long long tk0_ = __builtin_amdgcn_s_memrealtime();
#endif
    const int vcu = (G % 8 == 0) ? ((int)blockIdx.x % 8) * (G / 8) + (int)blockIdx.x / 8 : (int)blockIdx.x;
    const int NGW = G * NWAVES;
    gu32* ctl = (gu32*)(args.ws + WS_CTL);
    for (int u = threadIdx.x; u < (LDS_BYTES - LDSCTL_OFF) / 4; u += NWAVES * 64) ((LAS unsigned*)(lds + LDSCTL_OFF))[u] = 0u;
    __syncthreads();
    volatile LAS unsigned* MISC = (volatile LAS unsigned*)(lds + MISC_OFF);
    XcdBarrier bar; bar.bar = (unsigned*)(ctl + CW_BAR); bar.x = 0; bar.st = nullptr;
    const int ph_lo = __builtin_amdgcn_readfirstlane(args.ph_lo), ph_hi = __builtin_amdgcn_readfirstlane(args.ph_hi);
    const bool multi = (ph_hi - ph_lo) > 1;
    if (multi) bar = xcd_barrier_post((unsigned*)(ctl + CW_BAR), MISC + 8);

#ifdef PROBE_PH
#endif
    for (int pi = ph_lo; pi < ph_hi; ++pi) {
        const int ph = args.prog[pi];
        unsigned char* const ws = opaque_ws(args);
        bf16* const XB = (bf16*)(ws + WS_XB); float* const SS0 = (float*)(ws + WS_RSTD);
        float* const SS1 = (float*)(ws + WS_SS1); float* const SS2 = (float*)(ws + WS_SS2); float* const SS3 = (float*)(ws + WS_SS3);
#ifdef PROBE_PH
        const long long tp0_ = __builtin_amdgcn_s_memrealtime();
#endif
        if (ph == 0) prep_phase(args, lds, vcu, NGW, 0);
        else if (ph == 1) {
            pg8::Gemm g{XB, (const bf16*)(ws + WS_WIN), M_TOK, NINP, DM}; pg8::StaticOrder S; S.init(M_TOK, NINP, G, (int)blockIdx.x);
            pg8::EpiInConv E{(bf16*)(ws + WS_Z), (bf16*)(ws + WS_XBC), (float*)(ws + WS_DT), SS0, (bf16*)(ws + WS_XRAW), ARG_IN(args, 3), ARG_IN(args, 4), lds + RING_BYTES};
            stagger_spin((int)blockIdx.x >= 128 ? STAG_IN : 0);
            pg8::gemm_phase<pg8::EpiInConv, pg8::StaticOrder, true, true>(lds, g, S, E, (float*)(ws + 768 * 1024));
            if ((int)blockIdx.x >= 128) prep_phase(args, lds, vcu, NGW, 1, (int)blockIdx.x - 128, 128);
        }
        else if (ph == 25) ssmconv_fixup_phase(args);
        else if (ph == 2) ssd_fast_phase(args, lds, vcu);
        else if (ph == 13) {
            pg8::Gemm g{XB, (const bf16*)(ws + WS_WKVQ), M_TOK, 3072, DM}; pg8::StaticOrder S; S.init(M_TOK, 3072, G, (int)blockIdx.x);
            pg8::EpiKVQ E{(bf16*)(ws + WS_K), (size_t)(WS_V - WS_K) / 2, SS2, ARG_IN(args, 12), ARG_IN(args, 16), QSCALE};
            static_assert(WS_Q - WS_V == WS_V - WS_K, "K, V, Q equally spaced");
            stagger_spin((((int)blockIdx.x >> 3) & 3) * STAG_KVQ);
            pg8::gemm_phase<pg8::EpiKVQ, pg8::StaticOrder, true, true>(lds, g, S, E, (float*)(ws + 768 * 1024));
        }
        else if (ph == 15) attn_fast_phase(args, lds, vcu);
        else {
            const int ffn_l = (ph >= 18) ? 1 : 0;
            if (ph == 6 || ph == 18) {
                pg8::Gemm g{XB, (const bf16*)(ws + (ffn_l ? WS_WUP1 : WS_WUP0)), M_TOK, FF2, DM}; pg8::StaticOrder S; S.init(M_TOK, FF2, G, (int)blockIdx.x);
                pg8::EpiConvFFN E{(bf16*)(ws + WS_H), (bf16*)(ws + WS_FRAW), ffn_l ? SS3 : SS1, ARG_IN(args, 22) + (size_t)ffn_l * 3 * FF2, ARG_IN(args, 23) + (size_t)ffn_l * FF2, lds + RING_BYTES};
                stagger_spin((((int)blockIdx.x >> 3) & 3) * STAG_UP);
                pg8::gemm_phase<pg8::EpiConvFFN, pg8::StaticOrder, true, true>(lds, g, S, E, (float*)(ws + 768 * 1024));
            } else if (ph == 7 || ph == 19) convffn_fixup_phase(args, ffn_l);
            else {
                const bf16* A; const bf16* Bt; int Kg; const bf16* baseb = XB; float* outf = nullptr; bf16* xbp = XB; float* ssp;
                if (ph == 4) { A = (const bf16*)(ws + WS_Z); Bt = (const bf16*)(ws + WS_WOUT); Kg = DIN; ssp = SS1; }
                else if (ph == 16) { A = (const bf16*)(ws + WS_O); Bt = (const bf16*)(ws + WS_WAO); Kg = DM; ssp = SS3; }
                else { A = (const bf16*)(ws + WS_H); Bt = (const bf16*)(ws + (ffn_l ? WS_WDN1 : WS_WDN0)); Kg = FF; ssp = ffn_l ? nullptr : SS2; if (ffn_l) { outf = args.out; xbp = nullptr; } }
                pg8::Gemm g{A, Bt, M_TOK, DM, Kg}; pg8::StaticOrder S; S.init(M_TOK, DM, G, (int)blockIdx.x);
                pg8::EpiRes E{baseb, outf, xbp, ssp, (ph == 20) ? (const float*)(ws + 768 * 1024) : nullptr, (ph == 4) ? (const float*)(ws + WS_GSS) : nullptr, (PG8_LAS float*)(lds + RING_BYTES)};
                stagger_spin((((int)blockIdx.x >> 3) & 1) * STAG_RES);
                pg8::gemm_phase<pg8::EpiRes, pg8::StaticOrder, true, true>(lds, g, S, E, (float*)(ws + 768 * 1024));
            }
        }
        if (pi + 1 < ph_hi) xcd_barrier(bar);
#ifdef PROBE_BAR2
        if (pi + 1 < ph_hi) xcd_barrier(bar);
#endif
#ifdef PROBE_PH
        if (ph == PROBE_PH) { const long long now_ = __builtin_amdgcn_s_memrealtime(), tgt_ = now_ + PROBE_K * (now_ - tp0_) + PROBE_FIX * 100;
            while ((long long)__builtin_amdgcn_s_memrealtime() < tgt_) __builtin_amdgcn_s_sleep(20); }
#endif
    }
#ifdef PROBE_PH
    if (PROBE_PH == 99) { const long long now_ = __builtin_amdgcn_s_memrealtime(), tgt_ = now_ + (now_ - tk0_); while ((long long)__builtin_amdgcn_s_memrealtime() < tgt_) __builtin_amdgcn_s_sleep(20); }
#endif
}

extern "C" void kernel_launch(void* const* d_in, const int* in_sizes, int n_in, void* d_out, int out_size, void* d_ws, size_t ws_size, hipStream_t stream) {
    static int grid = 0;
    if (grid == 0) {
        if (n_in != 25 || in_sizes[0] != M_TOK * DM || out_size != M_TOK * DM || ws_size < WS_END) {
            fprintf(stderr, "kernel_launch: unexpected problem (n_in %d, in0 %d, out %d, ws %zu)\n", n_in, n_in > 0 ? in_sizes[0] : -1, out_size, ws_size); grid = -1; return; }
        int dev = 0, cus = 0, per_cu = 0;
        if (hipGetDevice(&dev) != hipSuccess || hipDeviceGetAttribute(&cus, hipDeviceAttributeMultiprocessorCount, dev) != hipSuccess) { grid = -1; return; }
        if (hipFuncSetAttribute((const void*)mk_fwd, hipFuncAttributeMaxDynamicSharedMemorySize, LDS_BYTES) != hipSuccess) { fprintf(stderr, "kernel_launch: hipFuncSetAttribute failed\n"); grid = -1; return; }
        if (hipOccupancyMaxActiveBlocksPerMultiprocessor(&per_cu, (const void*)mk_fwd, NWAVES * 64, LDS_BYTES) != hipSuccess || per_cu < 1)
            fprintf(stderr, "kernel_launch: occupancy query reports %d blocks per CU\n", per_cu);
        (void)hipGetLastError();
        grid = cus;
        if (grid != 256) { fprintf(stderr, "kernel_launch: built for a 256-CU device, found %d CUs\n", cus); grid = -1; return; }
    }
    if (grid < 0) return;
    if (hipMemsetAsync((char*)d_ws + WS_CTL, 0, CTL_ZERO_BYTES, stream) != hipSuccess) { fprintf(stderr, "kernel_launch: memset failed\n"); return; }
    Args a{};
    for (int i = 0; i < 25; ++i) a.in[i] = (const float*)d_in[i];
    a.out = (float*)d_out; a.ws = (unsigned char*)d_ws;
#ifndef MK_PROG
#define MK_PROG {0, 1, 2, 3, 4, 5, 6, 7, 8, 9, 10, 11, 12, 13, 14, 15, 16, 17, 18, 19, 20, 21, 22, 23}
#endif
    static const unsigned char prog_[] = MK_PROG; const int nprog = (int)sizeof(prog_);
    for (int i = 0; i < nprog && i < 64; ++i) a.prog[i] = prog_[i];
#if MK_ONE_LAUNCH
    a.ph_lo = 0; a.ph_hi = nprog;
    hipLaunchKernelGGL(mk_fwd, dim3(grid), dim3(NWAVES * 64), LDS_BYTES, stream, a);
#else
    for (int ph = 0; ph < nprog; ++ph) { a.ph_lo = ph; a.ph_hi = ph + 1; hipLaunchKernelGGL(mk_fwd, dim3(grid), dim3(NWAVES * 64), LDS_BYTES, stream, a); }
#endif
    const hipError_t le = hipPeekAtLastError();
    if (le != hipSuccess) fprintf(stderr, "kernel_launch: launch failed: %s\n", hipGetErrorName(le));
}
```
